# Optimizing an MI355X kernel written in HIP

```python
import math
import jax, jax.numpy as jnp
from jax import lax
import numpy as np

D_MODEL = 2048
BATCH = 2
SEQ = 8192
DEPTH = 2

ATTN_HEADS = 8
ATTN_KV_HEADS = 2
ATTN_HEAD_DIM = 128
ATTN_GROUP = ATTN_HEADS // ATTN_KV_HEADS
ATTN_INNER = ATTN_HEADS * ATTN_HEAD_DIM
IDX_HEADS = 8
IDX_HEAD_DIM = 64
TOPK_MAX = 256
Q_BLOCK = 128
ROPE_THETA = 500000.0
ROPE_FRACTION = 4

SSM_HEADS = 16
SSM_HEAD_DIM = 64
SSM_INNER = SSM_HEADS * SSM_HEAD_DIM
SSM_GROUPS = 2
SSM_STATE = 128
SSM_CONV = 4
SSM_CONV_DIM = SSM_INNER + 2 * SSM_GROUPS * SSM_STATE
SSM_CHUNK = 128

HYB_SPLITS = (ATTN_INNER, ATTN_KV_HEADS * ATTN_HEAD_DIM, ATTN_KV_HEADS * ATTN_HEAD_DIM,
              IDX_HEADS * IDX_HEAD_DIM, IDX_HEAD_DIM, IDX_HEADS,
              SSM_INNER, SSM_CONV_DIM, SSM_HEADS)
HYB_IN = sum(HYB_SPLITS)
HYB_MIX = ATTN_INNER + SSM_INNER

RET_HEADS = 8
RET_QK_DIM = 256
RET_V_DIM = 512
RET_QK_TOTAL = RET_HEADS * RET_QK_DIM
RET_V_TOTAL = RET_HEADS * RET_V_DIM
RET_IN = 2 * RET_QK_TOTAL + 2 * RET_V_TOTAL
RET_CHUNK = 128
RET_THETA = 10000.0

MOE_GROUPS = 8
MOE_EXPERTS_PER_GROUP = 8
N_EXPERTS = MOE_GROUPS * MOE_EXPERTS_PER_GROUP
MOE_TOPK = 2
EXPERT_FF = 512
MOE_BLOCK = 128

EPS = 1e-6
F32 = jnp.float32

kernel_name = "hybrid_dsa_ssd_retention_hmoe"


def _split(t, sizes):
    offs = [int(o) for o in np.cumsum(sizes)[:-1]]
    return jnp.split(t, offs, axis=-1)


def rmsnorm(x, g):
    xf = x.astype(F32)
    y = xf * lax.rsqrt(jnp.mean(xf * xf, axis=-1, keepdims=True) + EPS)
    return (y * g.astype(F32)).astype(x.dtype)


def rope(x, pos, rot_dim, theta):
    half = rot_dim // 2
    inv = jnp.power(theta, -(jnp.arange(half, dtype=F32) * 2.0 / rot_dim))
    ang = pos.astype(F32)[..., None] * inv
    cos = jnp.cos(ang)[:, :, None, :]
    sin = jnp.sin(ang)[:, :, None, :]
    xf = x.astype(F32)
    x1 = xf[..., :half]
    x2 = xf[..., half:rot_dim]
    out = jnp.concatenate([x1 * cos - x2 * sin, x2 * cos + x1 * sin, xf[..., rot_dim:]], axis=-1)
    return out.astype(x.dtype)


def dsa_attention(q, k, v, qi, ki, wi, k_sel):
    B, S = q.shape[:2]
    nb = S // Q_BLOCK

    def to_blocks(t):
        return t.reshape((B, nb, Q_BLOCK) + t.shape[2:]).swapaxes(0, 1)

    qb = to_blocks(q.reshape(B, S, ATTN_KV_HEADS, ATTN_GROUP, ATTN_HEAD_DIM))
    qib = to_blocks(qi)
    wib = to_blocks(wi)
    starts = jnp.arange(nb, dtype=jnp.int32) * Q_BLOCK
    key_pos = jnp.arange(S, dtype=jnp.int32)
    scale = ATTN_HEAD_DIM ** -0.5

    def block(args):
        qblk, qiblk, wblk, t0 = args
        t_pos = t0 + jnp.arange(Q_BLOCK, dtype=jnp.int32)
        rel = jax.nn.relu(jnp.einsum('bthd,bsd->btsh', qiblk, ki))
        score = jnp.einsum('btsh,bth->bts', rel, wblk).astype(F32)
        causal = key_pos[None, :] <= t_pos[:, None]
        score = jnp.where(causal[None], score, -jnp.inf)
        _, idx = lax.top_k(score, k_sel)
        valid = idx <= t_pos[None, :, None]
        kg = jax.vmap(lambda kk, ii: kk[ii])(k, idx)
        vg = jax.vmap(lambda vv, ii: vv[ii])(v, idx)
        s = jnp.einsum('btkgd,btskd->btkgs', qblk, kg).astype(F32) * scale
        s = jnp.where(valid[:, :, None, None, :], s, -jnp.inf)
        p = jax.nn.softmax(s, axis=-1).astype(v.dtype)
        return jnp.einsum('btkgs,btskd->btkgd', p, vg)

    out = lax.map(block, (qb, qib, wib, starts))
    return out.swapaxes(0, 1).reshape(B, S, ATTN_INNER)


def causal_conv(x, w, b):
    y = lax.conv_general_dilated(x, w[:, None, :].astype(x.dtype), window_strides=(1,),
                                 padding=[(SSM_CONV - 1, 0)],
                                 dimension_numbers=('NWC', 'WIO', 'NWC'),
                                 feature_group_count=x.shape[-1])
    return y + b.astype(x.dtype)


def ssd_chunked(xs, dt, a, bm, cm):
    B, S, H, P = xs.shape
    G, N = bm.shape[2], bm.shape[3]
    Hg = H // G
    Q = SSM_CHUNK
    nc = S // Q
    x = xs.reshape(B, nc, Q, G, Hg, P)
    dtc = dt.reshape(B, nc, Q, G, Hg)
    bc = bm.reshape(B, nc, Q, G, N)
    cc = cm.reshape(B, nc, Q, G, N)
    acum = jnp.cumsum(dtc * a.reshape(G, Hg), axis=2)
    xdt = x * dtc[..., None]
    causal = jnp.tril(jnp.ones((Q, Q), dtype=bool))
    seg = acum[:, :, :, None] - acum[:, :, None]
    lmat = jnp.exp(jnp.where(causal[:, :, None, None], seg, -jnp.inf))
    cb = jnp.einsum('bcign,bcjgn->bcijg', cc, bc)
    y_diag = jnp.einsum('bcijgh,bcjghp->bcighp', cb[..., None] * lmat, xdt)
    decay_to_end = jnp.exp(acum[:, :, -1:] - acum)
    states = jnp.einsum('bcjgn,bcjghp->bcghpn', bc, xdt * decay_to_end[..., None])
    chunk_decay = jnp.exp(acum[:, :, -1])

    def step(hs, inp):
        st, dec = inp
        return hs * dec[..., None, None] + st, hs

    h0 = jnp.zeros((B, G, Hg, P, N), F32)
    _, prev = lax.scan(step, h0, (states.swapaxes(0, 1), chunk_decay.swapaxes(0, 1)))
    prev = prev.swapaxes(0, 1)
    y_off = jnp.einsum('bcign,bcghpn->bcighp', cc, prev) * jnp.exp(acum)[..., None]
    return (y_diag + y_off).reshape(B, S, H, P)


def mamba2_ssd(z, xbc, dt_raw, conv_w, conv_b, dt_bias, a_log, d_skip, norm_g):
    B, S = z.shape[:2]
    xbc = jax.nn.silu(causal_conv(xbc, conv_w, conv_b))
    xs, bm, cm = _split(xbc, (SSM_INNER, SSM_GROUPS * SSM_STATE, SSM_GROUPS * SSM_STATE))
    xs = xs.reshape(B, S, SSM_HEADS, SSM_HEAD_DIM).astype(F32)
    bm = bm.reshape(B, S, SSM_GROUPS, SSM_STATE).astype(F32)
    cm = cm.reshape(B, S, SSM_GROUPS, SSM_STATE).astype(F32)
    dt = jax.nn.softplus(dt_raw.astype(F32) + dt_bias.astype(F32))
    a = -jnp.exp(a_log.astype(F32))
    y = ssd_chunked(xs, dt, a, bm, cm) + d_skip.astype(F32)[:, None] * xs
    y = y.reshape(B, S, SSM_INNER) * jax.nn.silu(z.astype(F32))
    y = rmsnorm(y.reshape(B, S, SSM_GROUPS, SSM_INNER // SSM_GROUPS),
                norm_g.reshape(SSM_GROUPS, SSM_INNER // SSM_GROUPS))
    return y.reshape(B, S, SSM_INNER).astype(z.dtype)


def hybrid_attn_ssm(h, pos, w_in, q_norm, k_norm, kidx_norm, conv_w, conv_b,
                    dt_bias, a_log, d_skip, ssm_norm_g, w_out, k_sel):
    B, S, _ = h.shape
    q, k, v, qi, ki, wi, z, xbc, dt_raw = _split(h @ w_in, HYB_SPLITS)
    rot = ATTN_HEAD_DIM // ROPE_FRACTION
    rot_i = IDX_HEAD_DIM // ROPE_FRACTION
    q = rope(rmsnorm(q.reshape(B, S, ATTN_HEADS, ATTN_HEAD_DIM), q_norm), pos, rot, ROPE_THETA)
    k = rope(rmsnorm(k.reshape(B, S, ATTN_KV_HEADS, ATTN_HEAD_DIM), k_norm), pos, rot, ROPE_THETA)
    v = v.reshape(B, S, ATTN_KV_HEADS, ATTN_HEAD_DIM)
    qi = rope(qi.reshape(B, S, IDX_HEADS, IDX_HEAD_DIM), pos, rot_i, ROPE_THETA)
    ki = rope(rmsnorm(ki, kidx_norm)[:, :, None, :], pos, rot_i, ROPE_THETA)[:, :, 0]
    wi = wi * (IDX_HEADS ** -0.5 * IDX_HEAD_DIM ** -0.5)
    attn = dsa_attention(q, k, v, qi, ki, wi, k_sel)
    ssm = mamba2_ssd(z, xbc, dt_raw, conv_w, conv_b, dt_bias, a_log, d_skip, ssm_norm_g)
    return jnp.concatenate([attn, ssm], axis=-1) @ w_out


def retention(h, pos, w_in, norm_g, w_out):
    B, S, _ = h.shape
    q, k, v, g = _split(h @ w_in, (RET_QK_TOTAL, RET_QK_TOTAL, RET_V_TOTAL, RET_V_TOTAL))
    q = rope(q.reshape(B, S, RET_HEADS, RET_QK_DIM), pos, RET_QK_DIM, RET_THETA).astype(F32)
    k = rope(k.reshape(B, S, RET_HEADS, RET_QK_DIM), pos, RET_QK_DIM, RET_THETA).astype(F32) * RET_QK_DIM ** -0.5
    v = v.reshape(B, S, RET_HEADS, RET_V_DIM).astype(F32)
    Q = RET_CHUNK
    nc = S // Q
    log_gamma = jnp.log(1.0 - jnp.power(2.0, -5.0 - jnp.arange(RET_HEADS, dtype=F32)))
    i = jnp.arange(Q, dtype=F32)
    diff = i[:, None] - i[None, :]
    dmat = jnp.where(diff[None] >= 0, jnp.exp(jnp.maximum(diff, 0.0)[None] * log_gamma[:, None, None]), 0.0)
    q_decay = jnp.exp((i + 1.0)[:, None] * log_gamma[None])
    k_decay = jnp.exp((Q - 1.0 - i)[:, None] * log_gamma[None])
    chunk_decay = jnp.exp(Q * log_gamma)

    def chunks(t):
        return t.reshape((B, nc, Q) + t.shape[2:]).swapaxes(0, 1)

    def step(state, inp):
        qc, kc, vc = inp
        s = jnp.einsum('bihd,bjhd->bhij', qc, kc) * dmat
        inner = jnp.einsum('bhij,bjhv->bihv', s, vc)
        cross = jnp.einsum('bihd,bhdv->bihv', qc, state) * q_decay[None, :, :, None]
        state = state * chunk_decay[None, :, None, None] + jnp.einsum(
            'bjhd,bjhv->bhdv', kc * k_decay[None, :, :, None], vc)
        return state, inner + cross

    s0 = jnp.zeros((B, RET_HEADS, RET_QK_DIM, RET_V_DIM), F32)
    _, o = lax.scan(step, s0, (chunks(q), chunks(k), chunks(v)))
    o = o.swapaxes(0, 1).reshape(B, S, RET_HEADS, RET_V_DIM)
    o = rmsnorm(o, norm_g.reshape(RET_HEADS, RET_V_DIM)).reshape(B, S, RET_V_TOTAL)
    o = (jax.nn.silu(g.astype(F32)) * o).astype(h.dtype)
    return o @ w_out


def hier_moe(h, w_rg, w_re, w_gate, w_up, w_down):
    N, D = h.shape
    E = N_EXPERTS
    g_logits = (h @ w_rg).astype(F32)
    grp = jnp.argmax(g_logits, axis=-1)
    p_grp = jnp.take_along_axis(jax.nn.softmax(g_logits, axis=-1), grp[:, None], axis=1)
    e_logits = (h @ w_re).astype(F32).reshape(N, MOE_GROUPS, MOE_EXPERTS_PER_GROUP)
    e_in = jnp.take_along_axis(e_logits, grp[:, None, None], axis=1)[:, 0]
    top_v, top_i = lax.top_k(e_in, MOE_TOPK)
    gate = (p_grp * jax.nn.softmax(top_v, axis=-1)).reshape(-1)
    eid = (grp[:, None] * MOE_EXPERTS_PER_GROUP + top_i).reshape(-1).astype(jnp.int32)
    tok = jnp.repeat(jnp.arange(N, dtype=jnp.int32), MOE_TOPK)
    A = N * MOE_TOPK
    order = jnp.argsort(eid)
    eid_s = eid[order]
    tok_s = tok[order]
    gate_s = gate[order]
    counts = jnp.zeros((E,), jnp.int32).at[eid].add(1)
    start = jnp.cumsum(counts) - counts
    padded = (counts + MOE_BLOCK - 1) // MOE_BLOCK * MOE_BLOCK
    pad_end = jnp.cumsum(padded)
    pad_start = pad_end - padded
    dest = pad_start[eid_s] + jnp.arange(A, dtype=jnp.int32) - start[eid_s]
    P = (-(-A // MOE_BLOCK) + E) * MOE_BLOCK
    nblk = P // MOE_BLOCK
    slot_tok = jnp.zeros((P,), jnp.int32).at[dest].set(tok_s)
    slot_gate = jnp.zeros((P,), F32).at[dest].set(gate_s)
    blk_expert = jnp.minimum(
        jnp.searchsorted(pad_end, jnp.arange(nblk, dtype=jnp.int32) * MOE_BLOCK, side='right'), E - 1)

    def expert_block(args):
        e, toks, gts = args
        xb = h[toks]
        hid = jax.nn.silu(xb @ w_gate[e]) * (xb @ w_up[e])
        return (hid @ w_down[e]) * gts.astype(h.dtype)[:, None]

    out = lax.map(expert_block, (blk_expert, slot_tok.reshape(nblk, MOE_BLOCK),
                                 slot_gate.reshape(nblk, MOE_BLOCK)))
    return jnp.zeros((N, D), h.dtype).at[slot_tok].add(out.reshape(P, D))


def setup_inputs(seed: int = 0) -> dict:
    key = jax.random.key(seed)
    ks = jax.random.split(key, 22)
    ne = (DEPTH + 1) // 2
    no = DEPTH // 2
    D = D_MODEL
    nrm = jax.random.normal
    x = nrm(ks[0], (BATCH, SEQ, D), F32)
    positions = jnp.broadcast_to(jnp.arange(SEQ, dtype=jnp.int32), (BATCH, SEQ))
    mix_norm = 1.0 + 0.05 * nrm(ks[1], (DEPTH, D), F32)
    ffn_norm = 1.0 + 0.05 * nrm(ks[2], (DEPTH, D), F32)
    hyb_w_in = nrm(ks[3], (ne, D, HYB_IN), F32) * D ** -0.5
    attn_q_norm = 1.0 + 0.05 * nrm(ks[4], (ne, ATTN_HEAD_DIM), F32)
    attn_k_norm = 1.0 + 0.05 * nrm(ks[5], (ne, ATTN_HEAD_DIM), F32)
    idx_k_norm = 1.0 + 0.05 * nrm(ks[6], (ne, IDX_HEAD_DIM), F32)
    ssm_conv_w = nrm(ks[7], (ne, SSM_CONV, SSM_CONV_DIM), F32) * SSM_CONV ** -0.5
    ssm_conv_b = 0.02 * nrm(ks[8], (ne, SSM_CONV_DIM), F32)
    dt0 = jnp.exp(jax.random.uniform(ks[9], (ne, SSM_HEADS), F32, math.log(1e-3), math.log(1e-1)))
    ssm_dt_bias = dt0 + jnp.log(-jnp.expm1(-dt0))
    ssm_a_log = jnp.log(jax.random.uniform(ks[10], (ne, SSM_HEADS), F32, 1.0, 16.0))
    ssm_d = 1.0 + 0.1 * nrm(ks[11], (ne, SSM_HEADS), F32)
    ssm_norm = 1.0 + 0.05 * nrm(ks[12], (ne, SSM_INNER), F32)
    hyb_w_out = nrm(ks[13], (ne, HYB_MIX, D), F32) * HYB_MIX ** -0.5
    ret_w_in = nrm(ks[14], (no, D, RET_IN), F32) * D ** -0.5
    ret_norm = 1.0 + 0.05 * nrm(ks[15], (no, RET_V_TOTAL), F32)
    ret_w_out = nrm(ks[16], (no, RET_V_TOTAL, D), F32) * RET_V_TOTAL ** -0.5
    moe_router_group = nrm(ks[17], (DEPTH, D, MOE_GROUPS), F32) * D ** -0.5
    moe_router_expert = nrm(ks[18], (DEPTH, D, N_EXPERTS), F32) * D ** -0.5
    moe_w_gate = nrm(ks[19], (DEPTH, N_EXPERTS, D, EXPERT_FF), F32) * D ** -0.5
    moe_w_up = nrm(ks[20], (DEPTH, N_EXPERTS, D, EXPERT_FF), F32) * D ** -0.5
    moe_w_down = nrm(ks[21], (DEPTH, N_EXPERTS, EXPERT_FF, D), F32) * EXPERT_FF ** -0.5
    return {"x": x, "positions": positions, "mix_norm": mix_norm, "ffn_norm": ffn_norm,
            "hyb_w_in": hyb_w_in, "attn_q_norm": attn_q_norm, "attn_k_norm": attn_k_norm,
            "idx_k_norm": idx_k_norm, "ssm_conv_w": ssm_conv_w, "ssm_conv_b": ssm_conv_b,
            "ssm_dt_bias": ssm_dt_bias, "ssm_a_log": ssm_a_log, "ssm_d": ssm_d,
            "ssm_norm": ssm_norm, "hyb_w_out": hyb_w_out, "ret_w_in": ret_w_in,
            "ret_norm": ret_norm, "ret_w_out": ret_w_out,
            "moe_router_group": moe_router_group, "moe_router_expert": moe_router_expert,
            "moe_w_gate": moe_w_gate, "moe_w_up": moe_w_up, "moe_w_down": moe_w_down}


def reference(x, positions, mix_norm, ffn_norm, hyb_w_in, attn_q_norm, attn_k_norm,
              idx_k_norm, ssm_conv_w, ssm_conv_b, ssm_dt_bias, ssm_a_log, ssm_d,
              ssm_norm, hyb_w_out, ret_w_in, ret_norm, ret_w_out,
              moe_router_group, moe_router_expert, moe_w_gate, moe_w_up, moe_w_down):
    B, S, D = x.shape
    k_sel = min(TOPK_MAX, S // 4)
    for layer in range(DEPTH):
        i = layer // 2
        h = rmsnorm(x, mix_norm[layer])
        if layer % 2 == 0:
            mix = hybrid_attn_ssm(h, positions, hyb_w_in[i], attn_q_norm[i], attn_k_norm[i],
                                  idx_k_norm[i], ssm_conv_w[i], ssm_conv_b[i], ssm_dt_bias[i],
                                  ssm_a_log[i], ssm_d[i], ssm_norm[i], hyb_w_out[i], k_sel)
        else:
            mix = retention(h, positions, ret_w_in[i], ret_norm[i], ret_w_out[i])
        x = x + mix
        h = rmsnorm(x, ffn_norm[layer]).reshape(B * S, D)
        x = x + hier_moe(h, moe_router_group[layer], moe_router_expert[layer],
                         moe_w_gate[layer], moe_w_up[layer], moe_w_down[layer]).reshape(B, S, D)
    return x
```

```cpp
#include <hip/hip_runtime.h>
#include <stdint.h>
#include <stdio.h>

#ifndef MX_OUT1
#define MX_OUT1 2
#endif
#ifndef FP8_OUT0
#define FP8_OUT0 0
#endif
#ifndef VG_FP8
#define VG_FP8 0
#endif
#ifndef MX_GU
#define MX_GU 2
#endif
#ifndef MX_DOWN
#define MX_DOWN 2
#endif
#ifndef REPEAT_GROUP
#define REPEAT_GROUP 0
#endif
#ifndef N_LAUNCH_MODE
#define N_LAUNCH_MODE 1
#endif

typedef unsigned short bf16_t;
typedef short bf16x8 __attribute__((ext_vector_type(8)));
typedef float f32x4 __attribute__((ext_vector_type(4)));
typedef float f32x2 __attribute__((ext_vector_type(2)));
typedef unsigned u32x2 __attribute__((ext_vector_type(2)));
typedef unsigned u32x4 __attribute__((ext_vector_type(4)));
#define DEV __device__ __forceinline__
#define LAS __attribute__((address_space(3)))
__device__ __forceinline__ int tid_opaque() { int t = threadIdx.x; asm volatile("" : "+v"(t)); return t; }
#define TIDX tid_opaque()

constexpr int NTOK = 16384, SEQ = 8192, DM = 2048, NBLK = 512  ;
constexpr int LD0 = 4864;
constexpr int LD1 = 12288;
constexpr float EPS = 1e-6f;
constexpr int LDS_BYTES = 160 * 1024;

constexpr size_t OFF_CTL   = 0;
constexpr size_t OFF_WIN0  = 65536;
constexpr size_t OFF_WOUT0 = OFF_WIN0  + (size_t)4864 * 2048 * 2;
constexpr size_t OFF_WIN1  = OFF_WOUT0 + (size_t)2048 * 2048 * 2;
constexpr size_t OFF_WOUT1 = OFF_WIN1  + (size_t)12288 * 2048 * 2;
constexpr size_t OFF_WGU   = OFF_WOUT1 + (size_t)2048 * 4096 * 2;
constexpr size_t OFF_WD    = OFF_WGU   + (size_t)2 * 64 * 1024 * 2048 * 2;
constexpr size_t OFF_WRT   = OFF_WD    + (size_t)2 * 64 * 2048 * 512 * 2;
constexpr size_t OFF_H     = OFF_WRT   + (size_t)2 * 1024 * 1024;
constexpr size_t OFF_Z     = OFF_H     + (size_t)NTOK * 2048 * 2;
constexpr size_t OFF_HID   = OFF_Z;
constexpr size_t OFF_Y     = OFF_Z + (size_t)64 * 1024 * 1024;
constexpr size_t OFF_MIX   = OFF_Z     + (size_t)NTOK * 12288 * 2;
constexpr size_t OFF_L0    = OFF_MIX   + (size_t)NTOK * 4096 * 2;
constexpr size_t OFF_ZS    = OFF_L0;
constexpr size_t OFF_QA    = OFF_ZS    + (size_t)NTOK * 256 * 4;
constexpr size_t OFF_KV    = OFF_QA    + (size_t)NTOK * 1024 * 2;
constexpr size_t OFF_QIA   = OFF_KV    + (size_t)NTOK * 512 * 2;
constexpr size_t OFF_KIA   = OFF_QIA   + (size_t)NTOK * 512 * 2;
constexpr size_t OFF_WIS   = OFF_KIA   + (size_t)NTOK * 64 * 2;
constexpr size_t OFF_DT    = OFF_WIS   + (size_t)NTOK * 8 * 4;
constexpr size_t OFF_XC    = OFF_DT    + (size_t)NTOK * 16 * 4;
constexpr size_t OFF_ST    = OFF_XC    + (size_t)NTOK * 1536 * 2;
constexpr size_t OFF_PREV  = OFF_ST    + (size_t)2 * 64 * 16 * 64 * 128 * 4;
constexpr size_t OFF_CD    = OFF_PREV  + (size_t)2 * 64 * 16 * 64 * 128 * 2;
constexpr size_t OFF_SELG  = OFF_CD    + 65536;
constexpr size_t L0_END    = OFF_SELG  + (size_t)NTOK * 256 * 2;
constexpr size_t OFF_KVLOC = OFF_L0;
constexpr size_t KVLOC_END = OFF_KVLOC + (size_t)1024 * 512 * 256 * 2;
constexpr size_t OFF_MOE   = (L0_END > KVLOC_END ? L0_END : KVLOC_END);
constexpr size_t OFF_LIST  = OFF_MOE;
constexpr size_t OFF_GATE  = OFF_LIST  + (size_t)2 * 64 * 16384 * 4;
constexpr size_t OFF_RSTD  = OFF_GATE  + (size_t)2 * 32768 * 4;
constexpr size_t OFF_ROPE  = OFF_RSTD  + (size_t)NTOK * 4;
constexpr size_t OFF_TSLOT = OFF_ROPE  + (size_t)NTOK * 256 * 4;
constexpr size_t WS_TOTAL  = OFF_TSLOT + (size_t)32768 * 4;
constexpr int CW_BAR = 0;
constexpr int CW_CNT = 4096;
constexpr int CW_PREPQ = 4224;
constexpr int CW_DSAQ = 4352;

struct Params {
    const float* x; const int* pos; const float* mix_norm; const float* ffn_norm; const float* hyb_w_in; const float* q_norm; const float* k_norm;
    const float* kidx_norm; const float* conv_w; const float* conv_b; const float* dt_bias; const float* a_log; const float* ssm_d; const float* ssm_norm;
    const float* hyb_w_out; const float* ret_w_in; const float* ret_norm; const float* ret_w_out; const float* w_rg; const float* w_re;
    const float* w_gate; const float* w_up; const float* w_down;
    float* out; unsigned char* ws; int ph_lo, ph_hi;
};

DEV float bf2f(bf16_t v) { return __uint_as_float(((unsigned)v) << 16); }
typedef __bf16 bf16x2_t __attribute__((ext_vector_type(2)));
DEV unsigned pk_bf16(float lo, float hi) { f32x2 v = {lo, hi}; bf16x2_t r = __builtin_convertvector(v, bf16x2_t); return __builtin_bit_cast(unsigned, r); }
DEV bf16_t f2bf(float v) { return (bf16_t)(pk_bf16(v, 0.f) & 0xffffu); }
DEV unsigned pk4_fp8(float a, float b, float c, float d) { int r = 0; r = __builtin_amdgcn_cvt_pk_fp8_f32(a, b, r, false); r = __builtin_amdgcn_cvt_pk_fp8_f32(c, d, r, true); return (unsigned)r; }
typedef int i32x8 __attribute__((ext_vector_type(8)));
DEV bf16x8 fp8x8_to_bf16(u32x2 w);
DEV f32x4 up4_fp8(unsigned w) { const f32x2 lo = __builtin_amdgcn_cvt_pk_f32_fp8((int)w, false), hi = __builtin_amdgcn_cvt_pk_f32_fp8((int)w, true); return (f32x4){lo.x, lo.y, hi.x, hi.y}; }
DEV bf16x8 fp8x8_to_bf16(u32x2 w) { const f32x4 a = up4_fp8(w.x), b = up4_fp8(w.y); u32x4 r; r.x = pk_bf16(a.x, a.y); r.y = pk_bf16(a.z, a.w); r.z = pk_bf16(b.x, b.y); r.w = pk_bf16(b.z, b.w); return __builtin_bit_cast(bf16x8, r); }
DEV float bflo(unsigned w) { return __uint_as_float(w << 16); }
DEV float bfhi(unsigned w) { return __uint_as_float(w & 0xffff0000u); }
DEV float wave_sum(float v) { v += __shfl_xor(v, 32); v += __shfl_xor(v, 16); v += __shfl_xor(v, 8); v += __shfl_xor(v, 4); v += __shfl_xor(v, 2); v += __shfl_xor(v, 1); return v; }
DEV float wave_max(float v) { v = fmaxf(v, __shfl_xor(v, 32)); v = fmaxf(v, __shfl_xor(v, 16)); v = fmaxf(v, __shfl_xor(v, 8)); v = fmaxf(v, __shfl_xor(v, 4)); v = fmaxf(v, __shfl_xor(v, 2)); v = fmaxf(v, __shfl_xor(v, 1)); return v; }
DEV float siluf(float v) { return v * __builtin_amdgcn_rcpf(1.f + __expf(-v)); }
DEV f32x4 mfma16(bf16x8 a, bf16x8 b, f32x4 c) { return __builtin_amdgcn_mfma_f32_16x16x32_bf16(a, b, c, 0, 0, 0); }
#define WAIT_VM0() asm volatile("s_waitcnt vmcnt(0)" ::: "memory")

extern __shared__ __attribute__((aligned(16))) unsigned char g_lds[];

#define XB_TMO      128
#define XB_XCNT(j)  (256  + 64 * (j))
#define XB_XSUB(j)  (1280 + 64 * (j))
#define XB_XGEN(j)  (2304 + 64 * (j))
#define XB_TOP      3328
#define XB_TOPGEN   3392
#define XCD_BAR_WORDS 3456
#define XB_SPIN_CAP (1u << 18)
__device__ __forceinline__ unsigned xb_ld(unsigned* p)              { return __hip_atomic_load(p, __ATOMIC_RELAXED, __HIP_MEMORY_SCOPE_AGENT); }
__device__ __forceinline__ unsigned xb_add(unsigned* p, unsigned v) { return __hip_atomic_fetch_add(p, v, __ATOMIC_RELAXED, __HIP_MEMORY_SCOPE_AGENT); }
__device__ __forceinline__ unsigned xb_xcc_id() { return (unsigned)__builtin_amdgcn_s_getreg((3 << 11) | 20) & 0xFu; }
#define XB_SPIN(cond, bar) do { unsigned _sp = 0; while (cond) { __builtin_amdgcn_s_sleep(1); \
    if ((++_sp & 255u) == 0u) { if (xb_ld(&(bar)[XB_TMO])) break; if (_sp > XB_SPIN_CAP) { atomicAdd(&(bar)[XB_TMO], 1u); break; } } } } while (0)
struct XcdBarrier { unsigned* bar; unsigned x; volatile LAS unsigned* st; };
__device__ __forceinline__ XcdBarrier xcd_barrier_post(unsigned* bar, volatile LAS unsigned* st) {
    XcdBarrier b; b.bar = bar; b.x = xb_xcc_id(); b.st = st;
    if (TIDX == 0) (void)xb_add(&bar[XB_XCNT(b.x)], 1u);
    return b;
}
__device__ __forceinline__ void xcd_barrier_complete(unsigned* bar, unsigned x, unsigned& nloc, unsigned& nx) {
    const unsigned G = gridDim.x * gridDim.y * gridDim.z;
    unsigned sum, cnt, mine, sp = 0u;
    for (;;) {
        sum = 0u; cnt = 0u; mine = 0u;
#pragma unroll
        for (unsigned j = 0; j < 16; ++j) { const unsigned c = xb_ld(&bar[XB_XCNT(j)]); sum += c; cnt += (c > 0u) ? 1u : 0u; mine = (j == x) ? c : mine; }
        if (sum == G) break;
        __builtin_amdgcn_s_sleep(1);
        if ((++sp & 255u) == 0u) { if (xb_ld(&bar[XB_TMO])) break; if (sp > XB_SPIN_CAP) { atomicAdd(&bar[XB_TMO], 1u); break; } }
    }
    nloc = mine > 0u ? mine : 1u; nx = cnt > 0u ? cnt : 1u;
}
__device__ __forceinline__ void xcd_barrier(const XcdBarrier& b) {
    asm volatile("s_waitcnt vmcnt(0)" ::: "memory");
    __syncthreads();
    if (TIDX == 0) {
        unsigned* bar = b.bar;
        __builtin_amdgcn_s_waitcnt(0);
        unsigned nloc = b.st[0], nx = b.st[1];
        if (nloc == 0u) { xcd_barrier_complete(bar, b.x, nloc, nx); b.st[0] = nloc; b.st[1] = nx; }
        const unsigned old = xb_add(&bar[XB_XSUB(b.x)], 1u);
        const unsigned gen = old / nloc;
        if (old + 1u == (gen + 1u) * nloc) {
            __builtin_amdgcn_fence(__ATOMIC_RELEASE, "agent");
            asm volatile("s_waitcnt vmcnt(0)" ::: "memory");
            const unsigned og = xb_add(&bar[XB_TOP], 1u);
            const unsigned tg = og / nx;
            if (og + 1u == (tg + 1u) * nx) xb_add(&bar[XB_TOPGEN], 1u);
            else XB_SPIN(xb_ld(&bar[XB_TOPGEN]) == tg, bar);
            __builtin_amdgcn_fence(__ATOMIC_ACQUIRE, "agent");
            xb_add(&bar[XB_XGEN(b.x)], 1u);
            asm volatile("s_waitcnt vmcnt(0)" ::: "memory");
        } else {
            XB_SPIN(xb_ld(&bar[XB_XGEN(b.x)]) == gen, bar);
            __builtin_amdgcn_fence(__ATOMIC_ACQUIRE, "agent");
            asm volatile("s_waitcnt vmcnt(0)" ::: "memory");
        }
    }
    __syncthreads();
}

DEV void st8(bf16_t* p, const float (&v)[8]);
struct ConvJob { const float* src; int ldsrc; bf16_t* dst; int K; float f8scale; };
template <class ColPtr>
DEV ConvJob conv_job(ColPtr cp, int ldsrc, bf16_t* dst, int K, int n0, int k0) {
    const int tid = TIDX, wid = tid >> 6, lane = tid & 63, r = tid >> 2, kq = tid & 3;
    const float* c = cp(n0 + 4 * lane);
    ConvJob j; j.src = c ? c + (size_t)(k0 + wid * 8) * ldsrc : nullptr; j.ldsrc = ldsrc; j.dst = dst + (size_t)(n0 + r) * K + k0 + kq * 16; j.K = K; j.f8scale = 0.f; return j;
}
template <class ColPtr>
DEV ConvJob conv_job8(ColPtr cp, int ldsrc, unsigned char* dst8, int K, int n0, int k0, float scale) {
    ConvJob j = conv_job(cp, ldsrc, (bf16_t*)nullptr, K, n0, k0);
    const int tid = TIDX, r = tid >> 2, kq = tid & 3;
    j.dst = (bf16_t*)(dst8 + (size_t)(n0 + r) * K + k0 + kq * 16); j.f8scale = scale; return j;
}
DEV void conv_load(const ConvJob& j, f32x4 (&v)[8]) {
#pragma unroll
    for (int i = 0; i < 8; ++i) v[i] = j.src ? __builtin_nontemporal_load((const f32x4*)(j.src + (size_t)i * j.ldsrc)) : (f32x4){0.f, 0.f, 0.f, 0.f};
}
DEV void conv_finish(const ConvJob& j, const f32x4 (&v)[8]) {
    unsigned char* tile = g_lds;
    const int tid = TIDX, wid = tid >> 6, lane = tid & 63, kq = tid & 3;
    if (j.f8scale != 0.f) {
        const float sc = j.f8scale;
#pragma unroll
        for (int c = 0; c < 4; ++c) {
            u32x2 w; w.x = pk4_fp8(v[0][c] * sc, v[1][c] * sc, v[2][c] * sc, v[3][c] * sc); w.y = pk4_fp8(v[4][c] * sc, v[5][c] * sc, v[6][c] * sc, v[7][c] * sc);
            *(u32x2*)(tile + (4 * lane + c) * 64 + ((wid ^ (lane & 7)) * 8)) = w;
        }
        __syncthreads();
#pragma unroll
        for (int ps = 0; ps < 2; ++ps) {
            const int r = (tid >> 2) + ps * 128, sw = (r >> 2) & 7;
            const u32x2 a = *(const u32x2*)(tile + r * 64 + (((2 * kq) ^ sw) * 8)), b = *(const u32x2*)(tile + r * 64 + (((2 * kq + 1) ^ sw) * 8));
            u32x4 w8; w8.x = a.x; w8.y = a.y; w8.z = b.x; w8.w = b.y;
            *(u32x4*)((unsigned char*)j.dst + (size_t)(ps * 128) * j.K) = w8;
        }
    } else {
#pragma unroll
        for (int c = 0; c < 4; ++c) {
            u32x4 w; w.x = pk_bf16(v[0][c], v[1][c]); w.y = pk_bf16(v[2][c], v[3][c]); w.z = pk_bf16(v[4][c], v[5][c]); w.w = pk_bf16(v[6][c], v[7][c]);
            *(u32x4*)(tile + (4 * lane + c) * 128 + ((wid ^ (lane & 7)) * 16)) = w;
        }
        __syncthreads();
#pragma unroll
        for (int ps = 0; ps < 2; ++ps) {
            const int r = (tid >> 2) + ps * 128, sw = (r >> 2) & 7;
            const u32x4 w0 = *(const u32x4*)(tile + r * 128 + (((2 * kq) ^ sw) * 16)), w1 = *(const u32x4*)(tile + r * 128 + (((2 * kq + 1) ^ sw) * 16));
            bf16_t* d = j.dst + (size_t)(ps * 128) * j.K;
            *(u32x4*)d = w0; *(u32x4*)(d + 8) = w1;
        }
    }
    __syncthreads();
}
struct CpPlain { const float* base; int ncols; DEV const float* operator()(int n) const { return n < ncols ? base + n : nullptr; } };
struct CpWin0 { const float* base; DEV const float* operator()(int n) const {
    int c;
    if (n < 2048) c = n; else if (n < 3072) c = 2120 + (n - 2048); else if (n < 4608) c = 3144 + (n - 3072);
    else if (n < 4672) c = 2048 + (n - 4608); else if (n < 4680) c = 2112 + (n - 4672); else if (n < 4696) c = n; else return nullptr;
    return base + c; } };
struct CpGU { const float* g; const float* u; DEV const float* operator()(int n) const {
    const int t = n >> 8, r = n & 255; return (r < 128) ? g + t * 128 + r : u + t * 128 + (r - 128); } };

constexpr int PREP_J0 = 19 * 32;
constexpr int GEMM_CUS = 152;
DEV void ph_prep(const Params& p, int vb, int nvb, int part) {
    unsigned char* ws = p.ws;
    if (part == 0 && vb == 0 && TIDX < 128) ((unsigned*)(ws + OFF_CTL))[CW_CNT + TIDX] = 0u;
    if (part == 1) {
        bf16_t* wrb = (bf16_t*)(ws + OFF_WRT);
        for (int i = vb * NBLK + TIDX; i < 2 * 64 * 5 * 64; i += nvb * NBLK) {
            const int l = i / 20480, rem = i % 20480, ks = rem / 320, nt = (rem / 64) % 5, ln = rem & 63;
            const int k0 = ks * 32 + (ln >> 4) * 8, n = nt * 16 + (ln & 15);
            float hi[8], lo[8];
#pragma unroll
            for (int e = 0; e < 8; ++e) {
                const int k = k0 + e; float w = 0.f;
                if (n < 8) w = p.w_rg[((size_t)l * 2048 + k) * 8 + n]; else if (n < 72) w = p.w_re[((size_t)l * 2048 + k) * 64 + (n - 8)];
                w *= p.ffn_norm[l * 2048 + k];
                const float h = bf2f(f2bf(w)); hi[e] = h; lo[e] = w - h;
            }
            bf16_t* d = wrb + (size_t)l * 327680 + ((size_t)(ks * 2) * 5 + nt) * 512 + ln * 8;
            st8(d, hi); st8(d + 5 * 512, lo);
        }
    }
    if (part == 1) {
        float* tbl = (float*)(ws + OFF_ROPE);
        for (int i = vb * NBLK + TIDX; i < NTOK * 128; i += nvb * NBLK) {
            const int tok = i >> 7, fi = i & 127;
            float sn, cs; sincosf((float)p.pos[tok] * exp2f(-(float)fi * (1.f / 128.f) * 13.287712379549449f), &sn, &cs);
            tbl[(size_t)tok * 256 + fi] = cs; tbl[(size_t)tok * 256 + 128 + fi] = sn;
        }
    }
    constexpr int J0 = 19 * 32, J1 = 8 * 32, J2 = 48 * 32, J3 = 8 * 64, J4 = 128 * 128, J5 = 128 * 64;
    constexpr int JT = J0 + J1 + J2 + J3 + J4 + J5;
    auto decode = [&](int job) -> ConvJob {
        int j = job;
        if (j < J0) return conv_job(CpWin0{p.hyb_w_in}, 4696, (bf16_t*)(ws + OFF_WIN0), 2048, (j / 32) * 256, (j % 32) * 64);
        j -= J0;
        if (j < J1) { if (FP8_OUT0) return conv_job8(CpPlain{p.hyb_w_out, 2048}, 2048, ws + OFF_WOUT0, 2048, (j / 32) * 256, (j % 32) * 64, 64.f);
                      return conv_job(CpPlain{p.hyb_w_out, 2048}, 2048, (bf16_t*)(ws + OFF_WOUT0), 2048, (j / 32) * 256, (j % 32) * 64); }
        j -= J1;
        if (j < J2) { const int ntile = j / 32;
            if (ntile < 16) return conv_job(CpPlain{p.ret_w_in, 12288}, 12288, (bf16_t*)(ws + OFF_WIN1), 2048, ntile * 256, (j % 32) * 64);
            return conv_job8(CpPlain{p.ret_w_in + 4096, 8192}, 12288, ws + OFF_WIN1 + (size_t)4096 * 2048 * 2, 2048, (ntile - 16) * 256, (j % 32) * 64, 64.f); }
        j -= J2;
        if (j < J3) return conv_job8(CpPlain{p.ret_w_out, 2048}, 2048, ws + OFF_WOUT1, 4096, (j / 64) * 256, (j % 64) * 64, 64.f);
        j -= J3;
        if (j < J4) { const int le = j / 128, t = j % 128;
            return conv_job8(CpGU{p.w_gate + (size_t)le * 2048 * 512, p.w_up + (size_t)le * 2048 * 512}, 512, ws + OFF_WGU + (size_t)le * 1024 * 2048, 2048, (t / 32) * 256, (t % 32) * 64, 32.f); }
        j -= J4;
        { const int le = j / 64, t = j % 64;
            return conv_job8(CpPlain{p.w_down + (size_t)le * 512 * 2048, 2048}, 2048, ws + OFF_WD + (size_t)le * 2048 * 512, 512, (t / 8) * 256, (t % 8) * 64, 16.f); }
    };
    static_assert(J0 == PREP_J0, "part split");
    const int jlo = part == 0 ? 0 : J0, jhi = part == 0 ? J0 : JT;
    if (part == 0) {
        if (jlo + vb < jhi) {
            ConvJob cj = decode(jlo + vb), c1 = cj, c2 = cj; f32x4 va[8], v1[8], v2[8]; conv_load(cj, va);
            if (jlo + vb + nvb < jhi) { c1 = decode(jlo + vb + nvb); conv_load(c1, v1); }
            for (int job = jlo + vb; job < jhi; job += nvb) {
                const int nj2 = job + 2 * nvb;
                if (nj2 < jhi) { c2 = decode(nj2); conv_load(c2, v2); }
                conv_finish(cj, va);
                cj = c1; c1 = c2;
#pragma unroll
                for (int i = 0; i < 8; ++i) { va[i] = v1[i]; v1[i] = v2[i]; }
            }
        }
    } else {
        unsigned* qhead = (unsigned*)(ws + OFF_CTL) + CW_PREPQ; volatile int* ring = (volatile int*)(g_lds + 40 * 1024);
        __syncthreads();
        if (TIDX == 0) { ring[0] = jlo + (int)atomicAdd(qhead, 1u); ring[1] = jlo + (int)atomicAdd(qhead, 1u); ring[2] = jlo + (int)atomicAdd(qhead, 1u); }
        __syncthreads();
        int job = ring[0], j1 = ring[1];
        if (job < jhi) {
            ConvJob cj = decode(job), c1 = cj, c2 = cj; f32x4 va[8], v1[8], v2[8]; conv_load(cj, va);
            if (j1 < jhi) { c1 = decode(j1); conv_load(c1, v1); }
            for (int it = 0; job < jhi; ++it) {
                if (TIDX == 0) ring[(it + 3) & 3] = jlo + (int)atomicAdd(qhead, 1u);
                const int j2 = ring[(it + 2) & 3];
                if (j2 < jhi) { c2 = decode(j2); conv_load(c2, v2); }
                conv_finish(cj, va);
                cj = c1; c1 = c2; job = j1; j1 = j2;
#pragma unroll
                for (int i = 0; i < 8; ++i) { va[i] = v1[i]; v1[i] = v2[i]; }
            }
        }
    }
}

DEV void ph_norm(const float* x, const float* g, bf16_t* H, int vb, int nvb) {
    const int wave = TIDX >> 6, lane = TIDX & 63;
    for (int row = vb * 8 + wave; row < NTOK; row += nvb * 8) {
        const f32x4* xr = (const f32x4*)(x + (size_t)row * DM);
        f32x4 v[8]; float ss = 0.f;
#pragma unroll
        for (int i = 0; i < 8; ++i) { v[i] = xr[i * 64 + lane]; ss += v[i].x * v[i].x + v[i].y * v[i].y + v[i].z * v[i].z + v[i].w * v[i].w; }
        ss = wave_sum(ss);
        const float r = rsqrtf(ss * (1.f / DM) + EPS);
#pragma unroll
        for (int i = 0; i < 8; ++i) {
            const f32x4 g4 = ((const f32x4*)g)[i * 64 + lane];
            u32x2 w; w.x = pk_bf16(v[i].x * r * g4.x, v[i].y * r * g4.y); w.y = pk_bf16(v[i].z * r * g4.z, v[i].w * r * g4.w);
            *(u32x2*)(H + (size_t)row * DM + (i * 64 + lane) * 4) = w;
        }
    }
}

constexpr int GEMM_ROWOFF = 48 * 1024;
template <int BM, int BN>
DEV void gemm_core(const bf16_t* __restrict__ A, const bf16_t* __restrict__ Bt, int ldb, int bcol, int K, f32x4 (&acc)[BM / 32][BN / 64]) {
    constexpr int TM = BM / 32, TN = BN / 64;
    unsigned char* SA = g_lds; unsigned char* SB = g_lds + BM * 64;
    const unsigned* rowoff = (const unsigned*)(g_lds + GEMM_ROWOFF);
    const int tid = TIDX, wid = tid >> 6, lane = tid & 63, wr = wid >> 2, wc = wid & 3, fr = lane & 15, fq = lane >> 4;
#pragma unroll
    for (int m = 0; m < TM; ++m)
#pragma unroll
        for (int n = 0; n < TN; ++n) acc[m][n] = (f32x4){0.f, 0.f, 0.f, 0.f};
    for (int kt = 0; kt < K / 32; ++kt) {
#pragma unroll
        for (int i = 0; i < BM * 4 / NBLK; ++i) { const int c = tid + i * NBLK, r = c >> 2, q = c & 3;
            __builtin_amdgcn_global_load_lds((const unsigned*)(A + rowoff[r] + kt * 32 + q * 8), (LAS unsigned*)(SA + c * 16), 16, 0, 0); }
#pragma unroll
        for (int i = 0; i < BN * 4 / NBLK; ++i) { const int c = tid + i * NBLK, r = c >> 2, q = c & 3;
            __builtin_amdgcn_global_load_lds((const unsigned*)(Bt + (size_t)(bcol + r) * ldb + kt * 32 + q * 8), (LAS unsigned*)(SB + c * 16), 16, 0, 0); }
        WAIT_VM0(); __syncthreads();
        bf16x8 af[TM], bfr[TN];
#pragma unroll
        for (int m = 0; m < TM; ++m) af[m] = *(const bf16x8*)(SA + (wr * (BM / 2) + m * 16 + fr) * 64 + fq * 16);
#pragma unroll
        for (int n = 0; n < TN; ++n) bfr[n] = *(const bf16x8*)(SB + (wc * (BN / 4) + n * 16 + fr) * 64 + fq * 16);
#pragma unroll
        for (int m = 0; m < TM; ++m)
#pragma unroll
            for (int n = 0; n < TN; ++n) acc[m][n] = mfma16(bfr[n], af[m], acc[m][n]);
        __syncthreads();
    }
}

template <class Epi>
DEV void ph_gemm_dense(const bf16_t* A, int lda, const bf16_t* Bt, int N, int K, Epi epi, int vb, int nvb) {
    const int nN = N / 256, nM = NTOK / 256, ntile = nM * nN;
    unsigned* rowoff = (unsigned*)(g_lds + GEMM_ROWOFF);
    const int tid = TIDX, wid = tid >> 6, lane = tid & 63, wr = wid >> 2, wc = wid & 3, fr = lane & 15, fq = lane >> 4;
    for (int t = vb; t < ntile; t += nvb) {
        const int pm = t % nM, pn = t / nM;
        __syncthreads();
        if (tid < 256) rowoff[tid] = (unsigned)((size_t)(pm * 256 + tid) * lda);
        __syncthreads();
        f32x4 acc[8][4];
        gemm_core<256, 256>(A, Bt, K, pn * 256, K, acc);
#pragma unroll
        for (int m = 0; m < 8; ++m)
#pragma unroll
            for (int n = 0; n < 4; ++n) epi(pm * 256 + wr * 128 + m * 16 + fr, pn * 256 + wc * 64 + n * 16 + fq * 4, acc[m][n]);
    }
}

struct EpiZ0 { bf16_t* Z; float* ZS; DEV void operator()(int row, int col, f32x4 v) const {
    u32x2 w; w.x = pk_bf16(v.x, v.y); w.y = pk_bf16(v.z, v.w);
    *(u32x2*)(Z + (size_t)row * LD0 + col) = w;
    if (col >= 4608) *(f32x4*)(ZS + (size_t)row * 256 + (col - 4608)) = v; } };
struct EpiBf { bf16_t* Z; int ld; DEV void operator()(int row, int col, f32x4 v) const {
    u32x2 w; w.x = pk_bf16(v.x, v.y); w.y = pk_bf16(v.z, v.w);
    *(u32x2*)(Z + (size_t)row * ld + col) = w; } };
struct EpiResid { const float* xin; float* xout; float scale; DEV void operator()(int row, int col, f32x4 v) const {
    const f32x4 r = *(const f32x4*)(xin + (size_t)row * DM + col);
    *(f32x4*)(xout + (size_t)row * DM + col) = r + v * scale; } };

namespace g8 {
typedef int i32x4_t __attribute__((ext_vector_type(4)));
constexpr int BK = 64, HALF = 128, HTB = HALF * BK * 2, STAGE_BYTES = 8 * HTB;
constexpr int GOFF_LDS = 156 * 1024;
DEV int lds_byte(int r, int c) { const int st = (r >> 4) * 2 + (c >> 5), rr = r & 15, cc = c & 31, ob = rr * 64 + cc * 2; return st * 1024 + (ob ^ (((ob >> 9) & 1) << 5)); }
DEV void stage_rc(int b, int& R, int& C) { const int st = b / 1024, sb = b % 1024, swz = sb ^ (((sb >> 9) & 1) << 5); R = (st >> 1) * 16 + swz / 64; C = (st & 1) * 32 + (swz % 64) / 2; }

template <bool GATHER, class Epi, class Sched, int FP8 = 0, int WSHIFT = 0>
DEV void gemm_phase(int K, const Sched& S, const Epi& E) {
    LAS unsigned char* lds = (LAS unsigned char*)g_lds;
    typedef typename Sched::Unit Unit;
    const int tid = TIDX, wid = __builtin_amdgcn_readfirstlane(tid >> 6), lane = tid & 63, wr = wid >> 2, wc = wid & 3, fr = lane & 15, fq = lane >> 4;
    const int rowB = FP8 ? K : 2 * K, nt = rowB / 128;
    int Rr[2], Cc[2]; unsigned voffB[2];
#pragma unroll
    for (int i = 0; i < 2; ++i) { stage_rc(tid * 16 + i * 8192, Rr[i], Cc[i]); voffB[i] = (unsigned)(Rr[i] * rowB + Cc[i] * 2); }
    const size_t kstep = (size_t)(BK * 2), hstep = (size_t)HALF * rowB, r64 = (size_t)64 * rowB;
    const unsigned ldsw = (unsigned)wid * 1024u;
    const int aoff = lds_byte(wr * 64 + fr, fq * 8), boff = lds_byte(wc * 32 + fr, fq * 8);
#define G8_SA(b, h) (((b) * 2 + (h)) * HTB)
#define G8_SB(b, h) ((4 + (b) * 2 + (h)) * HTB)
#define G8_STAGE(bufoff, gbase, voff) do { _Pragma("unroll") for (int _i = 0; _i < 2; ++_i) \
        __builtin_amdgcn_global_load_lds((const unsigned*)((const char*)(gbase) + (size_t)_i * r64 + (voff)[0]), (LAS unsigned*)(lds + (bufoff) + ldsw + _i * 8192), 16, 0, 0); } while (0)
#define G8_STAGE_A(bufoff, dptr, goffs, kb) do { if (GATHER) { _Pragma("unroll") for (int _i = 0; _i < 2; ++_i) \
        __builtin_amdgcn_global_load_lds((const unsigned*)((S.Abase() + (size_t)(kb)) + (RO[(goffs) + rr0 + 64 * _i] + cc0)), (LAS unsigned*)(lds + (bufoff) + ldsw + _i * 8192), 16, 0, 0); } \
        else G8_STAGE(bufoff, dptr, voffB); } while (0)
#define G8_LD2(dst, addr) do { const i32x4_t _lo = *(const LAS i32x4_t*)(addr), _hi = *(const LAS i32x4_t*)((addr) + 1024); dst = __builtin_shufflevector(_lo, _hi, 0, 1, 2, 3, 4, 5, 6, 7); } while (0)
#define G8_LDA(dst, b, h) do { _Pragma("unroll") for (int m = 0; m < 4; ++m) G8_LD2(dst[m], lds + G8_SA(b, h) + aoff + m * 2048); } while (0)
#define G8_LDB(dst, b, h) do { _Pragma("unroll") for (int n = 0; n < 2; ++n) G8_LD2(dst[n], lds + G8_SB(b, h) + boff + n * 2048); } while (0)
typedef int i32x2_t __attribute__((ext_vector_type(2)));
#define G8_Q0(x) __builtin_bit_cast(long, __builtin_shufflevector((x), (x), 0, 1))
#define G8_Q1(x) __builtin_bit_cast(long, __builtin_shufflevector((x), (x), 2, 3))
#define G8_Q2(x) __builtin_bit_cast(long, __builtin_shufflevector((x), (x), 4, 5))
#define G8_Q3(x) __builtin_bit_cast(long, __builtin_shufflevector((x), (x), 6, 7))
#define G8_LO(x) __builtin_bit_cast(bf16x8, __builtin_shufflevector((x), (x), 0, 1, 2, 3))
#define G8_HI(x) __builtin_bit_cast(bf16x8, __builtin_shufflevector((x), (x), 4, 5, 6, 7))
#define G8_MMA(ai, bj, At, Bt) do { __builtin_amdgcn_s_setprio(1); _Pragma("unroll") for (int m = 0; m < 4; ++m) _Pragma("unroll") for (int n = 0; n < 2; ++n) { \
        if (FP8 == 2) acc[ai][bj][m][n] = __builtin_amdgcn_mfma_scale_f32_16x16x128_f8f6f4(Bt[n], At[m], acc[ai][bj][m][n], 0, 0, 0, 0x01010101 * (127 - WSHIFT / 2), 0, 0x01010101 * (127 - WSHIFT / 2)); \
        else if (FP8) { acc[ai][bj][m][n] = __builtin_amdgcn_mfma_f32_16x16x32_fp8_fp8(G8_Q0(Bt[n]), G8_Q0(At[m]), acc[ai][bj][m][n], 0, 0, 0); \
                   acc[ai][bj][m][n] = __builtin_amdgcn_mfma_f32_16x16x32_fp8_fp8(G8_Q1(Bt[n]), G8_Q1(At[m]), acc[ai][bj][m][n], 0, 0, 0); \
                   acc[ai][bj][m][n] = __builtin_amdgcn_mfma_f32_16x16x32_fp8_fp8(G8_Q2(Bt[n]), G8_Q2(At[m]), acc[ai][bj][m][n], 0, 0, 0); \
                   acc[ai][bj][m][n] = __builtin_amdgcn_mfma_f32_16x16x32_fp8_fp8(G8_Q3(Bt[n]), G8_Q3(At[m]), acc[ai][bj][m][n], 0, 0, 0); } \
        else { acc[ai][bj][m][n] = __builtin_amdgcn_mfma_f32_16x16x32_bf16(G8_LO(Bt[n]), G8_LO(At[m]), acc[ai][bj][m][n], 0, 0, 0); \
               acc[ai][bj][m][n] = __builtin_amdgcn_mfma_f32_16x16x32_bf16(G8_HI(Bt[n]), G8_HI(At[m]), acc[ai][bj][m][n], 0, 0, 0); } } \
        __builtin_amdgcn_s_setprio(0); } while (0)
#define G8_WAIT_V(n) asm volatile("s_waitcnt vmcnt(" #n ")" ::: "memory")
#define G8_WAIT_L(n) asm volatile("s_waitcnt lgkmcnt(" #n ")" ::: "memory")
#define G8_BAR __builtin_amdgcn_s_barrier()
#define G8_SCHED __builtin_amdgcn_sched_barrier(0)
    Unit cur, nxt; int ui = 0;
    if (!S.next(0, cur)) return;
    f32x4 acc[2][2][4][2];
#pragma unroll
    for (int a = 0; a < 2; ++a)
#pragma unroll
        for (int b = 0; b < 2; ++b)
#pragma unroll
            for (int m = 0; m < 4; ++m)
#pragma unroll
                for (int n = 0; n < 2; ++n) acc[a][b][m][n] = (f32x4){0.f, 0.f, 0.f, 0.f};
    i32x8 At[4], B0[2], B1[2];
    const char* cA = GATHER ? nullptr : S.A0(cur); const char* cB = S.B0(cur);
    const unsigned* RO = (const unsigned*)(g_lds + GOFF_LDS);
    const int rr0 = Rr[0], cc0 = Cc[0] * 2;
    if (GATHER) { if (tid < 256) ((unsigned*)(g_lds + GOFF_LDS))[tid] = S.rowoff(cur, tid); __syncthreads(); }
    int gcur = 0;
    G8_STAGE(G8_SB(0, 0), cB, voffB); G8_STAGE_A(G8_SA(0, 0), cA, gcur, 0); G8_STAGE(G8_SB(0, 1), cB + hstep, voffB); G8_STAGE_A(G8_SA(0, 1), cA + hstep, gcur + 128, 0);
    if (wr == 1) G8_BAR;
    G8_WAIT_V(4); G8_BAR;
    G8_STAGE(G8_SB(1, 0), cB + kstep, voffB); G8_STAGE_A(G8_SA(1, 0), cA + kstep, gcur, kstep); G8_STAGE(G8_SB(1, 1), cB + hstep + kstep, voffB);
    G8_WAIT_V(6); G8_BAR;
    for (;;) {
        const bool has_next = S.next(ui + 1, nxt);
        const char* nA = (GATHER || !has_next) ? cA : S.A0(nxt); const char* nB = has_next ? S.B0(nxt) : cB;
        const int gnxt = has_next ? (gcur ^ 256) : gcur;
        if (GATHER && has_next && wid < 4) {
            int ln; asm volatile("v_mbcnt_lo_u32_b32 %0, -1, 0\n\tv_mbcnt_hi_u32_b32 %0, -1, %0" : "=v"(ln));
            const int t2 = wid * 64 + ln; ((unsigned*)(g_lds + GOFF_LDS))[gnxt + t2] = S.rowoff(nxt, t2); }
        for (int t = 0; t < nt; t += 2) {
            const bool last = (t == nt - 2);
            const char* a1 = cA + (size_t)(t + 1) * kstep;
            const char* a2 = last ? nA : cA + (size_t)(t + 2) * kstep; const char* b2 = last ? nB : cB + (size_t)(t + 2) * kstep;
            const char* a3 = a2 + kstep; const char* b3 = b2 + kstep;
            const size_t k1 = (size_t)(t + 1) * kstep, k2 = last ? 0 : (size_t)(t + 2) * kstep, k3 = k2 + kstep;
            const int g2 = last ? gnxt : gcur;
            G8_LDB(B0, 0, 0); G8_SCHED; G8_LDA(At, 0, 0); G8_STAGE_A(G8_SA(1, 1), a1 + hstep, gcur + 128, k1);
            G8_WAIT_L(8); G8_BAR; G8_WAIT_L(0); G8_MMA(0, 0, At, B0); G8_BAR; G8_SCHED;
            G8_LDB(B1, 0, 1); G8_STAGE(G8_SB(0, 0), b2, voffB);
            G8_BAR; G8_WAIT_L(0); G8_MMA(0, 1, At, B1); G8_BAR;
            G8_LDA(At, 0, 1); G8_STAGE_A(G8_SA(0, 0), a2, g2, k2);
            G8_BAR; G8_WAIT_L(0); G8_MMA(1, 0, At, B0); G8_BAR; G8_SCHED;
            G8_STAGE(G8_SB(0, 1), b2 + hstep, voffB);
            G8_WAIT_V(6); G8_BAR; G8_MMA(1, 1, At, B1); G8_BAR;
            G8_LDB(B0, 1, 0); G8_SCHED; G8_LDA(At, 1, 0); G8_STAGE_A(G8_SA(0, 1), a2 + hstep, g2 + 128, k2);
            G8_WAIT_L(8); G8_BAR; G8_WAIT_L(0); G8_MMA(0, 0, At, B0); G8_BAR; G8_SCHED;
            G8_LDB(B1, 1, 1); G8_STAGE(G8_SB(1, 0), b3, voffB);
            G8_BAR; G8_WAIT_L(0); G8_MMA(0, 1, At, B1); G8_BAR;
            G8_LDA(At, 1, 1); G8_STAGE_A(G8_SA(1, 0), a3, g2, k3);
            G8_BAR; G8_WAIT_L(0); G8_MMA(1, 0, At, B0); G8_BAR; G8_SCHED;
            G8_STAGE(G8_SB(1, 1), b3 + hstep, voffB);
            G8_WAIT_V(6); G8_BAR; G8_MMA(1, 1, At, B1); G8_BAR;
        }
        {
            int tz = TIDX; asm volatile("" : "+v"(tz));
            const int ewid = tz >> 6, elane = tz & 63;
            E(acc, cur, ewid >> 2, ewid & 3, elane & 15, elane >> 4);
        }
        if (!has_next) break;
#pragma unroll
        for (int a = 0; a < 2; ++a)
#pragma unroll
            for (int b = 0; b < 2; ++b)
#pragma unroll
                for (int m = 0; m < 4; ++m)
#pragma unroll
                    for (int n = 0; n < 2; ++n) acc[a][b][m][n] = (f32x4){0.f, 0.f, 0.f, 0.f};
        cur = nxt; cA = nA; cB = nB; ++ui; gcur = gnxt;
    }
    G8_WAIT_V(0);
    if (wr == 0) G8_BAR;
    G8_BAR;
#undef G8_SA
#undef G8_SB
#undef G8_STAGE
#undef G8_STAGE_A
#undef G8_LDA
#undef G8_LDB
#undef G8_MMA
#undef G8_LD2
#undef G8_LO
#undef G8_HI
#undef G8_WAIT_V
#undef G8_WAIT_L
#undef G8_BAR
#undef G8_SCHED
}

struct DenseSched {
    struct Unit { int pm, pn; };
    const bf16_t* A; const bf16_t* Bt; int K, nM, nN, nwg, G, c, rep, esz;
    DEV void init(const bf16_t* A_, const bf16_t* Bt_, int M, int N, int K_, int G_, int c_) { A = A_; Bt = Bt_; K = K_; nM = M / 256; nN = N / 256; nwg = nM * nN; G = G_; c = c_; rep = 1; esz = 2; }
    DEV bool next(int i, Unit& u) const {
        const int rounds = (nwg + G - 1) / G; if (i >= rounds * rep) return false;
        const long L = (long)(i % rounds) * G + c; if (L >= nwg) return false;
        int wgid = (int)L; { const int q = nwg / 8, r = nwg % 8, xcd = wgid % 8, off = wgid / 8; wgid = (xcd < r ? xcd * (q + 1) : r * (q + 1) + (xcd - r) * q) + off; }
        const int nig = 8 * nN, gid = wgid / nig, fm = gid * 8, gsz = (nM - fm) < 8 ? (nM - fm) : 8;
        u.pm = fm + ((wgid % nig) % gsz); u.pn = (wgid % nig) / gsz; return true;
    }
    DEV const char* A0(const Unit& u) const { return (const char*)A + (size_t)u.pm * 256 * K * esz; }
    DEV const char* B0(const Unit& u) const { return (const char*)Bt + (size_t)u.pn * 256 * K * esz; }
    DEV const char* Abase() const { return (const char*)A; }
    DEV bool half1(const Unit&) const { return true; }
    DEV unsigned rowoff(const Unit&, int) const { return 0u; }
};
template <class F> struct EpiEach { F f;
    DEV void operator()(const f32x4 (&acc)[2][2][4][2], const DenseSched::Unit& u, int wr, int wc, int fr, int fq) const {
#pragma unroll
        for (int ai = 0; ai < 2; ++ai)
#pragma unroll
            for (int m = 0; m < 4; ++m) {
#pragma unroll
                for (int bj = 0; bj < 2; ++bj)
#pragma unroll
                    for (int n = 0; n < 2; ++n) f(u.pm * 256 + ai * 128 + wr * 64 + m * 16 + fr, u.pn * 256 + bj * 128 + wc * 32 + n * 16 + fq * 4, acc[ai][bj][m][n]);
                __builtin_amdgcn_sched_barrier(0);
            }
    } };
constexpr int EPI_LDS = 136 * 1024, EPI_WAVE = 2560, EPI_PATCH = 1280;
template <int LD> struct EpiBfT { bf16_t* Z;
    DEV void operator()(const f32x4 (&acc)[2][2][4][2], const DenseSched::Unit& u, int wr, int wc, int fr, int fq) const {
        unsigned char* buf = g_lds + EPI_LDS + (wr * 4 + wc) * EPI_WAVE;
        const int lane = fq * 16 + fr, r2 = lane >> 2, c2 = lane & 3;
        const unsigned off0 = ((unsigned)(u.pm * 256 + wr * 64 + r2) * (unsigned)LD + (unsigned)(u.pn * 256 + wc * 32 + c2 * 8)) * 2u;
#pragma unroll
        for (int ai = 0; ai < 2; ++ai)
#pragma unroll
            for (int m = 0; m < 4; ++m)
#pragma unroll
                for (int bj = 0; bj < 2; ++bj) {
                    unsigned char* bb = buf + bj * EPI_PATCH;
#pragma unroll
                    for (int n = 0; n < 2; ++n) { const f32x4 v = acc[ai][bj][m][n]; u32x2 w; w.x = pk_bf16(v.x, v.y); w.y = pk_bf16(v.z, v.w); *(u32x2*)(bb + fr * 80 + n * 32 + fq * 8) = w; }
                    const u32x4 o = *(const u32x4*)(bb + r2 * 80 + c2 * 16);
                    *(u32x4*)((unsigned char*)Z + (off0 + (unsigned)(((ai * 128 + m * 16) * LD + bj * 128) * 2))) = o;
                    if (bj == 1) __builtin_amdgcn_sched_barrier(0);
                }
    } };
template <int ROWB> struct EpiF8T { unsigned char* Z;
    DEV void operator()(const f32x4 (&acc)[2][2][4][2], const DenseSched::Unit& u, int wr, int wc, int fr, int fq) const {
        unsigned char* buf = g_lds + EPI_LDS + (wr * 4 + wc) * EPI_WAVE;
        const int lane = fq * 16 + fr, r2 = lane >> 2, c2 = lane & 3;
        const unsigned off0 = (unsigned)(u.pm * 256 + wr * 64 + r2) * (unsigned)ROWB + (unsigned)(u.pn * 256 + wc * 32 + c2 * 8);
#pragma unroll
        for (int ai = 0; ai < 2; ++ai)
#pragma unroll
            for (int m = 0; m < 4; ++m)
#pragma unroll
                for (int bj = 0; bj < 2; ++bj) {
                    unsigned char* bb = buf + bj * EPI_PATCH;
#pragma unroll
                    for (int n = 0; n < 2; ++n) { const f32x4 v = acc[ai][bj][m][n]; u32x2 w; w.x = pk_bf16(v.x, v.y); w.y = pk_bf16(v.z, v.w); *(u32x2*)(bb + fr * 80 + n * 32 + fq * 8) = w; }
                    const u32x4 o = *(const u32x4*)(bb + r2 * 80 + c2 * 16);
                    u32x2 o8; o8.x = pk4_fp8(bflo(o.x), bfhi(o.x), bflo(o.y), bfhi(o.y)); o8.y = pk4_fp8(bflo(o.z), bfhi(o.z), bflo(o.w), bfhi(o.w));
                    *(u32x2*)(Z + (off0 + (unsigned)((ai * 128 + m * 16) * ROWB + bj * 128))) = o8;
                    if (bj == 1) __builtin_amdgcn_sched_barrier(0);
                }
    } };
struct EpiZ0T { bf16_t* Z; float* ZS;
    DEV void operator()(const f32x4 (&acc)[2][2][4][2], const DenseSched::Unit& u, int wr, int wc, int fr, int fq) const {
        EpiBfT<LD0>{Z}(acc, u, wr, wc, fr, fq);
        if (u.pn == 18) {
#pragma unroll
            for (int ai = 0; ai < 2; ++ai)
#pragma unroll
                for (int m = 0; m < 4; ++m)
#pragma unroll
                    for (int bj = 0; bj < 2; ++bj)
#pragma unroll
                        for (int n = 0; n < 2; ++n) *(f32x4*)(ZS + (size_t)(u.pm * 256 + ai * 128 + wr * 64 + m * 16 + fr) * 256 + bj * 128 + wc * 32 + n * 16 + fq * 4) = acc[ai][bj][m][n];
        }
    } };
struct EpiResidT { const float* xin; float* xout; float scale;
    DEV void operator()(const f32x4 (&acc)[2][2][4][2], const DenseSched::Unit& u, int wr, int wc, int fr, int fq) const {
        unsigned char* buf = g_lds + EPI_LDS + (wr * 4 + wc) * EPI_WAVE;
        const int lane = fq * 16 + fr, r2 = lane >> 2, c2 = lane & 3;
        const unsigned off0 = ((unsigned)(u.pm * 256 + wr * 64 + r2) * (unsigned)DM + (unsigned)(u.pn * 256 + wc * 32 + c2 * 4)) * 4u;
#pragma unroll
        for (int ai = 0; ai < 2; ++ai)
#pragma unroll
            for (int m = 0; m < 4; ++m) {
#pragma unroll
                for (int bj = 0; bj < 2; ++bj)
#pragma unroll
                    for (int n = 0; n < 2; ++n) {
                        unsigned char* bb = buf + n * EPI_PATCH;
                        *(f32x4*)(bb + fr * 80 + fq * 16) = acc[ai][bj][m][n];
                        const f32x4 v = *(const f32x4*)(bb + r2 * 80 + c2 * 16);
                        const unsigned o = off0 + (unsigned)(((ai * 128 + m * 16) * DM + bj * 128 + n * 16) * 4);
                        const f32x4 r = *(const f32x4*)((const unsigned char*)xin + o);
                        *(f32x4*)((unsigned char*)xout + o) = r + v * scale;
                    }
                __builtin_amdgcn_sched_barrier(0);
            }
    } };
}

struct EpiZ1 { bf16_t* Z; const float* tbl;
    DEV void operator()(const f32x4 (&acc)[2][2][4][2], const g8::DenseSched::Unit& u, int wr, int wc, int fr, int fq) const {
        const float sc = (u.pn >= 8) ? 0.0625f : 1.f;
        unsigned char* buf = g_lds + g8::EPI_LDS + (wr * 4 + wc) * g8::EPI_WAVE;
        const int lane = fq * 16 + fr, r2 = lane >> 2, c2 = lane & 3;
#pragma unroll
        for (int ai = 0; ai < 2; ++ai)
#pragma unroll
            for (int m = 0; m < 4; ++m) {
                const int row = u.pm * 256 + ai * 128 + wr * 64 + m * 16 + r2;
#pragma unroll
                for (int n = 0; n < 2; ++n) {
                    *(f32x4*)(buf + fr * 80 + fq * 16) = acc[ai][0][m][n]; *(f32x4*)(buf + g8::EPI_PATCH + fr * 80 + fq * 16) = acc[ai][1][m][n];
                    const f32x4 a = *(const f32x4*)(buf + r2 * 80 + c2 * 16), b = *(const f32x4*)(buf + g8::EPI_PATCH + r2 * 80 + c2 * 16);
                    const int i0 = wc * 32 + n * 16 + c2 * 4;
                    const f32x4 c = *(const f32x4*)(tbl + (size_t)row * 256 + i0), sn = *(const f32x4*)(tbl + (size_t)row * 256 + 128 + i0);
                    const f32x4 o1 = (a * c - b * sn) * sc, o2 = (b * c + a * sn) * sc;
                    u32x2 w; w.x = pk_bf16(o1.x, o1.y); w.y = pk_bf16(o1.z, o1.w);
                    *(u32x2*)(Z + (size_t)row * LD1 + u.pn * 256 + i0) = w;
                    w.x = pk_bf16(o2.x, o2.y); w.y = pk_bf16(o2.z, o2.w);
                    *(u32x2*)(Z + (size_t)row * LD1 + u.pn * 256 + 128 + i0) = w;
                }
                __builtin_amdgcn_sched_barrier(0);
            }
    } };
struct EpiZ1vg { bf16_t* Z; DEV void operator()(int row, int col, f32x4 v) const {
    u32x2 w; w.x = pk_bf16(v.x * 0.03125f, v.y * 0.03125f); w.y = pk_bf16(v.z * 0.03125f, v.w * 0.03125f);
    *(u32x2*)(Z + (size_t)row * LD1 + 4096 + col) = w; } };
template <class E>
DEV void ph_gemm8_dense(const bf16_t* A, const bf16_t* Bt, int N, int K, E e, int vb, int nvb) {
    g8::DenseSched S; S.init(A, Bt, NTOK, N, K, nvb, vb);
    if ((REPEAT_GROUP == 15 && N == LD0) || (REPEAT_GROUP == 16 && N == DM && K == DM)) S.rep = 2;
    g8::gemm_phase<false>(K, S, e);
}

DEV void ld16(const bf16_t* p, float (&v)[16]) {
    const u32x4 a = *(const u32x4*)p, b = *(const u32x4*)(p + 8);
    v[0] = bflo(a.x); v[1] = bfhi(a.x); v[2] = bflo(a.y); v[3] = bfhi(a.y); v[4] = bflo(a.z); v[5] = bfhi(a.z); v[6] = bflo(a.w); v[7] = bfhi(a.w);
    v[8] = bflo(b.x); v[9] = bfhi(b.x); v[10] = bflo(b.y); v[11] = bfhi(b.y); v[12] = bflo(b.z); v[13] = bfhi(b.z); v[14] = bflo(b.w); v[15] = bfhi(b.w);
}
DEV void ld8(const bf16_t* p, float (&v)[8]) {
    const u32x4 a = *(const u32x4*)p;
    v[0] = bflo(a.x); v[1] = bfhi(a.x); v[2] = bflo(a.y); v[3] = bfhi(a.y); v[4] = bflo(a.z); v[5] = bfhi(a.z); v[6] = bflo(a.w); v[7] = bfhi(a.w);
}
DEV void st16(bf16_t* p, const float (&v)[16]) {
    u32x4 a, b;
    a.x = pk_bf16(v[0], v[1]); a.y = pk_bf16(v[2], v[3]); a.z = pk_bf16(v[4], v[5]); a.w = pk_bf16(v[6], v[7]);
    b.x = pk_bf16(v[8], v[9]); b.y = pk_bf16(v[10], v[11]); b.z = pk_bf16(v[12], v[13]); b.w = pk_bf16(v[14], v[15]);
    *(u32x4*)p = a; *(u32x4*)(p + 8) = b;
}
DEV void st8(bf16_t* p, const float (&v)[8]) {
    u32x4 a; a.x = pk_bf16(v[0], v[1]); a.y = pk_bf16(v[2], v[3]); a.z = pk_bf16(v[4], v[5]); a.w = pk_bf16(v[6], v[7]);
    *(u32x4*)p = a;
}

DEV void up16(const u32x4 a, const u32x4 b, float (&v)[16]) {
    v[0] = bflo(a.x); v[1] = bfhi(a.x); v[2] = bflo(a.y); v[3] = bfhi(a.y); v[4] = bflo(a.z); v[5] = bfhi(a.z); v[6] = bflo(a.w); v[7] = bfhi(a.w);
    v[8] = bflo(b.x); v[9] = bfhi(b.x); v[10] = bflo(b.y); v[11] = bfhi(b.y); v[12] = bflo(b.z); v[13] = bfhi(b.z); v[14] = bflo(b.w); v[15] = bfhi(b.w);
}
DEV void up8(const u32x4 a, float (&v)[8]) {
    v[0] = bflo(a.x); v[1] = bfhi(a.x); v[2] = bflo(a.y); v[3] = bfhi(a.y); v[4] = bflo(a.z); v[5] = bfhi(a.z); v[6] = bflo(a.w); v[7] = bfhi(a.w);
}
DEV void ph_post0(const Params& p, int vb, int nvb) {
    unsigned char* ws = p.ws;
    const bf16_t* Z0 = (const bf16_t*)(ws + OFF_Z); const float* ZS = (const float*)(ws + OFF_ZS);
    bf16_t* QA = (bf16_t*)(ws + OFF_QA); bf16_t* KV = (bf16_t*)(ws + OFF_KV); bf16_t* QIA = (bf16_t*)(ws + OFF_QIA); bf16_t* KIA = (bf16_t*)(ws + OFF_KIA);
    float* WIS = (float*)(ws + OFF_WIS); float* DT = (float*)(ws + OFF_DT); bf16_t* XC = (bf16_t*)(ws + OFF_XC);
    const int wave = TIDX >> 6, lane = TIDX & 63, l8 = lane & 7;
    const float LOG2TH = 18.931568569324174f;
    float inv = 0.f;
    if (lane < 16) inv = exp2f(-(float)lane * (1.f / 16.f) * LOG2TH); else if (lane < 24) inv = exp2f(-(float)(lane - 16) * (1.f / 8.f) * LOG2TH);
    for (int tok = vb * 8 + wave; tok < NTOK; tok += nvb * 8) {
        const bf16_t* z = Z0 + (size_t)tok * LD0;
        const int la0 = lane & 15, s_tok = tok & (SEQ - 1);
        const u32x4 rq0 = *(const u32x4*)(z + 16 * lane), rq1 = *(const u32x4*)(z + 16 * lane + 8);
        const u32x4 rk0 = *(const u32x4*)(z + 1024 + 16 * la0), rk1 = *(const u32x4*)(z + 1024 + 16 * la0 + 8);
        const u32x4 rv0 = *(const u32x4*)(z + 1280 + 16 * la0), rv1 = *(const u32x4*)(z + 1280 + 16 * la0 + 8);
        const u32x4 rqi = *(const u32x4*)(z + 1536 + 8 * lane);
        const float zki = ZS[(size_t)tok * 256 + lane], zwi = ZS[(size_t)tok * 256 + 64 + (lane & 7)], zdt = ZS[(size_t)tok * 256 + 72 + (lane & 15)];
        u32x4 rc[3][4];
#pragma unroll
        for (int i = 0; i < 3; ++i)
#pragma unroll
            for (int k = 0; k < 4; ++k) { const int dk = (s_tok - 3 + k >= 0) ? (k - 3) : 0; rc[i][k] = *(const u32x4*)(z + (ptrdiff_t)dk * LD0 + 3072 + (i * 64 + lane) * 8); }
        const float posf = (float)p.pos[tok];
        float sn, cs; sincosf(posf * inv, &sn, &cs);
        float cq[16], sq[16];
#pragma unroll
        for (int i = 0; i < 16; ++i) { cq[i] = __shfl(cs, i); sq[i] = __shfl(sn, i); }
        {
            float v[16]; up16(rq0, rq1, v);
            float ss = 0.f;
#pragma unroll
            for (int i = 0; i < 16; ++i) ss += v[i] * v[i];
            ss += __shfl_xor(ss, 1); ss += __shfl_xor(ss, 2); ss += __shfl_xor(ss, 4);
            const float r = rsqrtf(ss * (1.f / 128.f) + EPS);
            const float* g = p.q_norm + l8 * 16;
#pragma unroll
            for (int i = 0; i < 16; ++i) v[i] = v[i] * r * g[i];
#pragma unroll
            for (int i = 0; i < 16; ++i) { const float o = __shfl_xor(v[i], 1);
                if (l8 == 0) v[i] = v[i] * cq[i] - o * sq[i]; else if (l8 == 1) v[i] = v[i] * cq[i] + o * sq[i]; }
            st16(QA + (size_t)tok * 1024 + 16 * lane, v);
        }
        {
            const int la = lane & 15;
            float v[16]; up16(rk0, rk1, v);
            float ss = 0.f;
#pragma unroll
            for (int i = 0; i < 16; ++i) ss += v[i] * v[i];
            ss += __shfl_xor(ss, 1); ss += __shfl_xor(ss, 2); ss += __shfl_xor(ss, 4);
            const float r = rsqrtf(ss * (1.f / 128.f) + EPS);
            const float* g = p.k_norm + l8 * 16;
#pragma unroll
            for (int i = 0; i < 16; ++i) v[i] = v[i] * r * g[i];
#pragma unroll
            for (int i = 0; i < 16; ++i) { const float o = __shfl_xor(v[i], 1);
                if (l8 == 0) v[i] = v[i] * cq[i] - o * sq[i]; else if (l8 == 1) v[i] = v[i] * cq[i] + o * sq[i]; }
            unsigned char* KV8 = (unsigned char*)KV;
            if (lane < 16) { u32x4 w; w.x = pk4_fp8(v[0], v[1], v[2], v[3]); w.y = pk4_fp8(v[4], v[5], v[6], v[7]); w.z = pk4_fp8(v[8], v[9], v[10], v[11]); w.w = pk4_fp8(v[12], v[13], v[14], v[15]);
                *(u32x4*)(KV8 + (size_t)tok * 512 + (la >> 3) * 256 + l8 * 16) = w; }
            if (lane >= 16 && lane < 32) {
                float vv[16]; up16(rv0, rv1, vv);
                u32x4 w; w.x = pk4_fp8(vv[0], vv[1], vv[2], vv[3]); w.y = pk4_fp8(vv[4], vv[5], vv[6], vv[7]); w.z = pk4_fp8(vv[8], vv[9], vv[10], vv[11]); w.w = pk4_fp8(vv[12], vv[13], vv[14], vv[15]);
                *(u32x4*)(KV8 + (size_t)tok * 512 + (la >> 3) * 256 + 128 + l8 * 16) = w;
            }
        }
        {
            float ci[8], si[8];
#pragma unroll
            for (int i = 0; i < 8; ++i) { ci[i] = __shfl(cs, 16 + i); si[i] = __shfl(sn, 16 + i); }
            float v[8]; up8(rqi, v);
#pragma unroll
            for (int i = 0; i < 8; ++i) { const float o = __shfl_xor(v[i], 1);
                if (l8 == 0) v[i] = v[i] * ci[i] - o * si[i]; else if (l8 == 1) v[i] = v[i] * ci[i] + o * si[i]; }
            st8(QIA + (size_t)tok * 512 + 8 * lane, v);
            float kv = zki;
            const float ss = wave_sum(kv * kv);
            kv = kv * rsqrtf(ss * (1.f / 64.f) + EPS) * p.kidx_norm[lane];
            const float o = __shfl_xor(kv, 8);
            const float c1 = __shfl(cs, 16 + (lane & 7)), s1 = __shfl(sn, 16 + (lane & 7));
            if (lane < 8) kv = kv * c1 - o * s1; else if (lane < 16) kv = kv * c1 + o * s1;
            KIA[(size_t)(tok >> 4) * 1024 + (lane >> 5) * 512 + (((lane >> 3) & 3) * 16 + (tok & 15)) * 8 + (lane & 7)] = f2bf(kv);
        }
        if (lane < 8) WIS[(size_t)tok * 8 + lane] = zwi * 0.044194173824159216f;
        if (lane < 16) { const float v = zdt + p.dt_bias[lane]; DT[(size_t)tok * 16 + lane] = v > 20.f ? v : log1pf(expf(v)); }
        {
            const int s = tok & (SEQ - 1);
#pragma unroll
            for (int i = 0; i < 3; ++i) {
                const int c0 = (i * 64 + lane) * 8;
                float acc[8];
                { const f32x4 b0 = *(const f32x4*)(p.conv_b + c0), b1 = *(const f32x4*)(p.conv_b + c0 + 4);
                  acc[0] = b0.x; acc[1] = b0.y; acc[2] = b0.z; acc[3] = b0.w; acc[4] = b1.x; acc[5] = b1.y; acc[6] = b1.z; acc[7] = b1.w; }
#pragma unroll
                for (int k = 0; k < 4; ++k) {
                    if (s - 3 + k >= 0) {
                        float xv[8]; up8(rc[i][k], xv);
                        const f32x4 w0 = *(const f32x4*)(p.conv_w + k * 1536 + c0), w1 = *(const f32x4*)(p.conv_w + k * 1536 + c0 + 4);
                        acc[0] += xv[0] * w0.x; acc[1] += xv[1] * w0.y; acc[2] += xv[2] * w0.z; acc[3] += xv[3] * w0.w;
                        acc[4] += xv[4] * w1.x; acc[5] += xv[5] * w1.y; acc[6] += xv[6] * w1.z; acc[7] += xv[7] * w1.w;
                    }
                }
#pragma unroll
                for (int e = 0; e < 8; ++e) acc[e] = siluf(acc[e]);
                st8(XC + (size_t)tok * 1536 + c0, acc);
            }
        }
    }
}

constexpr int DSA_SC = 0, DSA_HIST = 131072, DSA_SEL = 147456, DSA_MISC = 149504, DSA_PART = 149504 + 128, DSA_CAND = 150016;
DEV unsigned fkey(float f) { const unsigned u = __float_as_uint(f); return (u & 0x80000000u) ? ~u : (u | 0x80000000u); }

DEV void ph_dsa(const Params& p, int vb, int nvb) {
    unsigned char* ws = p.ws;
    const bf16_t* QA = (const bf16_t*)(ws + OFF_QA); const bf16_t* KV = (const bf16_t*)(ws + OFF_KV); const bf16_t* QIA = (const bf16_t*)(ws + OFF_QIA);
    const bf16_t* KIA = (const bf16_t*)(ws + OFF_KIA); const float* WIS = (const float*)(ws + OFF_WIS); bf16_t* MIX = (bf16_t*)(ws + OFF_MIX);
    unsigned* SC = (unsigned*)(g_lds + DSA_SC); unsigned* HIST = (unsigned*)(g_lds + DSA_HIST); unsigned short* SEL = (unsigned short*)(g_lds + DSA_SEL);
    unsigned* MISC = (unsigned*)(g_lds + DSA_MISC); unsigned* PART = (unsigned*)(g_lds + DSA_PART);
    const int tid = TIDX, wave = tid >> 6, lane = tid & 63, fr = lane & 15, fq = lane >> 4;
    bf16x8 an[2][2]; f32x4 wn[2]; int pref_k = -1;
#define DSA_QLOAD(kk) do { const int tk_ = ((kk) & 1) * SEQ + (2047 - ((kk) >> 1)) * 4; _Pragma("unroll") for (int mt = 0; mt < 2; ++mt) { \
        const bf16_t* qp = QIA + (size_t)(tk_ + (fr >> 2)) * 512 + ((fr & 3) + 4 * mt) * 64 + fq * 8; an[mt][0] = *(const bf16x8*)qp; an[mt][1] = *(const bf16x8*)(qp + 32); \
        wn[mt] = *(const f32x4*)(WIS + (size_t)(tk_ + fq) * 8 + mt * 4); } pref_k = (kk); } while (0)
#define DSA_UNIT(i2) (((((REPEAT_GROUP == 2) ? ((i2) >> 1) : (i2)) & 1) ? ((REPEAT_GROUP == 2) ? ((i2) >> 1) : (i2)) * nvb + (nvb - 1 - vb) : ((REPEAT_GROUP == 2) ? ((i2) >> 1) : (i2)) * nvb + vb))
    for (int it2 = 0; it2 * nvb < 4096 * (REPEAT_GROUP == 2 ? 2 : 1); ++it2) {
        const int k = DSA_UNIT(it2);
        if (k >= 4096) continue;
        const int b = k & 1, s0 = (2047 - (k >> 1)) * 4, tok0 = b * SEQ + s0;
        const int ntile = (s0 + 3) / 16 + 1, npad = ntile * 16;
        const bool sel = (s0 >= 256);
        if (pref_k != k) DSA_QLOAD(k);
        __syncthreads();
        if (sel) for (int i = tid; i < 4096; i += NBLK) HIST[i] = 0u;
        __syncthreads();
        {
            bf16x8 a[2][2]; f32x4 wv[2];
#pragma unroll
            for (int mt = 0; mt < 2; ++mt) { a[mt][0] = an[mt][0]; a[mt][1] = an[mt][1]; wv[mt] = wn[mt]; }
            const bf16_t* kbase = KIA + (size_t)(b * (SEQ / 16)) * 1024 + lane * 8;
            bf16x8 kb[2][4][2];
#define DSA_KLOAD(buf, t0) do { _Pragma("unroll") for (int u = 0; u < 4; ++u) { const bf16_t* kp = kbase + (size_t)min((t0) + 8 * u, ntile - 1) * 1024; \
                kb[buf][u][0] = *(const bf16x8*)kp; kb[buf][u][1] = *(const bf16x8*)(kp + 512); } } while (0)
            for (int srep = 0; srep < (REPEAT_GROUP == 21 ? 2 : 1); ++srep) {
            DSA_KLOAD(0, wave);
            for (int tile00 = wave; tile00 < ntile; tile00 += 64) {
#pragma unroll
              for (int hb = 0; hb < 2; ++hb) {
                const int tile0 = tile00 + hb * 32;
                if (hb == 0) DSA_KLOAD(1, tile0 + 32); else DSA_KLOAD(0, tile0 + 32);
#pragma unroll
                for (int u = 0; u < 4; ++u) {
                    const int tile = tile0 + 8 * u;
                    if (tile < ntile) {
                        const int key = tile * 16 + fr;
                        float tot = 0.f;
#pragma unroll
                        for (int mt = 0; mt < 2; ++mt) {
                            f32x4 acc = (f32x4){0.f, 0.f, 0.f, 0.f};
                            acc = mfma16(a[mt][0], kb[hb][u][0], acc); acc = mfma16(a[mt][1], kb[hb][u][1], acc);
#define DSA_RELU(x) __builtin_amdgcn_fmed3f((x), 0.f, 3.0e38f)
                            const float r0 = DSA_RELU(acc.x), r1 = DSA_RELU(acc.y), r2 = DSA_RELU(acc.z), r3 = DSA_RELU(acc.w);
                            asm("v_fmac_f32_e32 %0, %1, %2" : "+v"(tot) : "v"(wv[mt].x), "v"(r0)); asm("v_fmac_f32_e32 %0, %1, %2" : "+v"(tot) : "v"(wv[mt].y), "v"(r1));
                            asm("v_fmac_f32_e32 %0, %1, %2" : "+v"(tot) : "v"(wv[mt].z), "v"(r2)); asm("v_fmac_f32_e32 %0, %1, %2" : "+v"(tot) : "v"(wv[mt].w), "v"(r3));
#undef DSA_RELU
                        }
                        const int r = fq;
                        const unsigned fb = __float_as_uint(tot);
                        unsigned uk = fb ^ ((unsigned)((int)fb >> 31) | 0x80000000u);
                        if (tile == ntile - 1) uk = (key <= s0 + r) ? uk : 0u;
                        SC[r * 8192 + key] = uk;
                        if (sel && srep == 0 && uk != 0u) { const unsigned d = uk >> 21; atomicAdd(&HIST[r * 1024 + (d >> 1)], (d & 1u) ? 65536u : 1u); if (REPEAT_GROUP == 22) atomicAdd(&HIST[r * 1024 + (d >> 1)], 0u); }
                    }
                }
              }
            }
            }
#undef DSA_KLOAD
        }
        { const int kn = DSA_UNIT(it2 + 1); if ((it2 + 1) * nvb < 4096 * (REPEAT_GROUP == 2 ? 2 : 1) && kn < 4096) DSA_QLOAD(kn); }
        __syncthreads();
        if (!sel) {
            const int r = tid >> 7, tl = tid & 127, n = s0 + r + 1;
            for (int i = tl; i < 256; i += 128) SEL[r * 256 + i] = (unsigned short)(i < n ? i : 0);
            if (tl == 0) MISC[8 + r] = (unsigned)n;
        } else {
            const int r = tid >> 7, tl = tid & 127, hi = tl >> 6;
            unsigned* CK = (unsigned*)(g_lds + DSA_CAND); unsigned short* CI = (unsigned short*)(g_lds + DSA_CAND + 8192);
            for (int selrep = 0; selrep < (REPEAT_GROUP == 23 ? 2 : 1); ++selrep) {
            const unsigned long long ltm = (1ull << lane) - 1ull;
            unsigned prefix = 0u; int need = 256;
            {
                unsigned s = 0u;
                for (int w = 0; w < 8; ++w) { const unsigned hw = HIST[r * 1024 + tl * 8 + w]; s += (hw & 0xffffu) + (hw >> 16); }
                unsigned incl = s;
#pragma unroll
                for (int off = 1; off < 64; off <<= 1) { const unsigned t2 = __shfl_down(incl, off); if (lane + off < 64) incl += t2; }
                if (hi == 1 && lane == 0) PART[r] = incl;
                __syncthreads();
                const unsigned above = (incl - s) + (hi == 0 ? PART[r] : 0u);
                if ((int)above < need && need <= (int)(above + s)) {
                    unsigned cum = above; int dsel = tl * 16;
                    for (int d = tl * 16 + 15; d >= tl * 16; --d) {
                        const unsigned hw = HIST[r * 1024 + (d >> 1)]; const unsigned c = (d & 1) ? (hw >> 16) : (hw & 0xffffu);
                        if ((int)(cum + c) >= need) { dsel = d; break; }
                        cum += c;
                    }
                    MISC[r] = (unsigned)dsel; MISC[4 + r] = (unsigned)(need - (int)cum);
                }
                __syncthreads();
                prefix = MISC[r]; need = (int)MISC[4 + r];
            }
            const int ngt1 = 256 - need;
            {
                const int mid = ((npad >> 1) + 63) & ~63, lo_i = hi ? mid : 0, hi_i = hi ? npad : mid;
                const int ngr = (hi_i - lo_i + 63) >> 6;
                unsigned mg0 = 0u, mg1 = 0u, me0 = 0u, me1 = 0u;
#pragma unroll 4
                for (int gidx = 0; gidx < ngr; ++gidx) {
                    const int i = lo_i + gidx * 64 + lane; const unsigned u = (i < hi_i) ? SC[r * 8192 + i] : 0u; const unsigned bin = u >> 21;
                    const unsigned long long mg = __ballot(bin > prefix), me = __ballot((bin == prefix) && (u != 0u));
                    const bool mine = (lane == gidx);
                    mg0 = mine ? (unsigned)mg : mg0; mg1 = mine ? (unsigned)(mg >> 32) : mg1; me0 = mine ? (unsigned)me : me0; me1 = mine ? (unsigned)(me >> 32) : me1;
                }
                const unsigned packed = (unsigned)(__popc(mg0) + __popc(mg1)) | ((unsigned)(__popc(me0) + __popc(me1)) << 16);
                unsigned incl = packed;
#pragma unroll
                for (int off = 1; off < 64; off <<= 1) { const unsigned t2 = __shfl_up(incl, off); if (lane >= off) incl += t2; }
                int pg = (int)((incl - packed) & 0xffffu), pe = (int)((incl - packed) >> 16);
                const int cc = (int)(__shfl(incl, 63) >> 16);
                unsigned long long m = ((unsigned long long)mg1 << 32) | mg0;
                while (m) { const int i = lo_i + lane * 64 + __builtin_ctzll(m); m &= m - 1ull; SEL[r * 256 + (hi ? (ngt1 - 1 - pg) : pg)] = (unsigned short)i; ++pg; }
                m = ((unsigned long long)me1 << 32) | me0;
                while (m) { const int i = lo_i + lane * 64 + __builtin_ctzll(m); m &= m - 1ull;
                    if (pe < 512) { const int q = hi ? (511 - pe) : pe; const unsigned u = SC[r * 8192 + i]; CK[r * 512 + q] = ((u & 0x1FFFFFu) << 10) | (unsigned)((hi ? 511 : 1023) - pe); CI[r * 512 + q] = (unsigned short)i; }
                    ++pe; }
                if (lane == 0) MISC[12 + r * 2 + hi] = (unsigned)cc;
            }
            __syncthreads();
            bool ovf = false;
#pragma unroll
            for (int q = 0; q < 4; ++q) ovf |= (MISC[12 + q * 2] + MISC[13 + q * 2] > 512u);
            if (!ovf) {
                const int c0 = (int)MISC[12 + r * 2], c1 = (int)MISC[13 + r * 2], C = c0 + c1;
                unsigned kc[4]; int rank[4]; unsigned short ki[4];
#pragma unroll
                for (int q = 0; q < 4; ++q) { const int c = tl + q * 128; const int qc = (c < c0) ? c : (512 - C + c); kc[q] = (c < C) ? CK[r * 512 + qc] : ~0u; ki[q] = (c < C) ? CI[r * 512 + qc] : (unsigned short)0; rank[q] = 0; }
                const unsigned* s0 = CK + r * 512; const unsigned* s1 = CK + r * 512 + (512 - c1);
                if (C <= 256) {
#pragma unroll 8
                    for (int c2 = 0; c2 < c0; ++c2) { const unsigned k2 = s0[c2]; rank[0] += (k2 > kc[0]) ? 1 : 0; rank[1] += (k2 > kc[1]) ? 1 : 0; }
#pragma unroll 8
                    for (int c2 = 0; c2 < c1; ++c2) { const unsigned k2 = s1[c2]; rank[0] += (k2 > kc[0]) ? 1 : 0; rank[1] += (k2 > kc[1]) ? 1 : 0; }
                } else {
#pragma unroll 8
                    for (int c2 = 0; c2 < c0; ++c2) { const unsigned k2 = s0[c2];
#pragma unroll
                        for (int q = 0; q < 4; ++q) rank[q] += (k2 > kc[q]) ? 1 : 0; }
#pragma unroll 8
                    for (int c2 = 0; c2 < c1; ++c2) { const unsigned k2 = s1[c2];
#pragma unroll
                        for (int q = 0; q < 4; ++q) rank[q] += (k2 > kc[q]) ? 1 : 0; }
                }
#pragma unroll
                for (int q = 0; q < 4; ++q) if (tl + q * 128 < C && rank[q] < need) SEL[r * 256 + ngt1 + rank[q]] = ki[q];
                if (tl == 0) MISC[8 + r] = 256u;
            } else if (selrep == 0) {
#pragma unroll 1
                for (int pass = 1; pass < 3; ++pass) {
                    const int shift = pass == 1 ? 10 : 0, nbits = pass == 2 ? 10 : 11, per = (1 << nbits) / 128;
                    for (int i = tl; i < 1024; i += 128) HIST[r * 1024 + i] = 0u;
                    __syncthreads();
                    for (int i = tl; i < npad; i += 128) {
                        const unsigned u = SC[r * 8192 + i];
                        if ((u >> (shift + nbits)) == prefix) { const unsigned d = (u >> shift) & ((1u << nbits) - 1u); atomicAdd(&HIST[r * 1024 + (d >> 1)], (d & 1u) ? 65536u : 1u); }
                    }
                    __syncthreads();
                    unsigned s = 0u;
                    for (int w = 0; w < per / 2; ++w) { const unsigned hw = HIST[r * 1024 + tl * (per / 2) + w]; s += (hw & 0xffffu) + (hw >> 16); }
                    unsigned incl = s;
#pragma unroll
                    for (int off = 1; off < 64; off <<= 1) { const unsigned t2 = __shfl_down(incl, off); if (lane + off < 64) incl += t2; }
                    if (hi == 1 && lane == 0) PART[r] = incl;
                    __syncthreads();
                    const unsigned above = (incl - s) + (hi == 0 ? PART[r] : 0u);
                    if ((int)above < need && need <= (int)(above + s)) {
                        unsigned cum = above; int dsel = tl * per;
                        for (int d = tl * per + per - 1; d >= tl * per; --d) {
                            const unsigned hw = HIST[r * 1024 + (d >> 1)]; const unsigned c = (d & 1) ? (hw >> 16) : (hw & 0xffffu);
                            if ((int)(cum + c) >= need) { dsel = d; break; }
                            cum += c;
                        }
                        MISC[r] = (prefix << nbits) | (unsigned)dsel; MISC[4 + r] = (unsigned)(need - (int)cum);
                    }
                    __syncthreads();
                    prefix = MISC[r]; need = (int)MISC[4 + r];
                }
                if (wave < 4) {
                    const int rr = wave; const unsigned Kst = MISC[rr]; const int nd = (int)MISC[4 + rr], ngt = 256 - nd;
                    int cg = 0, ce = 0;
                    for (int base = 0; base < npad; base += 64) {
                        const int i0 = base + lane;
                        const unsigned u0 = (i0 < npad) ? SC[rr * 8192 + i0] : 0u;
                        const bool gt0 = u0 > Kst, eq0 = (u0 == Kst);
                        const unsigned long long mg0 = __ballot(gt0), me0 = __ballot(eq0);
                        if (gt0) SEL[rr * 256 + cg + __popcll(mg0 & ltm)] = (unsigned short)i0;
                        if (eq0) { const int rk = ce + __popcll(me0 & ltm); if (rk < nd) SEL[rr * 256 + ngt + rk] = (unsigned short)i0; }
                        cg += __popcll(mg0); ce += __popcll(me0);
                    }
                    if (lane == 0) MISC[8 + rr] = 256u;
                }
            }
            if (REPEAT_GROUP == 23) __syncthreads();
            }
        }
        __syncthreads();
        {
            unsigned short* SELG = (unsigned short*)(ws + OFF_SELG);
            if (tid < 128) { const int r = tid >> 5, c8 = tid & 31;
                *(u32x4*)(SELG + (size_t)(tok0 + r) * 256 + c8 * 8) = *(const u32x4*)(SEL + r * 256 + c8 * 8); }
        }
    }
}

#undef DSA_QLOAD
#undef DSA_UNIT
DEV void ph_dsa_attn(const Params& p, int vb, int nvb) {
    unsigned char* ws = p.ws;
    const bf16_t* QA = (const bf16_t*)(ws + OFF_QA); const bf16_t* KV = (const bf16_t*)(ws + OFF_KV); bf16_t* MIX = (bf16_t*)(ws + OFF_MIX);
    const unsigned short* SELG = (const unsigned short*)(ws + OFF_SELG);
    unsigned* Q = (unsigned*)(ws + OFF_CTL) + CW_DSAQ;
    int tz = TIDX; asm volatile("" : "+v"(tz));
    const int tid = tz, wave = tid >> 6, lane = tid & 63, fr = lane & 15, fq = lane >> 4;
    float* P = (float*)g_lds + wave * 1024;
    unsigned short* SELW = (unsigned short*)(g_lds + 32768) + wave * 256;
    const int grp0 = (int)((xb_xcc_id() >> 1) & 3u);
    const float scale = 0.08838834764831845f;
    for (int gi = 0; gi < 4; ++gi) {
        const int grp = (grp0 + gi) & 3, b = grp >> 1, g = grp & 1;
        const unsigned char* kvb = (const unsigned char*)KV + (size_t)(b * SEQ) * 512 + g * 256;
        for (;;) {
            unsigned chunk = 0;
            if (lane == 0) chunk = atomicAdd(&Q[grp * 64], 1u);
            chunk = (unsigned)__builtin_amdgcn_readfirstlane((int)chunk);
            if (chunk >= 2048u) break;
            const int sbase = (2047 - (int)chunk) * 4;
            u32x2 selnext = *(const u32x2*)(SELG + (size_t)(b * SEQ + sbase) * 256 + lane * 4);
#pragma unroll 1
            for (int rr = 0; rr < 4; ++rr) {
                const int sl = sbase + rr, tok = b * SEQ + sl, ns = min(sl + 1, 256);
                *(u32x2*)(SELW + lane * 4) = selnext;
                if (rr < 3) selnext = *(const u32x2*)(SELG + (size_t)(tok + 1) * 256 + lane * 4);
                bf16x8 qf[4];
#pragma unroll
                for (int ks = 0; ks < 4; ++ks) {
                    bf16x8 z = {0, 0, 0, 0, 0, 0, 0, 0};
                    qf[ks] = (fr < 4) ? *(const bf16x8*)(QA + (size_t)tok * 1024 + (4 * g + fr) * 128 + fq * 32 + ks * 8) : z;
                }
                __builtin_amdgcn_wave_barrier();
                float sc[4][4];
                {
                    u32x4 kf[16][2];
#define ATT_KLOAD(u0, u1) do { _Pragma("unroll") for (int u = (u0); u < (u1); ++u) { const int j = u * 16 + fr; const int idx = (j < ns) ? (int)SELW[j] : 0; \
                        const unsigned char* kp = kvb + (size_t)idx * 512 + fq * 32; kf[u][0] = *(const u32x4*)kp; kf[u][1] = *(const u32x4*)(kp + 16); } } while (0)
#define ATT_KUSE(u0, u1) do { _Pragma("unroll") for (int u = (u0); u < (u1); ++u) { f32x4 acc = (f32x4){0.f, 0.f, 0.f, 0.f}; \
                        _Pragma("unroll") for (int ks = 0; ks < 4; ++ks) { const u32x4 kq = kf[u][ks >> 1]; acc = mfma16(qf[ks], fp8x8_to_bf16((ks & 1) ? (u32x2){kq.z, kq.w} : (u32x2){kq.x, kq.y}), acc); } \
                        _Pragma("unroll") for (int h = 0; h < 4; ++h) { const float t = __shfl(acc[h], fr); if (fq == (u & 3)) sc[u >> 2][h] = t; } \
                        __builtin_amdgcn_sched_barrier(0); } } while (0)
                    ATT_KLOAD(0, 8);
                    __builtin_amdgcn_sched_barrier(0);
                    ATT_KUSE(0, 4);
                    ATT_KLOAD(8, 12);
                    __builtin_amdgcn_sched_barrier(0);
                    ATT_KUSE(4, 8);
                    ATT_KLOAD(12, 16);
                    __builtin_amdgcn_sched_barrier(0);
                    ATT_KUSE(8, 16);
#undef ATT_KLOAD
#undef ATT_KUSE
                }
                const unsigned char* vb2 = kvb + 128 + fr * 8;
                const int ngrp = (ns + 3) >> 2;
                u32x2 vvA[16], vvB[16];
#define ATT_VLOAD(vv, g0) do { _Pragma("unroll") for (int u = 0; u < 16; ++u) { const int j = min(((g0) + u) * 4 + fq, 255); const int idx = (int)SELW[j]; vv[u] = *(const u32x2*)(vb2 + (size_t)idx * 512); } } while (0)
                ATT_VLOAD(vvA, 0);
                __builtin_amdgcn_sched_barrier(0);
#pragma unroll
                for (int i = 0; i < 4; ++i) {
                    const bool vld = ((i * 4 + fq) * 16 + fr) < ns;
#pragma unroll
                    for (int h = 0; h < 4; ++h) sc[i][h] = vld ? sc[i][h] * scale : -INFINITY;
                }
                float mx[4], sm[4];
#pragma unroll
                for (int h = 0; h < 4; ++h) { mx[h] = wave_max(fmaxf(fmaxf(sc[0][h], sc[1][h]), fmaxf(sc[2][h], sc[3][h]))); sm[h] = 0.f; }
#pragma unroll
                for (int i = 0; i < 4; ++i) {
                    f32x4 pv;
#pragma unroll
                    for (int h = 0; h < 4; ++h) { const float e = __expf(sc[i][h] - mx[h]); pv[h] = e; sm[h] += e; }
                    *(f32x4*)(P + ((i * 4 + fq) * 16 + fr) * 4) = pv;
                }
                float inv[4];
#pragma unroll
                for (int h = 0; h < 4; ++h) inv[h] = __builtin_amdgcn_rcpf(wave_sum(sm[h]));
                __builtin_amdgcn_wave_barrier();
                float o[4][8];
#pragma unroll
                for (int h = 0; h < 4; ++h)
#pragma unroll
                    for (int e = 0; e < 8; ++e) o[h][e] = 0.f;
#define ATT_PV(vv, g0) do { _Pragma("unroll") for (int u = 0; u < 16; ++u) { \
                        const int j = ((g0) + u) * 4 + fq; \
                        f32x4 pv = *(const f32x4*)(P + min(j, 255) * 4); \
                        if (j >= ns) pv = (f32x4){0.f, 0.f, 0.f, 0.f}; \
                        const f32x4 va = up4_fp8(vv[u].x), vb4 = up4_fp8(vv[u].y); \
                        const float v8[8] = {va.x, va.y, va.z, va.w, vb4.x, vb4.y, vb4.z, vb4.w}; \
                        _Pragma("unroll") for (int h = 0; h < 4; ++h) _Pragma("unroll") for (int e = 0; e < 8; ++e) \
                            asm("v_fmac_f32_e32 %0, %1, %2" : "+v"(o[h][e]) : "v"(pv[h]), "v"(v8[e]));        \
                        if ((u & 3) == 3) __builtin_amdgcn_sched_barrier(0);         \
                    } } while (0)
#pragma unroll 1
                for (int g0 = 0; g0 < ngrp; g0 += 32) {
                    if (g0 + 16 < ngrp) ATT_VLOAD(vvB, g0 + 16);
                    __builtin_amdgcn_sched_barrier(0);
                    ATT_PV(vvA, g0);
                    if (g0 + 16 < ngrp) {
                        if (g0 + 32 < ngrp) ATT_VLOAD(vvA, g0 + 32);
                        __builtin_amdgcn_sched_barrier(0);
                        ATT_PV(vvB, g0 + 16);
                    }
                }
#undef ATT_VLOAD
#undef ATT_PV
#pragma unroll
                for (int h = 0; h < 4; ++h)
#pragma unroll
                    for (int e = 0; e < 8; ++e) { float v = o[h][e]; v += __shfl_xor(v, 16); v += __shfl_xor(v, 32); o[h][e] = v * inv[h]; }
                if (fq == 0) {
#pragma unroll
                    for (int h = 0; h < 4; ++h) {
                        if (FP8_OUT0) { u32x2 w8; w8.x = pk4_fp8(o[h][0], o[h][1], o[h][2], o[h][3]); w8.y = pk4_fp8(o[h][4], o[h][5], o[h][6], o[h][7]);
                            *(u32x2*)(ws + OFF_H + (size_t)tok * 2048 + (4 * g + h) * 128 + fr * 8) = w8; }
                        else { u32x4 w; w.x = pk_bf16(o[h][0], o[h][1]); w.y = pk_bf16(o[h][2], o[h][3]); w.z = pk_bf16(o[h][4], o[h][5]); w.w = pk_bf16(o[h][6], o[h][7]);
                            *(u32x4*)(MIX + (size_t)tok * 2048 + (4 * g + h) * 128 + fr * 8) = w; }
                    }
                }
                __builtin_amdgcn_wave_barrier();
            }
        }
    }
}

#ifdef DEBUG_NAN
#define DBG_SUB(cond, code) do { if (cond) atomicMax((unsigned*)(p.ws + OFF_CTL) + 8001, (unsigned)(code)); } while (0)
DEV bool nonfin(float v) { return (__float_as_uint(v) & 0x7f800000u) == 0x7f800000u; }
#else
#define DBG_SUB(cond, code) do {} while (0)
#endif
constexpr int SSD_PITCH = 136;
DEV void ssd_dt_acum(const Params& p, int tok0, int g, float* acum, float* dtv, float* cd_out) {
    const float* DT = (const float*)(p.ws + OFF_DT);
    for (int i = TIDX; i < 1024; i += NBLK) dtv[i] = DT[(size_t)(tok0 + (i >> 3)) * 16 + g * 8 + (i & 7)];
    __syncthreads();
    if (TIDX < 8) {
        const float a = -expf(p.a_log[g * 8 + TIDX]); float run = 0.f;
        for (int row = 0; row < 128; ++row) { run += dtv[row * 8 + TIDX] * a; acum[row * 8 + TIDX] = run; }
        if (cd_out) cd_out[g * 8 + TIDX] = expf(run);
    }
    __syncthreads();
}

DEV void ph_ssd_states(const Params& p, int vb, int nvb) {
    unsigned char* ws = p.ws;
    const bf16_t* XC = (const bf16_t*)(ws + OFF_XC); float* ST = (float*)(ws + OFF_ST); float* CD = (float*)(ws + OFF_CD);
    float* acum = (float*)g_lds; float* dtv = (float*)(g_lds + 4096);
    bf16_t* BT = (bf16_t*)(g_lds + 8192); bf16_t* XT = (bf16_t*)(g_lds + 43008);
    const int tid = TIDX, wave = tid >> 6, lane = tid & 63, fr = lane & 15, fq = lane >> 4;
    for (int unit = vb; unit < 256; unit += nvb) {
        const int b = unit >> 7, c = (unit >> 1) & 63, g = unit & 1, tok0 = b * SEQ + c * 128;
        __syncthreads();
        ssd_dt_acum(p, tok0, g, acum, dtv, CD + (size_t)(b * 64 + c) * 16);
        for (int ci = tid; ci < 2048; ci += NBLK) {
            const int j = ci & 127, n8 = ci >> 7;
            const u32x4 w = *(const u32x4*)(XC + (size_t)(tok0 + j) * 1536 + 1024 + g * 128 + n8 * 8);
            const unsigned ww[4] = {w.x, w.y, w.z, w.w};
#pragma unroll
            for (int e = 0; e < 4; ++e) { BT[(n8 * 8 + 2 * e) * SSD_PITCH + j] = (bf16_t)(ww[e] & 0xffffu); BT[(n8 * 8 + 2 * e + 1) * SSD_PITCH + j] = (bf16_t)(ww[e] >> 16); }
        }
        for (int half = 0; half < 2; ++half) {
            __syncthreads();
            for (int ci = tid; ci < 4096; ci += NBLK) {
                const int j = ci & 127, c8 = ci >> 7, chl0 = c8 * 8, hh = half * 4 + (chl0 >> 6);
                const float scl = dtv[j * 8 + hh] * expf(acum[127 * 8 + hh] - acum[j * 8 + hh]);
                float v[8]; ld8(XC + (size_t)(tok0 + j) * 1536 + g * 512 + half * 256 + chl0, v);
#pragma unroll
                for (int e = 0; e < 8; ++e) XT[(chl0 + e) * SSD_PITCH + j] = f2bf(v[e] * scl);
            }
            __syncthreads();
            const int hh4 = wave >> 1, nh = wave & 1;
            f32x4 acc[4][4];
#pragma unroll
            for (int m = 0; m < 4; ++m)
#pragma unroll
                for (int n = 0; n < 4; ++n) acc[m][n] = (f32x4){0.f, 0.f, 0.f, 0.f};
#pragma unroll
            for (int ks = 0; ks < 4; ++ks) {
                bf16x8 af[4], bfr[4];
#pragma unroll
                for (int m = 0; m < 4; ++m) af[m] = *(const bf16x8*)(XT + (hh4 * 64 + m * 16 + fr) * SSD_PITCH + ks * 32 + fq * 8);
#pragma unroll
                for (int n = 0; n < 4; ++n) bfr[n] = *(const bf16x8*)(BT + (nh * 64 + n * 16 + fr) * SSD_PITCH + ks * 32 + fq * 8);
#pragma unroll
                for (int m = 0; m < 4; ++m)
#pragma unroll
                    for (int n = 0; n < 4; ++n) acc[m][n] = mfma16(bfr[n], af[m], acc[m][n]);
            }
            const int h = g * 8 + half * 4 + hh4;
            float* stp = ST + ((size_t)((b * 64 + c) * 16 + h)) * 8192;
#pragma unroll
            for (int m = 0; m < 4; ++m)
#pragma unroll
                for (int n = 0; n < 4; ++n) *(f32x4*)(stp + (m * 16 + fr) * 128 + nh * 64 + n * 16 + fq * 4) = acc[m][n];
        }
    }
}

DEV void ph_ssd_scan(const Params& p, int vb, int nvb) {
    const float* ST = (const float*)(p.ws + OFF_ST); const float* CD = (const float*)(p.ws + OFF_CD); bf16_t* PREV = (bf16_t*)(p.ws + OFF_PREV);
    for (int e = vb * NBLK + TIDX; e < 65536; e += nvb * NBLK) {
        const int b = e >> 15, rem = e & 32767, h = rem >> 11, pn = rem & 2047;
        f32x4 run = (f32x4){0.f, 0.f, 0.f, 0.f};
#pragma unroll 8
        for (int c = 0; c < 64; ++c) {
            const size_t off = ((size_t)((b * 64 + c) * 16 + h)) * 8192 + pn * 4;
            const f32x4 st = *(const f32x4*)(ST + off); const float cd = CD[(b * 64 + c) * 16 + h];
            u32x2 w; w.x = pk_bf16(run.x, run.y); w.y = pk_bf16(run.z, run.w);
            *(u32x2*)(PREV + off) = w;
            run = run * cd + st;
        }
    }
}

DEV void ph_ssd_out(const Params& p, int vb, int nvb) {
    unsigned char* ws = p.ws;
    const bf16_t* XC = (const bf16_t*)(ws + OFF_XC); const bf16_t* Z0 = (const bf16_t*)(ws + OFF_Z); const bf16_t* PREV = (const bf16_t*)(ws + OFF_PREV);
    bf16_t* MIX = (bf16_t*)(ws + OFF_MIX);
    float* acum = (float*)g_lds; float* dtv = (float*)(g_lds + 4096); float* sspart = (float*)(g_lds + 8192); float* rstd = (float*)(g_lds + 16384);
    bf16_t* Cs = (bf16_t*)(g_lds + 17408); bf16_t* BL = (bf16_t*)(g_lds + 52224); bf16_t* CBs = (bf16_t*)(g_lds + 87040); bf16_t* XT = (bf16_t*)(g_lds + 121856);
    constexpr int SO_PATCH = 139264;
    const int tid = TIDX, wave = tid >> 6, lane = tid & 63, fr = lane & 15, fq = lane >> 4, wm = wave >> 1, wn = wave & 1;
    for (int unit = vb; unit < 256; unit += nvb) {
        const int b = unit >> 7, c = (unit >> 1) & 63, g = unit & 1, tok0 = b * SEQ + c * 128;
        __syncthreads();
        ssd_dt_acum(p, tok0, g, acum, dtv, nullptr);
#ifdef DEBUG_NAN
        for (int i = tid; i < 1024; i += NBLK) { DBG_SUB(nonfin(acum[i]), 60); DBG_SUB(nonfin(dtv[i]), 61); DBG_SUB(dtv[i] < 0.f, 62); DBG_SUB(dtv[i] > 100.f, 63); }
        if (tid < 16) DBG_SUB(nonfin(p.a_log[tid]) || p.a_log[tid] > 10.f || p.a_log[tid] < -10.f, 64);
#endif
        for (int ci = tid; ci < 2048; ci += NBLK) {
            const int row = ci >> 4, q = ci & 15;
            *(u32x4*)(Cs + row * SSD_PITCH + q * 8) = *(const u32x4*)(XC + (size_t)(tok0 + row) * 1536 + 1280 + g * 128 + q * 8);
            *(u32x4*)(BL + row * SSD_PITCH + q * 8) = *(const u32x4*)(XC + (size_t)(tok0 + row) * 1536 + 1024 + g * 128 + q * 8);
        }
        __syncthreads();
#ifdef DEBUG_NAN
        for (int i = tid; i < 1024; i += NBLK) DBG_SUB(nonfin(acum[i]), 75);
#endif
        {
            f32x4 acc[2][4];
#pragma unroll
            for (int m = 0; m < 2; ++m)
#pragma unroll
                for (int n = 0; n < 4; ++n) acc[m][n] = (f32x4){0.f, 0.f, 0.f, 0.f};
#pragma unroll
            for (int ks = 0; ks < 4; ++ks) {
                bf16x8 af[2], bfr[4];
#pragma unroll
                for (int m = 0; m < 2; ++m) af[m] = *(const bf16x8*)(Cs + (wm * 32 + m * 16 + fr) * SSD_PITCH + ks * 32 + fq * 8);
#pragma unroll
                for (int n = 0; n < 4; ++n) bfr[n] = *(const bf16x8*)(BL + (wn * 64 + n * 16 + fr) * SSD_PITCH + ks * 32 + fq * 8);
#pragma unroll
                for (int m = 0; m < 2; ++m)
#pragma unroll
                    for (int n = 0; n < 4; ++n) acc[m][n] = mfma16(bfr[n], af[m], acc[m][n]);
            }
#pragma unroll
            for (int m = 0; m < 2; ++m)
#pragma unroll
                for (int n = 0; n < 4; ++n) { u32x2 w; w.x = pk_bf16(acc[m][n].x, acc[m][n].y); w.y = pk_bf16(acc[m][n].z, acc[m][n].w);
#ifdef DEBUG_NAN
                    DBG_SUB(nonfin(acc[m][n].x) || nonfin(acc[m][n].y) || nonfin(acc[m][n].z) || nonfin(acc[m][n].w), 80);
                    DBG_SUB(fabsf(acc[m][n].x) > 1e6f, 81);
                    DBG_SUB((w.x & 0x7f80u) == 0x7f80u || (w.x & 0x7f800000u) == 0x7f800000u || (w.y & 0x7f80u) == 0x7f80u || (w.y & 0x7f800000u) == 0x7f800000u, 82);
#endif
                    *(u32x2*)(CBs + (wm * 32 + m * 16 + fr) * SSD_PITCH + wn * 64 + n * 16 + fq * 4) = w; }
        }
        __syncthreads();
        for (int hh = 0; hh < 8; ++hh) {
            const int h = g * 8 + hh, ch0 = g * 512 + hh * 64;
#ifdef DEBUG_NAN
            for (int i = tid; i < 1024; i += NBLK) DBG_SUB(nonfin(acum[i]), hh == 0 ? 74 : 73);
#endif
            for (int ci = tid; ci < 2048; ci += NBLK) {
                const int i = ci >> 4, j0 = (ci & 15) * 8; const float ai = acum[i * 8 + hh];
                float v[8]; ld8(CBs + i * SSD_PITCH + j0, v);
#ifdef DEBUG_NAN
                for (int e = 0; e < 8; ++e) DBG_SUB(nonfin(v[e]), 78);
#endif
#pragma unroll
                for (int e = 0; e < 8; ++e) { const int j = j0 + e; v[e] = (j <= i) ? v[e] * expf(ai - acum[j * 8 + hh]) : 0.f; }
#ifdef DEBUG_NAN
                for (int e = 0; e < 8; ++e) DBG_SUB(nonfin(v[e]), 53);
                DBG_SUB(nonfin(ai), 54);
#endif
                st8(BL + i * SSD_PITCH + j0, v);
            }
            for (int ci = tid; ci < 1024; ci += NBLK) {
                const int j = ci & 127, p0 = (ci >> 7) * 8; const float d = dtv[j * 8 + hh];
                float v[8]; ld8(XC + (size_t)(tok0 + j) * 1536 + ch0 + p0, v);
#pragma unroll
                for (int e = 0; e < 8; ++e) XT[(p0 + e) * SSD_PITCH + j] = f2bf(v[e] * d);
            }
            __syncthreads();
            f32x4 ad[2][2], ao[2][2];
#pragma unroll
            for (int m = 0; m < 2; ++m)
#pragma unroll
                for (int n = 0; n < 2; ++n) { ad[m][n] = (f32x4){0.f, 0.f, 0.f, 0.f}; ao[m][n] = (f32x4){0.f, 0.f, 0.f, 0.f}; }
            const bf16_t* pv = PREV + ((size_t)((b * 64 + c) * 16 + h)) * 8192;
#pragma unroll
            for (int ks = 0; ks < 4; ++ks) {
                bf16x8 al[2], ac[2], bx[2], bp[2];
#pragma unroll
                for (int m = 0; m < 2; ++m) { al[m] = *(const bf16x8*)(BL + (wm * 32 + m * 16 + fr) * SSD_PITCH + ks * 32 + fq * 8);
                                              ac[m] = *(const bf16x8*)(Cs + (wm * 32 + m * 16 + fr) * SSD_PITCH + ks * 32 + fq * 8); }
#pragma unroll
                for (int n = 0; n < 2; ++n) { bx[n] = *(const bf16x8*)(XT + (wn * 32 + n * 16 + fr) * SSD_PITCH + ks * 32 + fq * 8);
                                              bp[n] = *(const bf16x8*)(pv + (wn * 32 + n * 16 + fr) * 128 + ks * 32 + fq * 8); }
#pragma unroll
                for (int m = 0; m < 2; ++m)
#pragma unroll
                    for (int n = 0; n < 2; ++n) { ad[m][n] = mfma16(bx[n], al[m], ad[m][n]); ao[m][n] = mfma16(bp[n], ac[m], ao[m][n]); }
#ifdef DEBUG_NAN
                for (int m = 0; m < 2; ++m) for (int e = 0; e < 8; ++e) { DBG_SUB(((unsigned short)al[m][e] & 0x7f80u) == 0x7f80u, 50); DBG_SUB(((unsigned short)bx[m][e] & 0x7f80u) == 0x7f80u, 51); }
#endif
            }
            const float dsk = p.ssm_d[h];
#pragma unroll
            for (int m = 0; m < 2; ++m) {
                const float ea = expf(acum[(wm * 32 + m * 16 + fr) * 8 + hh]);
                unsigned char* bb = g_lds + SO_PATCH + wave * 2304;
#pragma unroll
                for (int n = 0; n < 2; ++n) *(f32x4*)(bb + fr * 144 + n * 64 + fq * 16) = ad[m][n] + ao[m][n] * ea;
                const int r2 = lane >> 2, c2 = lane & 3, i = wm * 32 + m * 16 + r2, pc = wn * 32 + c2 * 8;
                const f32x4 t0 = *(const f32x4*)(bb + r2 * 144 + c2 * 32), t1 = *(const f32x4*)(bb + r2 * 144 + c2 * 32 + 16);
                const u32x4 xw = *(const u32x4*)(XC + (size_t)(tok0 + i) * 1536 + ch0 + pc);
                const u32x4 zw = *(const u32x4*)(Z0 + (size_t)(tok0 + i) * LD0 + 2048 + ch0 + pc);
                float xs[8], zz[8]; up8(xw, xs); up8(zw, zz);
                const float t[8] = {t0.x, t0.y, t0.z, t0.w, t1.x, t1.y, t1.z, t1.w};
                float y[8], ssq = 0.f;
#pragma unroll
                for (int e = 0; e < 8; ++e) { y[e] = (t[e] + dsk * xs[e]) * siluf(zz[e]); ssq += y[e] * y[e]; }
                st8(MIX + (size_t)(tok0 + i) * 2048 + 1024 + ch0 + pc, y);
                ssq += __shfl_xor(ssq, 1); ssq += __shfl_xor(ssq, 2);
                if (c2 == 0) sspart[i * 16 + hh * 2 + wn] = ssq;
            }
            __syncthreads();
        }
        if (tid < 128) { float s = 0.f;
#pragma unroll
            for (int k2 = 0; k2 < 16; ++k2) s += sspart[tid * 16 + k2];
            rstd[tid] = rsqrtf(s * (1.f / 512.f) + EPS); }
        WAIT_VM0();
        __syncthreads();
#pragma unroll 4
        for (int k2 = 0; k2 < 16; ++k2) {
            const int ci = tid + k2 * NBLK, i = ci >> 6, cc = g * 512 + (ci & 63) * 8; const float rs = rstd[i];
            bf16_t* yp = MIX + (size_t)(tok0 + i) * 2048 + 1024 + cc;
            const u32x4 yw = *(const u32x4*)yp; const f32x4 g0 = *(const f32x4*)(p.ssm_norm + cc), g1 = *(const f32x4*)(p.ssm_norm + cc + 4);
            if (FP8_OUT0) { u32x2 w8; w8.x = pk4_fp8(bflo(yw.x) * rs * g0.x, bfhi(yw.x) * rs * g0.y, bflo(yw.y) * rs * g0.z, bfhi(yw.y) * rs * g0.w);
                w8.y = pk4_fp8(bflo(yw.z) * rs * g1.x, bfhi(yw.z) * rs * g1.y, bflo(yw.w) * rs * g1.z, bfhi(yw.w) * rs * g1.w);
                *(u32x2*)(ws + OFF_H + (size_t)(tok0 + i) * 2048 + 1024 + cc) = w8; }
            else { u32x4 w; w.x = pk_bf16(bflo(yw.x) * rs * g0.x, bfhi(yw.x) * rs * g0.y); w.y = pk_bf16(bflo(yw.y) * rs * g0.z, bfhi(yw.y) * rs * g0.w);
                w.z = pk_bf16(bflo(yw.z) * rs * g1.x, bfhi(yw.z) * rs * g1.y); w.w = pk_bf16(bflo(yw.w) * rs * g1.z, bfhi(yw.w) * rs * g1.w);
                *(u32x4*)yp = w; }
        }
    }
}

DEV void ph_router(const Params& p, int layer, const float* X, int vb, int nvb) {
    unsigned char* ws = p.ws;
    const float* gnorm = p.ffn_norm + layer * 2048;
    const bf16_t* WRB = (const bf16_t*)(ws + OFF_WRT) + (size_t)layer * 327680;
    bf16_t* H = (bf16_t*)(ws + OFF_H); float* RSTD = (float*)(ws + OFF_RSTD);
    unsigned* cnt = (unsigned*)(ws + OFF_CTL) + CW_CNT + layer * 64;
    unsigned* LIST = (unsigned*)(ws + OFF_LIST) + (size_t)layer * 64 * 16384;
    float* GATE = (float*)(ws + OFF_GATE) + (size_t)layer * 32768;
    float* PART = (float*)g_lds;
    float* SSP = (float*)(g_lds + 147456);
    const int tid = TIDX, wave = tid >> 6, lane = tid & 63, fr = lane & 15, fq = lane >> 4;
    for (int rb = vb; rb < NTOK / 64; rb += nvb) {
        const int row0 = rb * 64;
        __syncthreads();
        f32x4 acc[4][5]; float ssq[4] = {0.f, 0.f, 0.f, 0.f};
#pragma unroll
        for (int mt = 0; mt < 4; ++mt)
#pragma unroll
            for (int nt = 0; nt < 5; ++nt) acc[mt][nt] = (f32x4){0.f, 0.f, 0.f, 0.f};
        f32x4 xr[4][2];
#define RT_XLOAD(mt_, ks_) do { const size_t ro_ = (size_t)(row0 + (mt_) * 16 + fr) * DM + (wave * 8 + (ks_)) * 32 + fq * 8; xr[mt_][0] = *(const f32x4*)(X + ro_); xr[mt_][1] = *(const f32x4*)(X + ro_ + 4); } while (0)
#pragma unroll
        for (int mt = 0; mt < 4; ++mt) RT_XLOAD(mt, 0);
#pragma unroll 1
        for (int ks = 0; ks < 8; ++ks) {
          {
            const int kg = wave * 8 + ks, kb = kg * 32 + fq * 8;
            const bf16_t* bp = WRB + ((size_t)kg * 10 * 64 + lane) * 8;
            bf16x8 bh[5], bl[5];
#pragma unroll
            for (int nt = 0; nt < 5; ++nt) { bh[nt] = *(const bf16x8*)(bp + nt * 512); bl[nt] = *(const bf16x8*)(bp + (5 + nt) * 512); }
            const f32x4 g0 = *(const f32x4*)(gnorm + kb), g1 = *(const f32x4*)(gnorm + kb + 4);
#pragma unroll
            for (int mt = 0; mt < 4; ++mt) {
                const size_t ro = (size_t)(row0 + mt * 16 + fr) * DM + kb;
                const f32x4 x0 = xr[mt][0], x1 = xr[mt][1];
                ssq[mt] += x0.x * x0.x + x0.y * x0.y + x0.z * x0.z + x0.w * x0.w + x1.x * x1.x + x1.y * x1.y + x1.z * x1.z + x1.w * x1.w;
                u32x4 hh; hh.x = pk_bf16(x0.x, x0.y); hh.y = pk_bf16(x0.z, x0.w); hh.z = pk_bf16(x1.x, x1.y); hh.w = pk_bf16(x1.z, x1.w);
                u32x4 ll; ll.x = pk_bf16(x0.x - bflo(hh.x), x0.y - bfhi(hh.x)); ll.y = pk_bf16(x0.z - bflo(hh.y), x0.w - bfhi(hh.y));
                ll.z = pk_bf16(x1.x - bflo(hh.z), x1.y - bfhi(hh.z)); ll.w = pk_bf16(x1.z - bflo(hh.w), x1.w - bfhi(hh.w));
                u32x2 hw; hw.x = pk4_fp8(x0.x * g0.x, x0.y * g0.y, x0.z * g0.z, x0.w * g0.w); hw.y = pk4_fp8(x1.x * g1.x, x1.y * g1.y, x1.z * g1.z, x1.w * g1.w);
                *(u32x2*)((unsigned char*)H + ro) = hw;
                if (ks + 1 < 8) RT_XLOAD(mt, ks + 1);
                const bf16x8 xh = __builtin_bit_cast(bf16x8, hh), xl = __builtin_bit_cast(bf16x8, ll);
#pragma unroll
                for (int nt = 0; nt < 5; ++nt) { acc[mt][nt] = mfma16(xh, bh[nt], acc[mt][nt]); acc[mt][nt] = mfma16(xl, bh[nt], acc[mt][nt]); acc[mt][nt] = mfma16(xh, bl[nt], acc[mt][nt]); }
            }
          }
        }
#undef RT_XLOAD
#pragma unroll
        for (int mt = 0; mt < 4; ++mt) {
#pragma unroll
            for (int nt = 0; nt < 5; ++nt) {
                const int col = nt * 16 + fr;
                if (col < 72) {
#pragma unroll
                    for (int j = 0; j < 4; ++j) PART[(wave * 64 + mt * 16 + fq * 4 + j) * 72 + col] = acc[mt][nt][j];
                }
            }
            float sq = ssq[mt]; sq += __shfl_xor(sq, 16); sq += __shfl_xor(sq, 32);
            if (fq == 0) SSP[wave * 64 + mt * 16 + fr] = sq;
        }
        __syncthreads();
        {
            const int row = tid >> 3, c0 = (tid & 7) * 9;
            float ss = 0.f;
#pragma unroll
            for (int w = 0; w < 8; ++w) ss += SSP[w * 64 + row];
            const float rs = rsqrtf(ss * (1.f / DM) + EPS);
            float sum[9];
#pragma unroll
            for (int c = 0; c < 9; ++c) { float t = 0.f;
#pragma unroll
                for (int w = 0; w < 8; ++w) t += PART[(w * 64 + row) * 72 + c0 + c];
                sum[c] = t * rs; }
#pragma unroll
            for (int c = 0; c < 9; ++c) PART[row * 72 + c0 + c] = sum[c];
            if ((tid & 7) == 0) RSTD[row0 + row] = rs;
        }
        __syncthreads();
        if (tid < 64) {
            const int row = row0 + tid; const float* lg = PART + tid * 72;
            int gi = 0; float gm = lg[0];
            for (int k = 1; k < 8; ++k) if (lg[k] > gm) { gm = lg[k]; gi = k; }
            float se = 0.f; for (int k = 0; k < 8; ++k) se += expf(lg[k] - gm);
            const float pg = 1.f / se;
            const float* el = lg + 8 + gi * 8;
            int i1 = 0; float v1 = el[0];
            for (int k = 1; k < 8; ++k) if (el[k] > v1) { v1 = el[k]; i1 = k; }
            int i2 = -1; float v2 = -INFINITY;
            for (int k = 0; k < 8; ++k) if (k != i1 && el[k] > v2) { v2 = el[k]; i2 = k; }
            const float e2 = expf(v2 - v1), w1 = 1.f / (1.f + e2), w2 = e2 / (1.f + e2);
            const int ea = gi * 8 + i1, eb = gi * 8 + i2;
            GATE[row * 2] = pg * w1; GATE[row * 2 + 1] = pg * w2;
            const unsigned p1 = atomicAdd(&cnt[ea], 1u); LIST[(size_t)ea * 16384 + p1] = (unsigned)(row * 2);
            const unsigned p2 = atomicAdd(&cnt[eb], 1u); LIST[(size_t)eb * 16384 + p2] = (unsigned)(row * 2 + 1);
        }
    }
}

constexpr int MOE_TB = 132 * 1024;
DEV int moe_prefix(const unsigned* cnt) {
    int* tb = (int*)(g_lds + MOE_TB);
    __syncthreads();
    if (TIDX < 64) {
        const int lane = TIDX;
        const int t = (int)((__hip_atomic_load(cnt + lane, __ATOMIC_RELAXED, __HIP_MEMORY_SCOPE_AGENT) + 255u) >> 8);
        int incl = t;
#pragma unroll
        for (int off = 1; off < 64; off <<= 1) { const int v = __shfl_up(incl, off); if (lane >= off) incl += v; }
        tb[lane] = incl - t; if (lane == 63) tb[64] = incl;
    }
    __syncthreads();
    return tb[64];
}
struct MoeSched {
    struct Unit { int e, mt, nt, ce, slot0; };
    const int* tb; const unsigned* cnt; const unsigned* LIST; const bf16_t* A; const bf16_t* W; size_t wstride; int NT, K, G, c, total;
    DEV bool next(int i, Unit& u) const {
        int id;
        if ((G & 7) == 0) { const int k = i * (G >> 3) + (c >> 3); id = (((k >> 2) << 3) + (c & 7)) * 4 + (k & 3); } else id = i * G + c;
        if (id >= total * NT) return false;
        int e = 0, hi = 63; while (e < hi) { const int mid = (e + hi + 1) >> 1; if (tb[mid] * NT <= id) e = mid; else hi = mid - 1; }
        const int te = tb[e + 1] - tb[e], local = id - tb[e] * NT;
        u.e = e; u.nt = local / te; u.mt = local - u.nt * te; u.ce = (int)cnt[e]; u.slot0 = (tb[e] + u.mt) * 256; return true;
    }
    DEV const char* B0(const Unit& u) const { return (const char*)W + (size_t)u.e * wstride + (size_t)u.nt * 256 * K; }
    DEV const char* A0(const Unit& u) const { return (const char*)A + (size_t)u.slot0 * K; }
    DEV const char* Abase() const { return (const char*)A; }
    DEV bool half1(const Unit& u) const { return u.mt * 256 + 128 < u.ce; }
    DEV unsigned rowoff(const Unit& u, int r) const {
        const int idx = u.mt * 256 + r; const unsigned a = LIST[(size_t)u.e * 16384 + (idx < u.ce ? idx : 0)];
        return (a >> 1) * (unsigned)K; }
};
struct EpiGU { bf16_t* HID; const unsigned* LIST; const float* RSTD; unsigned* TSLOT;
    DEV void operator()(const f32x4 (&acc)[2][2][4][2], const MoeSched::Unit& u, int wr, int wc, int fr, int fq) const {
#pragma unroll
        for (int ai = 0; ai < 2; ++ai)
#pragma unroll
            for (int m = 0; m < 4; ++m) {
                const int r = ai * 128 + wr * 64 + m * 16 + fr;
                float rs = 0.f;
                if (u.mt * 256 + r < u.ce) {
                    const unsigned a = LIST[(size_t)u.e * 16384 + u.mt * 256 + r]; rs = RSTD[a >> 1] * 0.03125f;
                    if (u.nt == 0 && wc == 0 && fq == 0) TSLOT[a] = (unsigned)(u.slot0 + r);
                }
                unsigned char* bb = g_lds + g8::EPI_LDS + (wr * 4 + wc) * g8::EPI_WAVE + (m & 1) * g8::EPI_PATCH;
#pragma unroll
                for (int n = 0; n < 2; ++n) {
                    const f32x4 gg = acc[ai][0][m][n] * rs, uu = acc[ai][1][m][n] * rs;
                    *(unsigned*)(bb + fr * 40 + n * 16 + fq * 4) = pk4_fp8(siluf(gg.x) * uu.x, siluf(gg.y) * uu.y, siluf(gg.z) * uu.z, siluf(gg.w) * uu.w);
                }
                const int lane = fq * 16 + fr, r2 = lane >> 2, c2 = lane & 3;
                const u32x2 o = *(const u32x2*)(bb + r2 * 40 + c2 * 8);
                *(u32x2*)((unsigned char*)HID + (size_t)(u.slot0 + ai * 128 + wr * 64 + m * 16 + r2) * 512 + u.nt * 128 + wc * 32 + c2 * 8) = o;
            }
    } };
struct EpiDown { bf16_t* Y;
    DEV void operator()(const f32x4 (&acc)[2][2][4][2], const MoeSched::Unit& u, int wr, int wc, int fr, int fq) const {
#pragma unroll
        for (int ai = 0; ai < 2; ++ai)
#pragma unroll
            for (int m = 0; m < 4; ++m) {
                const int lane = fq * 16 + fr, r2 = lane >> 2, c2 = lane & 3;
                unsigned char* yp = (unsigned char*)Y + (size_t)(u.slot0 + ai * 128 + wr * 64 + m * 16 + r2) * 2048 + u.nt * 256 + wc * 32 + c2 * 8;
#pragma unroll
                for (int bj = 0; bj < 2; ++bj) {
                    unsigned char* bb = g_lds + g8::EPI_LDS + (wr * 4 + wc) * g8::EPI_WAVE + bj * g8::EPI_PATCH;
#pragma unroll
                    for (int n = 0; n < 2; ++n) {
                        const f32x4 v = (MX_DOWN == 2) ? acc[ai][bj][m][n] : acc[ai][bj][m][n] * 0.25f;
                        *(unsigned*)(bb + fr * 40 + n * 16 + fq * 4) = pk4_fp8(v.x, v.y, v.z, v.w);
                    }
                    *(u32x2*)(yp + bj * 128) = *(const u32x2*)(bb + r2 * 40 + c2 * 8);
                }
            }
    } };
DEV void ph_moe_gu(const Params& p, int layer, int vb, int nvb) {
    unsigned char* ws = p.ws;
    const unsigned* cnt = (const unsigned*)(ws + OFF_CTL) + CW_CNT + layer * 64;
    const int total = __builtin_amdgcn_readfirstlane(moe_prefix(cnt));
    MoeSched S; S.tb = (const int*)(g_lds + MOE_TB); S.cnt = cnt; S.LIST = (const unsigned*)(ws + OFF_LIST) + (size_t)layer * 64 * 16384; S.total = total;
    S.A = (const bf16_t*)(ws + OFF_H); S.W = (const bf16_t*)(ws + OFF_WGU + (size_t)layer * 64 * 1024 * 2048); S.wstride = (size_t)1024 * 2048;   S.NT = 4; S.K = 2048; S.G = nvb; S.c = vb;
    EpiGU E{(bf16_t*)(ws + OFF_HID), S.LIST, (const float*)(ws + OFF_RSTD), (unsigned*)(ws + OFF_TSLOT)};
    g8::gemm_phase<true, EpiGU, MoeSched, MX_GU>(2048, S, E);
}
DEV void ph_moe_down(const Params& p, int layer, int vb, int nvb) {
    unsigned char* ws = p.ws;
    const unsigned* cnt = (const unsigned*)(ws + OFF_CTL) + CW_CNT + layer * 64;
    const int total = __builtin_amdgcn_readfirstlane(moe_prefix(cnt));
    MoeSched S; S.tb = (const int*)(g_lds + MOE_TB); S.cnt = cnt; S.LIST = (const unsigned*)(ws + OFF_LIST) + (size_t)layer * 64 * 16384; S.total = total;
    S.A = (const bf16_t*)(ws + OFF_HID); S.W = (const bf16_t*)(ws + OFF_WD + (size_t)layer * 64 * 2048 * 512); S.wstride = (size_t)2048 * 512;   S.NT = 8; S.K = 512; S.G = nvb; S.c = vb;
    EpiDown E{(bf16_t*)(ws + OFF_Y)};
    g8::gemm_phase<false, EpiDown, MoeSched, MX_DOWN, 2>(512, S, E);
}

DEV void ph_combine(const Params& p, int layer, float* X, const float* g  , int vb, int nvb) {
    const bf16_t* Y = (const bf16_t*)(p.ws + OFF_Y); bf16_t* H = (bf16_t*)(p.ws + OFF_H); unsigned char* H8 = p.ws + OFF_MIX;
    const unsigned* TSLOT = (const unsigned*)(p.ws + OFF_TSLOT); const float* GATE = (const float*)(p.ws + OFF_GATE) + (size_t)layer * 32768;
    const int wave = TIDX >> 6, lane = TIDX & 63;
    for (int row = vb * 8 + wave; row < NTOK; row += nvb * 8) {
        f32x4 v[8]; float ss = 0.f;
        const size_t r0 = (size_t)TSLOT[2 * row] * DM, r1 = (size_t)TSLOT[2 * row + 1] * DM; const float g0 = GATE[2 * row] * 0.25f, g1 = GATE[2 * row + 1] * 0.25f;
        const unsigned char* Y8 = (const unsigned char*)Y;
#pragma unroll
        for (int i = 0; i < 8; ++i) {
            const int c = (i * 64 + lane) * 4;
            f32x4 x4 = *(const f32x4*)(X + (size_t)row * DM + c);
            const f32x4 y0 = up4_fp8(*(const unsigned*)(Y8 + r0 + c)), y1 = up4_fp8(*(const unsigned*)(Y8 + r1 + c));
            x4.x += g0 * y0.x + g1 * y1.x; x4.y += g0 * y0.y + g1 * y1.y; x4.z += g0 * y0.z + g1 * y1.z; x4.w += g0 * y0.w + g1 * y1.w;
            *(f32x4*)(X + (size_t)row * DM + c) = x4; v[i] = x4;
            ss += x4.x * x4.x + x4.y * x4.y + x4.z * x4.z + x4.w * x4.w;
        }
        if (g) {
            ss = wave_sum(ss); const float r = rsqrtf(ss * (1.f / DM) + EPS);
#pragma unroll
            for (int i = 0; i < 8; ++i) { const f32x4 g4 = ((const f32x4*)g)[i * 64 + lane];
                u32x2 w; w.x = pk_bf16(v[i].x * r * g4.x, v[i].y * r * g4.y); w.y = pk_bf16(v[i].z * r * g4.z, v[i].w * r * g4.w);
                *(u32x2*)(H + (size_t)row * DM + (i * 64 + lane) * 4) = w;
                *(unsigned*)(H8 + (size_t)row * DM + (i * 64 + lane) * 4) = pk4_fp8(v[i].x * r * g4.x, v[i].y * r * g4.y, v[i].z * r * g4.z, v[i].w * r * g4.w); }
        }
    }
}

typedef short s16x4 __attribute__((ext_vector_type(4)));
DEV bf16x8 tr_frag(const bf16_t* tile, int pitch, int k0, int n0, int lane) {
    const int t16 = lane & 15, kq = lane >> 4;
    const bf16_t* a = tile + (k0 + 8 * kq + (t16 >> 2)) * pitch + n0 + (t16 & 3) * 4;
    const s16x4 lo = __builtin_amdgcn_ds_read_tr16_b64_v4i16((LAS s16x4*)a);
    const s16x4 hi = __builtin_amdgcn_ds_read_tr16_b64_v4i16((LAS s16x4*)(a + 4 * pitch));
    return (bf16x8){lo[0], lo[1], lo[2], lo[3], hi[0], hi[1], hi[2], hi[3]};
}
#if VG_FP8
typedef u32x2 vg8_t;
DEV vg8_t ld_vg8(const bf16_t* Z1, size_t tok, int e8) { return *(const u32x2*)((const unsigned char*)Z1 + tok * (size_t)(LD1 * 2) + 8192 + e8); }
DEV u32x4 vg8_bf(vg8_t w) { return __builtin_bit_cast(u32x4, fp8x8_to_bf16(w)); }
#else
typedef u32x4 vg8_t;
DEV vg8_t ld_vg8(const bf16_t* Z1, size_t tok, int e8) { return *(const u32x4*)(Z1 + tok * LD1 + 4096 + e8); }
DEV u32x4 vg8_bf(vg8_t w) { return w; }
#endif
DEV float ret_lg(int h) { return log1pf(-exp2f(-5.f - (float)h)); }
DEV void ph_rope1(const Params& p, int vb, int nvb) {
    bf16_t* Z1 = (bf16_t*)(p.ws + OFF_Z);
    const int wave = TIDX >> 6, lane = TIDX & 63;
    const float L2T = 13.287712379549449f;
    const float inv0 = exp2f(-(float)(2 * lane) * (1.f / 128.f) * L2T), inv1 = exp2f(-(float)(2 * lane + 1) * (1.f / 128.f) * L2T);
    for (int tok = vb * 8 + wave; tok < NTOK; tok += nvb * 8) {
        const float posf = (float)p.pos[tok];
        float s0, c0, s1, c1; sincosf(posf * inv0, &s0, &c0); sincosf(posf * inv1, &s1, &c1);
        bf16_t* z = Z1 + (size_t)tok * LD1;
#pragma unroll
        for (int hq = 0; hq < 16; ++hq) {
            bf16_t* hp = z + hq * 256 + 2 * lane;
            const unsigned a = *(const unsigned*)hp, b2 = *(const unsigned*)(hp + 128);
            const float x10 = bflo(a), x11 = bfhi(a), x20 = bflo(b2), x21 = bfhi(b2);
            const float sc = hq >= 8 ? 0.0625f : 1.f;
            *(unsigned*)hp = pk_bf16((x10 * c0 - x20 * s0) * sc, (x11 * c1 - x21 * s1) * sc);
            *(unsigned*)(hp + 128) = pk_bf16((x20 * c0 + x10 * s0) * sc, (x21 * c1 + x11 * s1) * sc);
        }
    }
}

DEV void ph_ret_kv(const Params& p, int vb, int nvb) {
    const bf16_t* Z1 = (const bf16_t*)(p.ws + OFF_Z); bf16_t* KVL = (bf16_t*)(p.ws + OFF_KVLOC);
    constexpr int TP = 272;
    bf16_t* Vs = (bf16_t*)g_lds; bf16_t* Ks = (bf16_t*)(g_lds + 69632);
    const int tid = TIDX, wave = tid >> 6, lane = tid & 63, fr = lane & 15, fq = lane >> 4, wm = wave >> 1, wn = wave & 1;
    for (int u = vb; u < 1024; u += nvb) {
        const int c = u & 63, h = (u >> 6) & 7, b = u >> 9, tok0 = b * SEQ + c * 128;
        const float lg = ret_lg(h);
        __syncthreads();
        vg8_t vpre[8];
#pragma unroll
        for (int k2 = 0; k2 < 8; ++k2) {
            const int ci = tid + k2 * NBLK, j = ci >> 5, d0 = (ci & 31) * 8; const float dec = expf((float)(127 - j) * lg);
            float v[8]; ld8(Z1 + (size_t)(tok0 + j) * LD1 + 2048 + h * 256 + d0, v);
#pragma unroll
            for (int e = 0; e < 8; ++e) v[e] *= dec;
            st8(Ks + j * TP + d0, v);
            vpre[k2] = ld_vg8(Z1, (size_t)(tok0 + j), h * 512 + d0);
        }
#pragma unroll 1
        for (int vh = 0; vh < 2; ++vh) {
            if (vh > 0) __syncthreads();
#pragma unroll
            for (int k2 = 0; k2 < 8; ++k2) { const int ci = tid + k2 * NBLK, j = ci >> 5, d0 = (ci & 31) * 8; *(u32x4*)(Vs + j * TP + d0) = vg8_bf(vpre[k2]); }
            __syncthreads();
            if (vh == 0) {
#pragma unroll
                for (int k2 = 0; k2 < 8; ++k2) { const int ci = tid + k2 * NBLK, j = ci >> 5, d0 = (ci & 31) * 8; vpre[k2] = ld_vg8(Z1, (size_t)(tok0 + j), h * 512 + 256 + d0); }
            }
            f32x4 acc[4][8];
#pragma unroll
            for (int m = 0; m < 4; ++m)
#pragma unroll
                for (int n = 0; n < 8; ++n) acc[m][n] = (f32x4){0.f, 0.f, 0.f, 0.f};
#pragma unroll 1
            for (int ks = 0; ks < 4; ++ks) {
                bf16x8 af[4];
#pragma unroll
                for (int m = 0; m < 4; ++m) af[m] = tr_frag(Vs, TP, ks * 32, wm * 64 + m * 16, lane);
#pragma unroll
                for (int n = 0; n < 8; ++n) { const bf16x8 bfr = tr_frag(Ks, TP, ks * 32, wn * 128 + n * 16, lane);
#pragma unroll
                    for (int m = 0; m < 4; ++m) acc[m][n] = mfma16(bfr, af[m], acc[m][n]); }
            }
#pragma unroll
            for (int m = 0; m < 4; ++m)
#pragma unroll
                for (int n = 0; n < 8; n += 2) {
                    const unsigned x = pk4_fp8(acc[m][n].x * 8.f, acc[m][n].y * 8.f, acc[m][n].z * 8.f, acc[m][n].w * 8.f);
                    const unsigned y = pk4_fp8(acc[m][n + 1].x * 8.f, acc[m][n + 1].y * 8.f, acc[m][n + 1].z * 8.f, acc[m][n + 1].w * 8.f);
                    const auto pr = __builtin_amdgcn_permlane16_swap(x, y, false, false);
                    u32x2 w; w.x = pr[0]; w.y = pr[1];
                    const int vg = vh * 16 + wm * 4 + m, ks = wn * 4 + (n >> 1), fq2 = (fq & 1) * 2 + (fq >> 1);
                    *(u32x2*)((unsigned char*)KVL + ((((size_t)u * 32 + vg) * 8 + ks) * 64 + fq2 * 16 + fr) * 8) = w;
                }
        }
    }
}
DEV void ph_ret_scan(const Params& p, int vb, int nvb) {
    unsigned char* KVL = p.ws + OFF_KVLOC;
    int tz = TIDX; asm volatile("" : "+v"(tz));
    for (int e = vb * NBLK + tz; e < 16 * 16384; e += nvb * NBLK) {
        const int bh = e >> 14, rem = e & 16383; const float cdec = expf(128.f * ret_lg(bh & 7));
        float run[8];
#pragma unroll
        for (int i = 0; i < 8; ++i) run[i] = 0.f;
#pragma unroll 8
        for (int c = 0; c < 64; ++c) {
            unsigned char* sp = KVL + ((size_t)(bh * 64 + c) * 16384 + rem) * 8;
            const u32x2 w = *(const u32x2*)sp;
            u32x2 o; o.x = pk4_fp8(run[0], run[1], run[2], run[3]); o.y = pk4_fp8(run[4], run[5], run[6], run[7]);
            *(u32x2*)sp = o;
            const f32x4 a = up4_fp8(w.x), b2 = up4_fp8(w.y);
            run[0] = run[0] * cdec + a.x; run[1] = run[1] * cdec + a.y; run[2] = run[2] * cdec + a.z; run[3] = run[3] * cdec + a.w;
            run[4] = run[4] * cdec + b2.x; run[5] = run[5] * cdec + b2.y; run[6] = run[6] * cdec + b2.z; run[7] = run[7] * cdec + b2.w;
        }
    }
}
DEV void ph_ret_out(const Params& p, int vb, int nvb) {
    const bf16_t* Z1 = (const bf16_t*)(p.ws + OFF_Z); const bf16_t* KVL = (const bf16_t*)(p.ws + OFF_KVLOC); bf16_t* OG = (bf16_t*)(p.ws + OFF_MIX);
    unsigned char* OG8 = p.ws + OFF_H;
    constexpr int QP = 264, VP = 144, RO_PATCH = 143104;
    bf16_t* Qs = (bf16_t*)g_lds; bf16_t* Ks = (bf16_t*)(g_lds + 67584); bf16_t* Sb = (bf16_t*)(g_lds + 67584); bf16_t* Vq = (bf16_t*)(g_lds + 67584 + 34816);
    float* sspart = (float*)(g_lds + 139264); float* rstd = (float*)(g_lds + 139264 + 2048);
    const int tid = TIDX, wave = tid >> 6, lane = tid & 63, fr = lane & 15, fq = lane >> 4, wm = wave >> 2, wn = wave & 3;
    for (int u = vb; u < 1024; u += nvb) {
        const int c = u & 63, h = (u >> 6) & 7, b = u >> 9, tok0 = b * SEQ + c * 128;
        const float lg = ret_lg(h);
        __syncthreads();
        for (int ci = tid; ci < 4096; ci += NBLK) {
            const int i = ci >> 5, d0 = (ci & 31) * 8; const float dec = expf((float)(i + 1) * lg);
            float v[8]; ld8(Z1 + (size_t)(tok0 + i) * LD1 + h * 256 + d0, v);
#pragma unroll
            for (int e = 0; e < 8; ++e) v[e] *= dec;
            st8(Qs + i * QP + d0, v);
            *(u32x4*)(Ks + i * QP + d0) = *(const u32x4*)(Z1 + (size_t)(tok0 + i) * LD1 + 2048 + h * 256 + d0);
        }
        vg8_t vpre[4];
#pragma unroll
        for (int k2 = 0; k2 < 4; ++k2) { const int ci = tid + k2 * NBLK; vpre[k2] = ld_vg8(Z1, (size_t)(tok0 + (ci >> 4)), h * 512 + (ci & 15) * 8); }
        __syncthreads();
        {
            f32x4 acc[4][2];
#pragma unroll
            for (int m = 0; m < 4; ++m)
#pragma unroll
                for (int n = 0; n < 2; ++n) acc[m][n] = (f32x4){0.f, 0.f, 0.f, 0.f};
#pragma unroll
            for (int ks = 0; ks < 8; ++ks) {
                bf16x8 af[4], bfr[2];
#pragma unroll
                for (int m = 0; m < 4; ++m) af[m] = *(const bf16x8*)(Qs + (wm * 64 + m * 16 + fr) * QP + ks * 32 + fq * 8);
#pragma unroll
                for (int n = 0; n < 2; ++n) bfr[n] = *(const bf16x8*)(Ks + (wn * 32 + n * 16 + fr) * QP + ks * 32 + fq * 8);
#pragma unroll
                for (int m = 0; m < 4; ++m)
#pragma unroll
                    for (int n = 0; n < 2; ++n) acc[m][n] = mfma16(bfr[n], af[m], acc[m][n]);
            }
            __syncthreads();
#pragma unroll
            for (int m = 0; m < 4; ++m)
#pragma unroll
                for (int n = 0; n < 2; ++n) {
                    const int i = wm * 64 + m * 16 + fr, j0 = wn * 32 + n * 16 + fq * 4;
                    float v[4];
#pragma unroll
                    for (int e = 0; e < 4; ++e) { const int j = j0 + e; v[e] = (j <= i) ? acc[m][n][e] * expf(-(float)(j + 1) * lg) : 0.f; }
                    u32x2 w; w.x = pk_bf16(v[0], v[1]); w.y = pk_bf16(v[2], v[3]);
                    *(u32x2*)(Sb + i * SSD_PITCH + j0) = w;
                }
        }
        float ssq[4] = {0.f, 0.f, 0.f, 0.f};
#pragma unroll 1
        for (int q = 0; q < 4; ++q) {
            u32x2 sf8[8][2];
#pragma unroll
            for (int ks = 0; ks < 8; ++ks)
#pragma unroll
                for (int n = 0; n < 2; ++n) sf8[ks][n] = *(const u32x2*)((const unsigned char*)KVL + ((((size_t)u * 32 + q * 8 + wn * 2 + n) * 8 + ks) * 64 + lane) * 8);
            if (q > 0) __syncthreads();
#pragma unroll
            for (int k2 = 0; k2 < 4; ++k2) { const int ci = tid + k2 * NBLK; *(u32x4*)(Vq + (ci >> 4) * VP + (ci & 15) * 8) = vg8_bf(vpre[k2]); }
            __syncthreads();
            if (q < 3) {
#pragma unroll
                for (int k2 = 0; k2 < 4; ++k2) { const int ci = tid + k2 * NBLK; vpre[k2] = ld_vg8(Z1, (size_t)(tok0 + (ci >> 4)), h * 512 + (q + 1) * 128 + (ci & 15) * 8); }
            }
            f32x4 acc[4][2];
#pragma unroll
            for (int m = 0; m < 4; ++m)
#pragma unroll
                for (int n = 0; n < 2; ++n) acc[m][n] = (f32x4){0.f, 0.f, 0.f, 0.f};
#pragma unroll
            for (int ks = 0; ks < 4; ++ks) {
                bf16x8 af[4], bfr[2];
#pragma unroll
                for (int m = 0; m < 4; ++m) af[m] = *(const bf16x8*)(Sb + (wm * 64 + m * 16 + fr) * SSD_PITCH + ks * 32 + fq * 8);
#pragma unroll
                for (int n = 0; n < 2; ++n) bfr[n] = tr_frag(Vq, VP, ks * 32, wn * 32 + n * 16, lane);
#pragma unroll
                for (int m = 0; m < 4; ++m)
#pragma unroll
                    for (int n = 0; n < 2; ++n) acc[m][n] = mfma16(bfr[n], af[m], acc[m][n]);
            }
#pragma unroll
            for (int ks = 0; ks < 8; ++ks) {
                bf16x8 af[4];
#pragma unroll
                for (int m = 0; m < 4; ++m) af[m] = *(const bf16x8*)(Qs + (wm * 64 + m * 16 + fr) * QP + ks * 32 + fq * 8);
                bf16x8 sfr[2];
#pragma unroll
                for (int n = 0; n < 2; ++n) { const f32x4 a = up4_fp8(sf8[ks][n].x) * 0.125f, b2 = up4_fp8(sf8[ks][n].y) * 0.125f;
                    u32x4 w; w.x = pk_bf16(a.x, a.y); w.y = pk_bf16(a.z, a.w); w.z = pk_bf16(b2.x, b2.y); w.w = pk_bf16(b2.z, b2.w); sfr[n] = __builtin_bit_cast(bf16x8, w); }
#pragma unroll
                for (int m = 0; m < 4; ++m)
#pragma unroll
                    for (int n = 0; n < 2; ++n) acc[m][n] = mfma16(sfr[n], af[m], acc[m][n]);
            }
#pragma unroll
            for (int m = 0; m < 4; ++m) {
                unsigned char* bb = g_lds + RO_PATCH + wave * 2560 + (m & 1) * 1280;
#pragma unroll
                for (int n = 0; n < 2; ++n) {
                    const f32x4 a = acc[m][n];
                    ssq[m] += a.x * a.x + a.y * a.y + a.z * a.z + a.w * a.w;
                    u32x2 w; w.x = pk_bf16(a.x, a.y); w.y = pk_bf16(a.z, a.w);
                    *(u32x2*)(bb + fr * 80 + n * 32 + fq * 8) = w;
                }
                const int r2 = lane >> 2, c2 = lane & 3;
                *(u32x4*)(OG + (size_t)(tok0 + wm * 64 + m * 16 + r2) * 4096 + h * 512 + q * 128 + wn * 32 + c2 * 8) = *(const u32x4*)(bb + r2 * 80 + c2 * 16);
            }
        }
#pragma unroll
        for (int m = 0; m < 4; ++m) {
            float s2 = ssq[m];
            s2 += __shfl_xor(s2, 16); s2 += __shfl_xor(s2, 32);
            if (fq == 0) sspart[(wm * 64 + m * 16 + fr) * 4 + wn] = s2;
        }
        WAIT_VM0();
        __syncthreads();
        if (tid < 128) rstd[tid] = rsqrtf((sspart[tid * 4] + sspart[tid * 4 + 1] + sspart[tid * 4 + 2] + sspart[tid * 4 + 3]) * (1.f / 512.f) + EPS);
        __syncthreads();
#pragma unroll 4
        for (int k2 = 0; k2 < 16; ++k2) {
            const int ci = tid + k2 * NBLK, i = ci >> 6, vc = h * 512 + (ci & 63) * 8; const float rs = rstd[i];
            const u32x4 ow = *(const u32x4*)(OG + (size_t)(tok0 + i) * 4096 + vc);
            const u32x4 gw = vg8_bf(ld_vg8(Z1, (size_t)(tok0 + i), 4096 + vc));
            const f32x4 g0 = *(const f32x4*)(p.ret_norm + vc), g1 = *(const f32x4*)(p.ret_norm + vc + 4);
            u32x2 o;
            o.x = pk4_fp8(bflo(ow.x) * rs * g0.x * siluf(bflo(gw.x)), bfhi(ow.x) * rs * g0.y * siluf(bfhi(gw.x)), bflo(ow.y) * rs * g0.z * siluf(bflo(gw.y)), bfhi(ow.y) * rs * g0.w * siluf(bfhi(gw.y)));
            o.y = pk4_fp8(bflo(ow.z) * rs * g1.x * siluf(bflo(gw.z)), bfhi(ow.z) * rs * g1.y * siluf(bfhi(gw.z)), bflo(ow.w) * rs * g1.z * siluf(bflo(gw.w)), bfhi(ow.w) * rs * g1.w * siluf(bfhi(gw.w)));
            *(u32x2*)(OG8 + (size_t)(tok0 + i) * 4096 + vc) = o;
        }
    }
}

__global__ void __launch_bounds__(NBLK, 2) fwd_kernel(Params p) {
    const int vb = blockIdx.x, nvb = gridDim.x;
    unsigned char* ws = p.ws;
    LAS unsigned* xbw = (LAS unsigned*)(g_lds + LDS_BYTES - 16);
    if (TIDX == 0) { xbw[0] = 0u; xbw[1] = 0u; xbw[2] = 0u; xbw[3] = 0u; }
    __syncthreads();
#if N_LAUNCH_MODE == 1
    XcdBarrier bar = xcd_barrier_post((unsigned*)(ws + OFF_CTL) + CW_BAR, (volatile LAS unsigned*)xbw);
#define GRID_BAR() xcd_barrier(bar)
#else
#define GRID_BAR() do {} while (0)
#endif
    const int lo = p.ph_lo, hi = p.ph_hi;
#ifdef ONLY_PHASE
#define IN(k) ((k) == ONLY_PHASE)
#else
#define IN(k) (lo <= (k) && (k) < hi)
#endif
#define SEAM(k) do { if (IN(k) && IN((k) + 1)) GRID_BAR(); } while (0)
    bf16_t* Hb = (bf16_t*)(ws + OFF_H);
    if (IN(0)) { ph_prep(p, vb, nvb, 0); ph_norm(p.x, p.mix_norm, Hb, vb, nvb); } SEAM(0);
    if (IN(1)) {
        const int G = (nvb == 256) ? GEMM_CUS : nvb;
        if (vb < G) ph_gemm8_dense(Hb, (const bf16_t*)(ws + OFF_WIN0), LD0, DM, g8::EpiZ0T{(bf16_t*)(ws + OFF_Z), (float*)(ws + OFF_ZS)}, vb, G);
        ph_prep(p, vb, nvb, 1);
    } SEAM(1);
    if (IN(2)) { ph_post0(p, vb, nvb); } SEAM(2);
#if REPEAT_GROUP == 13
    ph_post0(p, vb, nvb); GRID_BAR();
#endif
    if (IN(3)) { ph_dsa(p, vb, nvb); ph_ssd_states(p, vb, nvb); } SEAM(3);
#if REPEAT_GROUP == 7
    ph_ssd_states(p, vb, nvb); GRID_BAR();
#endif
    if (IN(4)) { ph_ssd_scan(p, vb, nvb); ph_dsa_attn(p, vb, nvb); } SEAM(4);
    if (IN(5)) { ph_ssd_out(p, vb, nvb); } SEAM(5);
#if REPEAT_GROUP == 6
    ph_ssd_scan(p, vb, nvb); GRID_BAR(); ph_ssd_out(p, vb, nvb); GRID_BAR();
#endif
    if (IN(6)) {
        if (FP8_OUT0) { g8::DenseSched S; S.init((const bf16_t*)(ws + OFF_H), (const bf16_t*)(ws + OFF_WOUT0), NTOK, DM, DM, nvb, vb); S.esz = 1; if (REPEAT_GROUP == 16) S.rep = 2;
            g8::EpiResidT E{p.x, p.out, 1.f};
            g8::gemm_phase<false, g8::EpiResidT, g8::DenseSched, 2, 6>(DM, S, E); }
        else ph_gemm8_dense((const bf16_t*)(ws + OFF_MIX), (const bf16_t*)(ws + OFF_WOUT0), DM, DM, g8::EpiResidT{p.x, p.out, 1.f}, vb, nvb); } SEAM(6);
    if (IN(7)) { ph_router(p, 0, p.out, vb, nvb); } SEAM(7);
    if (IN(8)) { ph_moe_gu(p, 0, vb, nvb); } SEAM(8);
    if (IN(9)) { ph_moe_down(p, 0, vb, nvb); } SEAM(9);
    if (IN(10)) { ph_combine(p, 0, p.out, p.mix_norm + DM, vb, nvb); } SEAM(10);
    if (IN(11)) { g8::DenseSched S; S.init(Hb, (const bf16_t*)(ws + OFF_WIN1), NTOK, 4096, DM, nvb, vb); if (REPEAT_GROUP == 17) S.rep = 2; g8::gemm_phase<false>(DM, S, EpiZ1{(bf16_t*)(ws + OFF_Z), (const float*)(ws + OFF_ROPE)}); } SEAM(11);
    if (IN(12)) {
        g8::DenseSched S; S.init((const bf16_t*)(ws + OFF_MIX), (const bf16_t*)(ws + OFF_WIN1 + (size_t)4096 * 2048 * 2), NTOK, 8192, DM, nvb, vb); S.esz = 1; if (REPEAT_GROUP == 18) S.rep = 2;
#if VG_FP8
        g8::EpiF8T<LD1 * 2> E{ws + OFF_Z + 8192};
        g8::gemm_phase<false, g8::EpiF8T<LD1 * 2>, g8::DenseSched, 2, 6>(DM, S, E); } SEAM(12);
#else
        g8::EpiBfT<LD1> E{(bf16_t*)(ws + OFF_Z) + 4096};
        g8::gemm_phase<false, g8::EpiBfT<LD1>, g8::DenseSched, 2, 6>(DM, S, E); } SEAM(12);
#endif
    if (IN(13)) { ph_ret_kv(p, vb, nvb); } SEAM(13);
#if REPEAT_GROUP == 10
    ph_ret_kv(p, vb, nvb); GRID_BAR();
#endif
    if (IN(14)) { ph_ret_scan(p, vb, nvb); } SEAM(14);
    if (IN(15)) { ph_ret_out(p, vb, nvb); } SEAM(15);
#if REPEAT_GROUP == 12
    ph_ret_out(p, vb, nvb); GRID_BAR();
#endif
#if REPEAT_GROUP == 4
    ph_ret_kv(p, vb, nvb); GRID_BAR(); ph_ret_scan(p, vb, nvb); GRID_BAR(); ph_ret_out(p, vb, nvb); GRID_BAR();
#endif
    if (IN(16)) {
        g8::DenseSched S; S.init((const bf16_t*)(ws + OFF_H), (const bf16_t*)(ws + OFF_WOUT1), NTOK, DM, 4096, nvb, vb); S.esz = 1;
        g8::EpiResidT E{p.out, p.out, MX_OUT1 == 2 ? 1.f : 1.f / 64.f};
        g8::gemm_phase<false, g8::EpiResidT, g8::DenseSched, MX_OUT1, 6>(4096, S, E); } SEAM(16);
    if (IN(17)) { ph_router(p, 1, p.out, vb, nvb); } SEAM(17);
    if (IN(18)) { ph_moe_gu(p, 1, vb, nvb); } SEAM(18);
    if (IN(19)) { ph_moe_down(p, 1, vb, nvb); } SEAM(19);
#if REPEAT_GROUP == 5
    if (vb == 0 && TIDX < 64) ((unsigned*)(ws + OFF_CTL))[CW_CNT + 64 + TIDX] = 0u; GRID_BAR();
    ph_router(p, 1, p.out, vb, nvb); GRID_BAR(); ph_moe_gu(p, 1, vb, nvb); GRID_BAR(); ph_moe_down(p, 1, vb, nvb); GRID_BAR();
#endif
#if REPEAT_GROUP == 8
    ph_moe_gu(p, 1, vb, nvb); GRID_BAR();
#endif
#if REPEAT_GROUP == 9
    ph_moe_down(p, 1, vb, nvb); GRID_BAR();
#endif
    if (IN(20)) { ph_combine(p, 1, p.out, nullptr, vb, nvb); }
}


#ifdef DEBUG_NAN
__global__ void dbg_check(const void* p, size_t n, int is_f32, unsigned code, unsigned* flag) {
    size_t i = (size_t)blockIdx.x * blockDim.x + TIDX; const size_t st = (size_t)gridDim.x * blockDim.x;
    bool bad = false;
    if (is_f32) { const unsigned* u = (const unsigned*)p; for (; i < n; i += st) bad |= ((u[i] & 0x7f800000u) == 0x7f800000u); }
    else { const unsigned short* u = (const unsigned short*)p; for (; i < n; i += st) bad |= ((u[i] & 0x7f80u) == 0x7f80u); }
    if (bad) atomicMax(flag, 64u - code);
}
__global__ void dbg_fill(float* out, size_t n, const unsigned* flag) {
    const unsigned f = *flag; const unsigned sub = flag[1]; if (f == 0u && sub == 0u) return;
    const float v = sub ? (float)sub : (float)(64u - f);
    for (size_t i = (size_t)blockIdx.x * blockDim.x + TIDX; i < n; i += (size_t)gridDim.x * blockDim.x) out[i] = v;
}
#endif

extern "C" void kernel_launch(void* const* d_in, const int* in_sizes, int n_in, void* d_out, int out_size, void* d_ws, size_t ws_size, hipStream_t stream) {
    static int grid = 0;
    if (grid == 0) {
        if (n_in != 23 || ws_size < WS_TOTAL) { fprintf(stderr, "kernel_launch: need 23 inputs and %zu ws bytes (got %d, %zu)\n", (size_t)WS_TOTAL, n_in, ws_size); grid = -1; return; }
        int dev = 0, cus = 0;
        hipGetDevice(&dev); hipDeviceGetAttribute(&cus, hipDeviceAttributeMultiprocessorCount, dev);
        if (hipFuncSetAttribute((const void*)fwd_kernel, hipFuncAttributeMaxDynamicSharedMemorySize, LDS_BYTES) != hipSuccess) { fprintf(stderr, "hipFuncSetAttribute failed\n"); grid = -1; return; }
        int per_cu = 0; hipOccupancyMaxActiveBlocksPerMultiprocessor(&per_cu, (const void*)fwd_kernel, NBLK, LDS_BYTES); (void)hipGetLastError();
        grid = cus > 0 ? cus : 256;
    }
    if (grid < 0) return;
    hipMemsetAsync((char*)d_ws + OFF_CTL, 0, 65536, stream);
    Params p{};
    const float** f = (const float**)&p.x;
    (void)f;
    p.x = (const float*)d_in[0]; p.pos = (const int*)d_in[1]; p.mix_norm = (const float*)d_in[2]; p.ffn_norm = (const float*)d_in[3]; p.hyb_w_in = (const float*)d_in[4];
    p.q_norm = (const float*)d_in[5]; p.k_norm = (const float*)d_in[6]; p.kidx_norm = (const float*)d_in[7]; p.conv_w = (const float*)d_in[8]; p.conv_b = (const float*)d_in[9];
    p.dt_bias = (const float*)d_in[10]; p.a_log = (const float*)d_in[11]; p.ssm_d = (const float*)d_in[12]; p.ssm_norm = (const float*)d_in[13]; p.hyb_w_out = (const float*)d_in[14];
    p.ret_w_in = (const float*)d_in[15]; p.ret_norm = (const float*)d_in[16]; p.ret_w_out = (const float*)d_in[17]; p.w_rg = (const float*)d_in[18]; p.w_re = (const float*)d_in[19];
    p.w_gate = (const float*)d_in[20]; p.w_up = (const float*)d_in[21]; p.w_down = (const float*)d_in[22];
    p.out = (float*)d_out; p.ws = (unsigned char*)d_ws;
    constexpr int NPH = 21;
#if N_LAUNCH_MODE == 1
#ifdef PROBE_PHASE
    p.ph_lo = 0; p.ph_hi = PROBE_PHASE + 1; hipLaunchKernelGGL(fwd_kernel, dim3(grid), dim3(NBLK), LDS_BYTES, stream, p);
    hipMemsetAsync((char*)d_ws + OFF_CTL, 0, XCD_BAR_WORDS * 4, stream);
    if (PROBE_PHASE == 4) hipMemsetAsync((char*)d_ws + OFF_CTL + CW_DSAQ * 4, 0, 1024, stream);
    if (PROBE_PHASE == 7 || PROBE_PHASE == 17) hipMemsetAsync((char*)d_ws + OFF_CTL + (CW_CNT + (PROBE_PHASE == 17 ? 64 : 0)) * 4, 0, 256, stream);
    p.ph_lo = PROBE_PHASE; p.ph_hi = PROBE_PHASE + 1; hipLaunchKernelGGL(fwd_kernel, dim3(grid), dim3(NBLK), LDS_BYTES, stream, p);
    hipMemsetAsync((char*)d_ws + OFF_CTL, 0, XCD_BAR_WORDS * 4, stream);
    p.ph_lo = PROBE_PHASE + 1; p.ph_hi = NPH; hipLaunchKernelGGL(fwd_kernel, dim3(grid), dim3(NBLK), LDS_BYTES, stream, p);
#else
    p.ph_lo = 0; p.ph_hi = NPH;
    hipLaunchKernelGGL(fwd_kernel, dim3(grid), dim3(NBLK), LDS_BYTES, stream, p);
#endif
#else
    for (int k = 0; k < NPH; ++k) { p.ph_lo = k; p.ph_hi = k + 1; hipLaunchKernelGGL(fwd_kernel, dim3(grid), dim3(NBLK), LDS_BYTES, stream, p);
#ifdef DEBUG_NAN
        unsigned* flag = (unsigned*)((char*)d_ws + OFF_CTL) + 8000; char* w = (char*)d_ws;
#define CHK(ptr, n, f32) hipLaunchKernelGGL(dbg_check, dim3(1024), dim3(256), 0, stream, (const void*)(ptr), (size_t)(n), (int)(f32), (unsigned)(k + 1), flag)
        switch (k) {
        case 0: CHK(w + OFF_H, (size_t)NTOK * 2048, 0); CHK(w + OFF_WIN0, (OFF_WRT - OFF_WIN0) / 2, 0); CHK(w + OFF_WRT, 2 * 72 * 2048, 1); break;
        case 1: CHK(w + OFF_Z, (size_t)NTOK * LD0, 0); CHK(w + OFF_ZS, (size_t)NTOK * 256, 1); break;
        case 2: CHK(w + OFF_QA, (OFF_WIS - OFF_QA) / 2, 0); CHK(w + OFF_WIS, (OFF_XC - OFF_WIS) / 4, 1); CHK(w + OFF_XC, (size_t)NTOK * 1536, 0); break;
        case 3: CHK(w + OFF_MIX, (size_t)NTOK * 2048, 0); CHK(w + OFF_ST, (size_t)2 * 64 * 16 * 8192, 1); CHK(w + OFF_CD, 2048, 1); break;
        case 4: CHK(w + OFF_PREV, (size_t)2 * 64 * 16 * 8192, 0); break;
        case 5: CHK(w + OFF_MIX, (size_t)NTOK * 2048, 0); break;
        case 6: case 10: case 16: case 20: CHK(d_out, (size_t)NTOK * 2048, 1); break;
        case 7: case 17: CHK(w + OFF_H, (size_t)NTOK * 2048, 0); CHK(w + OFF_GATE, 65536, 1); break;
        case 8: case 18: CHK(w + OFF_HID, (size_t)49152 * 512, 0); break;
        case 9: case 19: CHK(w + OFF_Y, (size_t)32768 * 2048, 0); break;
        case 11: case 12: CHK(w + OFF_Z, (size_t)NTOK * LD1, 0); break;
        case 13: case 14: CHK(w + OFF_KVLOC, (size_t)1024 * 131072, 0); break;
        case 15: CHK(w + OFF_MIX, (size_t)NTOK * 4096, 0); break;
        }
        if (k == NPH - 1) hipLaunchKernelGGL(dbg_fill, dim3(1024), dim3(256), 0, stream, (float*)d_out, (size_t)NTOK * 2048, (const unsigned*)flag);
#endif
    }
#endif
}
```

```cpp
#include <hip/hip_runtime.h>
#include <stdint.h>
#include <stdio.h>

#ifndef MX_OUT1
#define MX_OUT1 2
#endif
#ifndef FP8_OUT0
#define FP8_OUT0 0
#endif
#ifndef VG_FP8
#define VG_FP8 0
#endif
#ifndef QK_FP8
#define QK_FP8 1
#endif
#ifndef MX_GU
#define MX_GU 2
#endif
#ifndef MX_DOWN
#define MX_DOWN 2
#endif
#ifndef REPEAT_GROUP
#define REPEAT_GROUP 0
#endif
#ifndef N_LAUNCH_MODE
#define N_LAUNCH_MODE 1
#endif

typedef unsigned short bf16_t;
typedef short bf16x8 __attribute__((ext_vector_type(8)));
typedef float f32x4 __attribute__((ext_vector_type(4)));
typedef float f32x2 __attribute__((ext_vector_type(2)));
typedef unsigned u32x2 __attribute__((ext_vector_type(2)));
typedef unsigned u32x4 __attribute__((ext_vector_type(4)));
#define DEV __device__ __forceinline__
#define LAS __attribute__((address_space(3)))
__device__ __forceinline__ int tid_opaque() { int t = threadIdx.x; asm volatile("" : "+v"(t)); return t; }
#define TIDX tid_opaque()

constexpr int NTOK = 16384, SEQ = 8192, DM = 2048, NBLK = 512  ;
constexpr int LD0 = 4864;
constexpr int LD1 = 12288;
constexpr float EPS = 1e-6f;
constexpr int LDS_BYTES = 160 * 1024;

constexpr size_t OFF_CTL   = 0;
constexpr size_t OFF_WIN0  = 65536;
constexpr size_t OFF_WOUT0 = OFF_WIN0  + (size_t)4864 * 2048 * 2;
constexpr size_t OFF_WIN1  = OFF_WOUT0 + (size_t)2048 * 2048 * 2;
constexpr size_t OFF_WOUT1 = OFF_WIN1  + (size_t)12288 * 2048 * 2;
constexpr size_t OFF_WGU   = OFF_WOUT1 + (size_t)2048 * 4096 * 2;
constexpr size_t OFF_WD    = OFF_WGU   + (size_t)2 * 64 * 1024 * 2048 * 2;
constexpr size_t OFF_WRT   = OFF_WD    + (size_t)2 * 64 * 2048 * 512 * 2;
constexpr size_t OFF_H     = OFF_WRT   + (size_t)2 * 1024 * 1024;
constexpr size_t OFF_Z     = OFF_H     + (size_t)NTOK * 2048 * 2;
constexpr size_t OFF_HID   = OFF_Z;
constexpr size_t OFF_Y     = OFF_Z + (size_t)64 * 1024 * 1024;
constexpr size_t OFF_MIX   = OFF_Z     + (size_t)NTOK * 12288 * 2;
constexpr size_t OFF_L0    = OFF_MIX   + (size_t)NTOK * 4096 * 2;
constexpr size_t OFF_ZS    = OFF_L0;
constexpr size_t OFF_QA    = OFF_ZS    + (size_t)NTOK * 256 * 4;
constexpr size_t OFF_KV    = OFF_QA    + (size_t)NTOK * 1024 * 2;
constexpr size_t OFF_QIA   = OFF_KV    + (size_t)NTOK * 512 * 2;
constexpr size_t OFF_KIA   = OFF_QIA   + (size_t)NTOK * 512 * 2;
constexpr size_t OFF_WIS   = OFF_KIA   + (size_t)NTOK * 64 * 2;
constexpr size_t OFF_DT    = OFF_WIS   + (size_t)NTOK * 8 * 4;
constexpr size_t OFF_XC    = OFF_DT    + (size_t)NTOK * 16 * 4;
constexpr size_t OFF_ST    = OFF_XC    + (size_t)NTOK * 1536 * 2;
constexpr size_t OFF_PREV  = OFF_ST    + (size_t)2 * 64 * 16 * 64 * 128 * 4;
constexpr size_t OFF_CD    = OFF_PREV  + (size_t)2 * 64 * 16 * 64 * 128 * 2;
constexpr size_t OFF_SELG  = OFF_CD    + 65536;
constexpr size_t L0_END    = OFF_SELG  + (size_t)NTOK * 256 * 2;
constexpr size_t OFF_KVLOC = OFF_L0;
constexpr size_t KVLOC_END = OFF_KVLOC + (size_t)1024 * 512 * 256 * 2;
constexpr size_t OFF_MOE   = (L0_END > KVLOC_END ? L0_END : KVLOC_END);
constexpr size_t OFF_LIST  = OFF_MOE;
constexpr size_t OFF_GATE  = OFF_LIST  + (size_t)2 * 64 * 16384 * 4;
constexpr size_t OFF_RSTD  = OFF_GATE  + (size_t)2 * 32768 * 4;
constexpr size_t OFF_ROPE  = OFF_RSTD  + (size_t)NTOK * 4;
constexpr size_t OFF_TSLOT = OFF_ROPE  + (size_t)NTOK * 256 * 4;
constexpr size_t WS_TOTAL  = OFF_TSLOT + (size_t)32768 * 4;
constexpr int CW_BAR = 0;
constexpr int CW_CNT = 4096;
constexpr int CW_PREPQ = 4224;
constexpr int CW_DSAQ = 4352;

struct Params {
    const float* x; const int* pos; const float* mix_norm; const float* ffn_norm; const float* hyb_w_in; const float* q_norm; const float* k_norm;
    const float* kidx_norm; const float* conv_w; const float* conv_b; const float* dt_bias; const float* a_log; const float* ssm_d; const float* ssm_norm;
    const float* hyb_w_out; const float* ret_w_in; const float* ret_norm; const float* ret_w_out; const float* w_rg; const float* w_re;
    const float* w_gate; const float* w_up; const float* w_down;
    float* out; unsigned char* ws; int ph_lo, ph_hi;
};

DEV float bf2f(bf16_t v) { return __uint_as_float(((unsigned)v) << 16); }
typedef __bf16 bf16x2_t __attribute__((ext_vector_type(2)));
DEV unsigned pk_bf16(float lo, float hi) { f32x2 v = {lo, hi}; bf16x2_t r = __builtin_convertvector(v, bf16x2_t); return __builtin_bit_cast(unsigned, r); }
DEV bf16_t f2bf(float v) { return (bf16_t)(pk_bf16(v, 0.f) & 0xffffu); }
DEV unsigned pk4_fp8(float a, float b, float c, float d) { int r = 0; r = __builtin_amdgcn_cvt_pk_fp8_f32(a, b, r, false); r = __builtin_amdgcn_cvt_pk_fp8_f32(c, d, r, true); return (unsigned)r; }
typedef int i32x8 __attribute__((ext_vector_type(8)));
DEV bf16x8 fp8x8_to_bf16(u32x2 w);
DEV f32x4 up4_fp8(unsigned w) { const f32x2 lo = __builtin_amdgcn_cvt_pk_f32_fp8((int)w, false), hi = __builtin_amdgcn_cvt_pk_f32_fp8((int)w, true); return (f32x4){lo.x, lo.y, hi.x, hi.y}; }
DEV bf16x8 fp8x8_to_bf16(u32x2 w) { const f32x4 a = up4_fp8(w.x), b = up4_fp8(w.y); u32x4 r; r.x = pk_bf16(a.x, a.y); r.y = pk_bf16(a.z, a.w); r.z = pk_bf16(b.x, b.y); r.w = pk_bf16(b.z, b.w); return __builtin_bit_cast(bf16x8, r); }
DEV float bflo(unsigned w) { return __uint_as_float(w << 16); }
DEV float bfhi(unsigned w) { return __uint_as_float(w & 0xffff0000u); }
DEV float wave_sum(float v) { v += __shfl_xor(v, 32); v += __shfl_xor(v, 16); v += __shfl_xor(v, 8); v += __shfl_xor(v, 4); v += __shfl_xor(v, 2); v += __shfl_xor(v, 1); return v; }
DEV float wave_max(float v) { v = fmaxf(v, __shfl_xor(v, 32)); v = fmaxf(v, __shfl_xor(v, 16)); v = fmaxf(v, __shfl_xor(v, 8)); v = fmaxf(v, __shfl_xor(v, 4)); v = fmaxf(v, __shfl_xor(v, 2)); v = fmaxf(v, __shfl_xor(v, 1)); return v; }
DEV float siluf(float v) { return v * __builtin_amdgcn_rcpf(1.f + __expf(-v)); }
DEV f32x4 mfma16(bf16x8 a, bf16x8 b, f32x4 c) { return __builtin_amdgcn_mfma_f32_16x16x32_bf16(a, b, c, 0, 0, 0); }
#define WAIT_VM0() asm volatile("s_waitcnt vmcnt(0)" ::: "memory")

extern __shared__ __attribute__((aligned(16))) unsigned char g_lds[];

#define XB_TMO      128
#define XB_XCNT(j)  (256  + 64 * (j))
#define XB_XSUB(j)  (1280 + 64 * (j))
#define XB_XGEN(j)  (2304 + 64 * (j))
#define XB_TOP      3328
#define XB_TOPGEN   3392
#define XCD_BAR_WORDS 3456
#define XB_SPIN_CAP (1u << 18)
__device__ __forceinline__ unsigned xb_ld(unsigned* p)              { return __hip_atomic_load(p, __ATOMIC_RELAXED, __HIP_MEMORY_SCOPE_AGENT); }
__device__ __forceinline__ unsigned xb_add(unsigned* p, unsigned v) { return __hip_atomic_fetch_add(p, v, __ATOMIC_RELAXED, __HIP_MEMORY_SCOPE_AGENT); }
__device__ __forceinline__ unsigned xb_xcc_id() { return (unsigned)__builtin_amdgcn_s_getreg((3 << 11) | 20) & 0xFu; }
#define XB_SPIN(cond, bar) do { unsigned _sp = 0; while (cond) { __builtin_amdgcn_s_sleep(1); \
    if ((++_sp & 255u) == 0u) { if (xb_ld(&(bar)[XB_TMO])) break; if (_sp > XB_SPIN_CAP) { atomicAdd(&(bar)[XB_TMO], 1u); break; } } } } while (0)
struct XcdBarrier { unsigned* bar; unsigned x; volatile LAS unsigned* st; };
__device__ __forceinline__ XcdBarrier xcd_barrier_post(unsigned* bar, volatile LAS unsigned* st) {
    XcdBarrier b; b.bar = bar; b.x = xb_xcc_id(); b.st = st;
    if (TIDX == 0) (void)xb_add(&bar[XB_XCNT(b.x)], 1u);
    return b;
}
__device__ __forceinline__ void xcd_barrier_complete(unsigned* bar, unsigned x, unsigned& nloc, unsigned& nx) {
    const unsigned G = gridDim.x * gridDim.y * gridDim.z;
    unsigned sum, cnt, mine, sp = 0u;
    for (;;) {
        sum = 0u; cnt = 0u; mine = 0u;
#pragma unroll
        for (unsigned j = 0; j < 16; ++j) { const unsigned c = xb_ld(&bar[XB_XCNT(j)]); sum += c; cnt += (c > 0u) ? 1u : 0u; mine = (j == x) ? c : mine; }
        if (sum == G) break;
        __builtin_amdgcn_s_sleep(1);
        if ((++sp & 255u) == 0u) { if (xb_ld(&bar[XB_TMO])) break; if (sp > XB_SPIN_CAP) { atomicAdd(&bar[XB_TMO], 1u); break; } }
    }
    nloc = mine > 0u ? mine : 1u; nx = cnt > 0u ? cnt : 1u;
}
__device__ __forceinline__ void xcd_barrier(const XcdBarrier& b) {
    asm volatile("s_waitcnt vmcnt(0)" ::: "memory");
    __syncthreads();
    if (TIDX == 0) {
        unsigned* bar = b.bar;
        __builtin_amdgcn_s_waitcnt(0);
        unsigned nloc = b.st[0], nx = b.st[1];
        if (nloc == 0u) { xcd_barrier_complete(bar, b.x, nloc, nx); b.st[0] = nloc; b.st[1] = nx; }
        const unsigned old = xb_add(&bar[XB_XSUB(b.x)], 1u);
        const unsigned gen = old / nloc;
        if (old + 1u == (gen + 1u) * nloc) {
            __builtin_amdgcn_fence(__ATOMIC_RELEASE, "agent");
            asm volatile("s_waitcnt vmcnt(0)" ::: "memory");
            const unsigned og = xb_add(&bar[XB_TOP], 1u);
            const unsigned tg = og / nx;
            if (og + 1u == (tg + 1u) * nx) xb_add(&bar[XB_TOPGEN], 1u);
            else XB_SPIN(xb_ld(&bar[XB_TOPGEN]) == tg, bar);
            __builtin_amdgcn_fence(__ATOMIC_ACQUIRE, "agent");
            xb_add(&bar[XB_XGEN(b.x)], 1u);
            asm volatile("s_waitcnt vmcnt(0)" ::: "memory");
        } else {
            XB_SPIN(xb_ld(&bar[XB_XGEN(b.x)]) == gen, bar);
            __builtin_amdgcn_fence(__ATOMIC_ACQUIRE, "agent");
            asm volatile("s_waitcnt vmcnt(0)" ::: "memory");
        }
    }
    __syncthreads();
}

DEV void st8(bf16_t* p, const float (&v)[8]);
struct ConvJob { const float* src; int ldsrc; bf16_t* dst; int K; float f8scale; };
template <class ColPtr>
DEV ConvJob conv_job(ColPtr cp, int ldsrc, bf16_t* dst, int K, int n0, int k0) {
    const int tid = TIDX, wid = tid >> 6, lane = tid & 63, r = tid >> 2, kq = tid & 3;
    const float* c = cp(n0 + 4 * lane);
    ConvJob j; j.src = c ? c + (size_t)(k0 + wid * 8) * ldsrc : nullptr; j.ldsrc = ldsrc; j.dst = dst + (size_t)(n0 + r) * K + k0 + kq * 16; j.K = K; j.f8scale = 0.f; return j;
}
template <class ColPtr>
DEV ConvJob conv_job8(ColPtr cp, int ldsrc, unsigned char* dst8, int K, int n0, int k0, float scale) {
    ConvJob j = conv_job(cp, ldsrc, (bf16_t*)nullptr, K, n0, k0);
    const int tid = TIDX, r = tid >> 2, kq = tid & 3;
    j.dst = (bf16_t*)(dst8 + (size_t)(n0 + r) * K + k0 + kq * 16); j.f8scale = scale; return j;
}
DEV void conv_load(const ConvJob& j, f32x4 (&v)[8]) {
#pragma unroll
    for (int i = 0; i < 8; ++i) v[i] = j.src ? *(const f32x4*)(j.src + (size_t)i * j.ldsrc) : (f32x4){0.f, 0.f, 0.f, 0.f};
}
DEV void conv_finish(const ConvJob& j, const f32x4 (&v)[8]) {
    unsigned char* tile = g_lds;
    const int tid = TIDX, wid = tid >> 6, lane = tid & 63, kq = tid & 3;
    if (j.f8scale != 0.f) {
        const float sc = j.f8scale;
#pragma unroll
        for (int c = 0; c < 4; ++c) {
            u32x2 w; w.x = pk4_fp8(v[0][c] * sc, v[1][c] * sc, v[2][c] * sc, v[3][c] * sc); w.y = pk4_fp8(v[4][c] * sc, v[5][c] * sc, v[6][c] * sc, v[7][c] * sc);
            *(u32x2*)(tile + (4 * lane + c) * 64 + ((wid ^ (lane & 7)) * 8)) = w;
        }
        __syncthreads();
#pragma unroll
        for (int ps = 0; ps < 2; ++ps) {
            const int r = (tid >> 2) + ps * 128, sw = (r >> 2) & 7;
            const u32x2 a = *(const u32x2*)(tile + r * 64 + (((2 * kq) ^ sw) * 8)), b = *(const u32x2*)(tile + r * 64 + (((2 * kq + 1) ^ sw) * 8));
            u32x4 w8; w8.x = a.x; w8.y = a.y; w8.z = b.x; w8.w = b.y;
            *(u32x4*)((unsigned char*)j.dst + (size_t)(ps * 128) * j.K) = w8;
        }
    } else {
#pragma unroll
        for (int c = 0; c < 4; ++c) {
            u32x4 w; w.x = pk_bf16(v[0][c], v[1][c]); w.y = pk_bf16(v[2][c], v[3][c]); w.z = pk_bf16(v[4][c], v[5][c]); w.w = pk_bf16(v[6][c], v[7][c]);
            *(u32x4*)(tile + (4 * lane + c) * 128 + ((wid ^ (lane & 7)) * 16)) = w;
        }
        __syncthreads();
#pragma unroll
        for (int ps = 0; ps < 2; ++ps) {
            const int r = (tid >> 2) + ps * 128, sw = (r >> 2) & 7;
            const u32x4 w0 = *(const u32x4*)(tile + r * 128 + (((2 * kq) ^ sw) * 16)), w1 = *(const u32x4*)(tile + r * 128 + (((2 * kq + 1) ^ sw) * 16));
            bf16_t* d = j.dst + (size_t)(ps * 128) * j.K;
            *(u32x4*)d = w0; *(u32x4*)(d + 8) = w1;
        }
    }
    __syncthreads();
}
struct CpPlain { const float* base; int ncols; DEV const float* operator()(int n) const { return n < ncols ? base + n : nullptr; } };
struct CpWin0 { const float* base; DEV const float* operator()(int n) const {
    int c;
    if (n < 2048) c = n; else if (n < 3072) c = 2120 + (n - 2048); else if (n < 4608) c = 3144 + (n - 3072);
    else if (n < 4672) c = 2048 + (n - 4608); else if (n < 4680) c = 2112 + (n - 4672); else if (n < 4696) c = n; else return nullptr;
    return base + c; } };
struct CpGU { const float* g; const float* u; DEV const float* operator()(int n) const {
    const int t = n >> 8, r = n & 255; return (r < 128) ? g + t * 128 + r : u + t * 128 + (r - 128); } };

constexpr int PREP_J0 = 19 * 32;
constexpr int GEMM_CUS = 152;
DEV void ph_prep(const Params& p, int vb, int nvb, int part) {
    unsigned char* ws = p.ws;
    if (part == 0 && vb == 0 && TIDX < 128) ((unsigned*)(ws + OFF_CTL))[CW_CNT + TIDX] = 0u;
    if (part == 1) {
        bf16_t* wrb = (bf16_t*)(ws + OFF_WRT);
        for (int i = vb * NBLK + TIDX; i < 2 * 64 * 5 * 64; i += nvb * NBLK) {
            const int l = i / 20480, rem = i % 20480, ks = rem / 320, nt = (rem / 64) % 5, ln = rem & 63;
            const int k0 = ks * 32 + (ln >> 4) * 8, n = nt * 16 + (ln & 15);
            float hi[8], lo[8];
#pragma unroll
            for (int e = 0; e < 8; ++e) {
                const int k = k0 + e; float w = 0.f;
                if (n < 8) w = p.w_rg[((size_t)l * 2048 + k) * 8 + n]; else if (n < 72) w = p.w_re[((size_t)l * 2048 + k) * 64 + (n - 8)];
                w *= p.ffn_norm[l * 2048 + k];
                const float h = bf2f(f2bf(w)); hi[e] = h; lo[e] = w - h;
            }
            bf16_t* d = wrb + (size_t)l * 327680 + ((size_t)(ks * 2) * 5 + nt) * 512 + ln * 8;
            st8(d, hi); st8(d + 5 * 512, lo);
        }
    }
    if (part == 1) {
        float* tbl = (float*)(ws + OFF_ROPE);
        for (int i = vb * NBLK + TIDX; i < NTOK * 128; i += nvb * NBLK) {
            const int tok = i >> 7, fi = i & 127;
            float sn, cs; sincosf((float)p.pos[tok] * exp2f(-(float)fi * (1.f / 128.f) * 13.287712379549449f), &sn, &cs);
            tbl[(size_t)tok * 256 + fi] = cs; tbl[(size_t)tok * 256 + 128 + fi] = sn;
        }
    }
    constexpr int J0 = 19 * 32, J1 = 8 * 32, J2 = 48 * 32, J3 = 8 * 64, J4 = 128 * 128, J5 = 128 * 64;
    constexpr int JT = J0 + J1 + J2 + J3 + J4 + J5;
    auto decode = [&](int job) -> ConvJob {
        int j = job;
        if (j < J0) return conv_job(CpWin0{p.hyb_w_in}, 4696, (bf16_t*)(ws + OFF_WIN0), 2048, (j / 32) * 256, (j % 32) * 64);
        j -= J0;
        if (j < J1) { if (FP8_OUT0) return conv_job8(CpPlain{p.hyb_w_out, 2048}, 2048, ws + OFF_WOUT0, 2048, (j / 32) * 256, (j % 32) * 64, 64.f);
                      return conv_job(CpPlain{p.hyb_w_out, 2048}, 2048, (bf16_t*)(ws + OFF_WOUT0), 2048, (j / 32) * 256, (j % 32) * 64); }
        j -= J1;
        if (j < J2) { const int ntile = j / 32;
            if (ntile < 16) { if (QK_FP8) return conv_job8(CpPlain{p.ret_w_in, 12288}, 12288, ws + OFF_WIN1, 2048, ntile * 256, (j % 32) * 64, 64.f);
                              return conv_job(CpPlain{p.ret_w_in, 12288}, 12288, (bf16_t*)(ws + OFF_WIN1), 2048, ntile * 256, (j % 32) * 64); }
            return conv_job8(CpPlain{p.ret_w_in + 4096, 8192}, 12288, ws + OFF_WIN1 + (size_t)4096 * 2048 * 2, 2048, (ntile - 16) * 256, (j % 32) * 64, 64.f); }
        j -= J2;
        if (j < J3) return conv_job8(CpPlain{p.ret_w_out, 2048}, 2048, ws + OFF_WOUT1, 4096, (j / 64) * 256, (j % 64) * 64, 64.f);
        j -= J3;
        if (j < J4) { const int le = j / 128, t = j % 128;
            return conv_job8(CpGU{p.w_gate + (size_t)le * 2048 * 512, p.w_up + (size_t)le * 2048 * 512}, 512, ws + OFF_WGU + (size_t)le * 1024 * 2048, 2048, (t / 32) * 256, (t % 32) * 64, 32.f); }
        j -= J4;
        { const int le = j / 64, t = j % 64;
            return conv_job8(CpPlain{p.w_down + (size_t)le * 512 * 2048, 2048}, 2048, ws + OFF_WD + (size_t)le * 2048 * 512, 512, (t / 8) * 256, (t % 8) * 64, 16.f); }
    };
    static_assert(J0 == PREP_J0, "part split");
    const int jlo = part == 0 ? 0 : J0, jhi = part == 0 ? J0 : JT;
    if (part == 0) {
        if (jlo + vb < jhi) {
            ConvJob cj = decode(jlo + vb), c1 = cj, c2 = cj; f32x4 va[8], v1[8], v2[8]; conv_load(cj, va);
            if (jlo + vb + nvb < jhi) { c1 = decode(jlo + vb + nvb); conv_load(c1, v1); }
            for (int job = jlo + vb; job < jhi; job += nvb) {
                const int nj2 = job + 2 * nvb;
                if (nj2 < jhi) { c2 = decode(nj2); conv_load(c2, v2); }
                conv_finish(cj, va);
                cj = c1; c1 = c2;
#pragma unroll
                for (int i = 0; i < 8; ++i) { va[i] = v1[i]; v1[i] = v2[i]; }
            }
        }
    } else {
        unsigned* qhead = (unsigned*)(ws + OFF_CTL) + CW_PREPQ; volatile int* ring = (volatile int*)(g_lds + 40 * 1024);
        __syncthreads();
        if (TIDX == 0) { ring[0] = jlo + (int)atomicAdd(qhead, 1u); ring[1] = jlo + (int)atomicAdd(qhead, 1u); ring[2] = jlo + (int)atomicAdd(qhead, 1u); }
        __syncthreads();
        int job = ring[0], j1 = ring[1];
        if (job < jhi) {
            ConvJob cj = decode(job), c1 = cj, c2 = cj; f32x4 va[8], v1[8], v2[8]; conv_load(cj, va);
            if (j1 < jhi) { c1 = decode(j1); conv_load(c1, v1); }
            for (int it = 0; job < jhi; ++it) {
                if (TIDX == 0) ring[(it + 3) & 3] = jlo + (int)atomicAdd(qhead, 1u);
                const int j2 = ring[(it + 2) & 3];
                if (j2 < jhi) { c2 = decode(j2); conv_load(c2, v2); }
                conv_finish(cj, va);
                cj = c1; c1 = c2; job = j1; j1 = j2;
#pragma unroll
                for (int i = 0; i < 8; ++i) { va[i] = v1[i]; v1[i] = v2[i]; }
            }
        }
    }
}

DEV void ph_norm(const float* x, const float* g, bf16_t* H, int vb, int nvb) {
    const int wave = TIDX >> 6, lane = TIDX & 63;
    for (int row = vb * 8 + wave; row < NTOK; row += nvb * 8) {
        const f32x4* xr = (const f32x4*)(x + (size_t)row * DM);
        f32x4 v[8]; float ss = 0.f;
#pragma unroll
        for (int i = 0; i < 8; ++i) { v[i] = xr[i * 64 + lane]; ss += v[i].x * v[i].x + v[i].y * v[i].y + v[i].z * v[i].z + v[i].w * v[i].w; }
        ss = wave_sum(ss);
        const float r = rsqrtf(ss * (1.f / DM) + EPS);
#pragma unroll
        for (int i = 0; i < 8; ++i) {
            const f32x4 g4 = ((const f32x4*)g)[i * 64 + lane];
            u32x2 w; w.x = pk_bf16(v[i].x * r * g4.x, v[i].y * r * g4.y); w.y = pk_bf16(v[i].z * r * g4.z, v[i].w * r * g4.w);
            *(u32x2*)(H + (size_t)row * DM + (i * 64 + lane) * 4) = w;
        }
    }
}

constexpr int GEMM_ROWOFF = 48 * 1024;
template <int BM, int BN>
DEV void gemm_core(const bf16_t* __restrict__ A, const bf16_t* __restrict__ Bt, int ldb, int bcol, int K, f32x4 (&acc)[BM / 32][BN / 64]) {
    constexpr int TM = BM / 32, TN = BN / 64;
    unsigned char* SA = g_lds; unsigned char* SB = g_lds + BM * 64;
    const unsigned* rowoff = (const unsigned*)(g_lds + GEMM_ROWOFF);
    const int tid = TIDX, wid = tid >> 6, lane = tid & 63, wr = wid >> 2, wc = wid & 3, fr = lane & 15, fq = lane >> 4;
#pragma unroll
    for (int m = 0; m < TM; ++m)
#pragma unroll
        for (int n = 0; n < TN; ++n) acc[m][n] = (f32x4){0.f, 0.f, 0.f, 0.f};
    for (int kt = 0; kt < K / 32; ++kt) {
#pragma unroll
        for (int i = 0; i < BM * 4 / NBLK; ++i) { const int c = tid + i * NBLK, r = c >> 2, q = c & 3;
            __builtin_amdgcn_global_load_lds((const unsigned*)(A + rowoff[r] + kt * 32 + q * 8), (LAS unsigned*)(SA + c * 16), 16, 0, 0); }
#pragma unroll
        for (int i = 0; i < BN * 4 / NBLK; ++i) { const int c = tid + i * NBLK, r = c >> 2, q = c & 3;
            __builtin_amdgcn_global_load_lds((const unsigned*)(Bt + (size_t)(bcol + r) * ldb + kt * 32 + q * 8), (LAS unsigned*)(SB + c * 16), 16, 0, 0); }
        WAIT_VM0(); __syncthreads();
        bf16x8 af[TM], bfr[TN];
#pragma unroll
        for (int m = 0; m < TM; ++m) af[m] = *(const bf16x8*)(SA + (wr * (BM / 2) + m * 16 + fr) * 64 + fq * 16);
#pragma unroll
        for (int n = 0; n < TN; ++n) bfr[n] = *(const bf16x8*)(SB + (wc * (BN / 4) + n * 16 + fr) * 64 + fq * 16);
#pragma unroll
        for (int m = 0; m < TM; ++m)
#pragma unroll
            for (int n = 0; n < TN; ++n) acc[m][n] = mfma16(bfr[n], af[m], acc[m][n]);
        __syncthreads();
    }
}

template <class Epi>
DEV void ph_gemm_dense(const bf16_t* A, int lda, const bf16_t* Bt, int N, int K, Epi epi, int vb, int nvb) {
    const int nN = N / 256, nM = NTOK / 256, ntile = nM * nN;
    unsigned* rowoff = (unsigned*)(g_lds + GEMM_ROWOFF);
    const int tid = TIDX, wid = tid >> 6, lane = tid & 63, wr = wid >> 2, wc = wid & 3, fr = lane & 15, fq = lane >> 4;
    for (int t = vb; t < ntile; t += nvb) {
        const int pm = t % nM, pn = t / nM;
        __syncthreads();
        if (tid < 256) rowoff[tid] = (unsigned)((size_t)(pm * 256 + tid) * lda);
        __syncthreads();
        f32x4 acc[8][4];
        gemm_core<256, 256>(A, Bt, K, pn * 256, K, acc);
#pragma unroll
        for (int m = 0; m < 8; ++m)
#pragma unroll
            for (int n = 0; n < 4; ++n) epi(pm * 256 + wr * 128 + m * 16 + fr, pn * 256 + wc * 64 + n * 16 + fq * 4, acc[m][n]);
    }
}

struct EpiZ0 { bf16_t* Z; float* ZS; DEV void operator()(int row, int col, f32x4 v) const {
    u32x2 w; w.x = pk_bf16(v.x, v.y); w.y = pk_bf16(v.z, v.w);
    *(u32x2*)(Z + (size_t)row * LD0 + col) = w;
    if (col >= 4608) *(f32x4*)(ZS + (size_t)row * 256 + (col - 4608)) = v; } };
struct EpiBf { bf16_t* Z; int ld; DEV void operator()(int row, int col, f32x4 v) const {
    u32x2 w; w.x = pk_bf16(v.x, v.y); w.y = pk_bf16(v.z, v.w);
    *(u32x2*)(Z + (size_t)row * ld + col) = w; } };
struct EpiResid { const float* xin; float* xout; float scale; DEV void operator()(int row, int col, f32x4 v) const {
    const f32x4 r = *(const f32x4*)(xin + (size_t)row * DM + col);
    *(f32x4*)(xout + (size_t)row * DM + col) = r + v * scale; } };

namespace g8 {
typedef int i32x4_t __attribute__((ext_vector_type(4)));
constexpr int BK = 64, HALF = 128, HTB = HALF * BK * 2, STAGE_BYTES = 8 * HTB;
constexpr int GOFF_LDS = 156 * 1024;
DEV int lds_byte(int r, int c) { const int st = (r >> 4) * 2 + (c >> 5), rr = r & 15, cc = c & 31, ob = rr * 64 + cc * 2; return st * 1024 + (ob ^ (((ob >> 9) & 1) << 5)); }
DEV void stage_rc(int b, int& R, int& C) { const int st = b / 1024, sb = b % 1024, swz = sb ^ (((sb >> 9) & 1) << 5); R = (st >> 1) * 16 + swz / 64; C = (st & 1) * 32 + (swz % 64) / 2; }

template <bool GATHER, class Epi, class Sched, int FP8 = 0, int WSHIFT = 0>
DEV void gemm_phase(int K, const Sched& S, const Epi& E) {
    LAS unsigned char* lds = (LAS unsigned char*)g_lds;
    typedef typename Sched::Unit Unit;
    const int tid = TIDX, wid = __builtin_amdgcn_readfirstlane(tid >> 6), lane = tid & 63, wr = wid >> 2, wc = wid & 3, fr = lane & 15, fq = lane >> 4;
    const int rowB = FP8 ? K : 2 * K, nt = rowB / 128;
    int Rr[2], Cc[2]; unsigned voffB[2];
#pragma unroll
    for (int i = 0; i < 2; ++i) { stage_rc(tid * 16 + i * 8192, Rr[i], Cc[i]); voffB[i] = (unsigned)(Rr[i] * rowB + Cc[i] * 2); }
    const size_t kstep = (size_t)(BK * 2), hstep = (size_t)HALF * rowB, r64 = (size_t)64 * rowB;
    const unsigned ldsw = (unsigned)wid * 1024u;
    const int aoff = lds_byte(wr * 64 + fr, fq * 8), boff = lds_byte(wc * 32 + fr, fq * 8);
#define G8_SA(b, h) (((b) * 2 + (h)) * HTB)
#define G8_SB(b, h) ((4 + (b) * 2 + (h)) * HTB)
#define G8_STAGE(bufoff, gbase, voff) do { _Pragma("unroll") for (int _i = 0; _i < 2; ++_i) \
        __builtin_amdgcn_global_load_lds((const unsigned*)((const char*)(gbase) + (size_t)_i * r64 + (voff)[0]), (LAS unsigned*)(lds + (bufoff) + ldsw + _i * 8192), 16, 0, 0); } while (0)
#define G8_STAGE_A(bufoff, dptr, goffs, kb) do { if (GATHER) { _Pragma("unroll") for (int _i = 0; _i < 2; ++_i) \
        __builtin_amdgcn_global_load_lds((const unsigned*)((S.Abase() + (size_t)(kb)) + (RO[(goffs) + rr0 + 64 * _i] + cc0)), (LAS unsigned*)(lds + (bufoff) + ldsw + _i * 8192), 16, 0, 0); } \
        else G8_STAGE(bufoff, dptr, voffB); } while (0)
#define G8_LD2(dst, addr) do { const i32x4_t _lo = *(const LAS i32x4_t*)(addr), _hi = *(const LAS i32x4_t*)((addr) + 1024); dst = __builtin_shufflevector(_lo, _hi, 0, 1, 2, 3, 4, 5, 6, 7); } while (0)
#define G8_LDA(dst, b, h) do { _Pragma("unroll") for (int m = 0; m < 4; ++m) G8_LD2(dst[m], lds + G8_SA(b, h) + aoff + m * 2048); } while (0)
#define G8_LDB(dst, b, h) do { _Pragma("unroll") for (int n = 0; n < 2; ++n) G8_LD2(dst[n], lds + G8_SB(b, h) + boff + n * 2048); } while (0)
typedef int i32x2_t __attribute__((ext_vector_type(2)));
#define G8_Q0(x) __builtin_bit_cast(long, __builtin_shufflevector((x), (x), 0, 1))
#define G8_Q1(x) __builtin_bit_cast(long, __builtin_shufflevector((x), (x), 2, 3))
#define G8_Q2(x) __builtin_bit_cast(long, __builtin_shufflevector((x), (x), 4, 5))
#define G8_Q3(x) __builtin_bit_cast(long, __builtin_shufflevector((x), (x), 6, 7))
#define G8_LO(x) __builtin_bit_cast(bf16x8, __builtin_shufflevector((x), (x), 0, 1, 2, 3))
#define G8_HI(x) __builtin_bit_cast(bf16x8, __builtin_shufflevector((x), (x), 4, 5, 6, 7))
#define G8_MMA(ai, bj, At, Bt) do { __builtin_amdgcn_s_setprio(1); _Pragma("unroll") for (int m = 0; m < 4; ++m) _Pragma("unroll") for (int n = 0; n < 2; ++n) { \
        if (FP8 == 2) acc[ai][bj][m][n] = __builtin_amdgcn_mfma_scale_f32_16x16x128_f8f6f4(Bt[n], At[m], acc[ai][bj][m][n], 0, 0, 0, 0x01010101 * (127 - WSHIFT / 2), 0, 0x01010101 * (127 - WSHIFT / 2)); \
        else if (FP8) { acc[ai][bj][m][n] = __builtin_amdgcn_mfma_f32_16x16x32_fp8_fp8(G8_Q0(Bt[n]), G8_Q0(At[m]), acc[ai][bj][m][n], 0, 0, 0); \
                   acc[ai][bj][m][n] = __builtin_amdgcn_mfma_f32_16x16x32_fp8_fp8(G8_Q1(Bt[n]), G8_Q1(At[m]), acc[ai][bj][m][n], 0, 0, 0); \
                   acc[ai][bj][m][n] = __builtin_amdgcn_mfma_f32_16x16x32_fp8_fp8(G8_Q2(Bt[n]), G8_Q2(At[m]), acc[ai][bj][m][n], 0, 0, 0); \
                   acc[ai][bj][m][n] = __builtin_amdgcn_mfma_f32_16x16x32_fp8_fp8(G8_Q3(Bt[n]), G8_Q3(At[m]), acc[ai][bj][m][n], 0, 0, 0); } \
        else { acc[ai][bj][m][n] = __builtin_amdgcn_mfma_f32_16x16x32_bf16(G8_LO(Bt[n]), G8_LO(At[m]), acc[ai][bj][m][n], 0, 0, 0); \
               acc[ai][bj][m][n] = __builtin_amdgcn_mfma_f32_16x16x32_bf16(G8_HI(Bt[n]), G8_HI(At[m]), acc[ai][bj][m][n], 0, 0, 0); } } \
        __builtin_amdgcn_s_setprio(0); } while (0)
#define G8_WAIT_V(n) asm volatile("s_waitcnt vmcnt(" #n ")" ::: "memory")
#define G8_WAIT_L(n) asm volatile("s_waitcnt lgkmcnt(" #n ")" ::: "memory")
#define G8_BAR __builtin_amdgcn_s_barrier()
#define G8_SCHED __builtin_amdgcn_sched_barrier(0)
    Unit cur, nxt; int ui = 0;
    if (!S.next(0, cur)) return;
    f32x4 acc[2][2][4][2];
#pragma unroll
    for (int a = 0; a < 2; ++a)
#pragma unroll
        for (int b = 0; b < 2; ++b)
#pragma unroll
            for (int m = 0; m < 4; ++m)
#pragma unroll
                for (int n = 0; n < 2; ++n) acc[a][b][m][n] = (f32x4){0.f, 0.f, 0.f, 0.f};
    i32x8 At[4], B0[2], B1[2];
    const char* cA = GATHER ? nullptr : S.A0(cur); const char* cB = S.B0(cur);
    const unsigned* RO = (const unsigned*)(g_lds + GOFF_LDS);
    const int rr0 = Rr[0], cc0 = Cc[0] * 2;
    if (GATHER) { if (tid < 256) ((unsigned*)(g_lds + GOFF_LDS))[tid] = S.rowoff(cur, tid); __syncthreads(); }
    int gcur = 0;
    G8_STAGE(G8_SB(0, 0), cB, voffB); G8_STAGE_A(G8_SA(0, 0), cA, gcur, 0); G8_STAGE(G8_SB(0, 1), cB + hstep, voffB); G8_STAGE_A(G8_SA(0, 1), cA + hstep, gcur + 128, 0);
    if (wr == 1) G8_BAR;
    G8_WAIT_V(4); G8_BAR;
    G8_STAGE(G8_SB(1, 0), cB + kstep, voffB); G8_STAGE_A(G8_SA(1, 0), cA + kstep, gcur, kstep); G8_STAGE(G8_SB(1, 1), cB + hstep + kstep, voffB);
    G8_WAIT_V(6); G8_BAR;
    for (;;) {
        const bool has_next = S.next(ui + 1, nxt);
        const char* nA = (GATHER || !has_next) ? cA : S.A0(nxt); const char* nB = has_next ? S.B0(nxt) : cB;
        const int gnxt = has_next ? (gcur ^ 256) : gcur;
        if (GATHER && has_next && wid < 4) {
            int ln; asm volatile("v_mbcnt_lo_u32_b32 %0, -1, 0\n\tv_mbcnt_hi_u32_b32 %0, -1, %0" : "=v"(ln));
            const int t2 = wid * 64 + ln; ((unsigned*)(g_lds + GOFF_LDS))[gnxt + t2] = S.rowoff(nxt, t2); }
        for (int t = 0; t < nt; t += 2) {
            const bool last = (t == nt - 2);
            const char* a1 = cA + (size_t)(t + 1) * kstep;
            const char* a2 = last ? nA : cA + (size_t)(t + 2) * kstep; const char* b2 = last ? nB : cB + (size_t)(t + 2) * kstep;
            const char* a3 = a2 + kstep; const char* b3 = b2 + kstep;
            const size_t k1 = (size_t)(t + 1) * kstep, k2 = last ? 0 : (size_t)(t + 2) * kstep, k3 = k2 + kstep;
            const int g2 = last ? gnxt : gcur;
            G8_LDB(B0, 0, 0); G8_SCHED; G8_LDA(At, 0, 0); G8_STAGE_A(G8_SA(1, 1), a1 + hstep, gcur + 128, k1);
            G8_WAIT_L(8); G8_BAR; G8_WAIT_L(0); G8_MMA(0, 0, At, B0); G8_BAR; G8_SCHED;
            G8_LDB(B1, 0, 1); G8_STAGE(G8_SB(0, 0), b2, voffB);
            G8_BAR; G8_WAIT_L(0); G8_MMA(0, 1, At, B1); G8_BAR;
            G8_LDA(At, 0, 1); G8_STAGE_A(G8_SA(0, 0), a2, g2, k2);
            G8_BAR; G8_WAIT_L(0); G8_MMA(1, 0, At, B0); G8_BAR; G8_SCHED;
            G8_STAGE(G8_SB(0, 1), b2 + hstep, voffB);
            G8_WAIT_V(6); G8_BAR; G8_MMA(1, 1, At, B1); G8_BAR;
            G8_LDB(B0, 1, 0); G8_SCHED; G8_LDA(At, 1, 0); G8_STAGE_A(G8_SA(0, 1), a2 + hstep, g2 + 128, k2);
            G8_WAIT_L(8); G8_BAR; G8_WAIT_L(0); G8_MMA(0, 0, At, B0); G8_BAR; G8_SCHED;
            G8_LDB(B1, 1, 1); G8_STAGE(G8_SB(1, 0), b3, voffB);
            G8_BAR; G8_WAIT_L(0); G8_MMA(0, 1, At, B1); G8_BAR;
            G8_LDA(At, 1, 1); G8_STAGE_A(G8_SA(1, 0), a3, g2, k3);
            G8_BAR; G8_WAIT_L(0); G8_MMA(1, 0, At, B0); G8_BAR; G8_SCHED;
            G8_STAGE(G8_SB(1, 1), b3 + hstep, voffB);
            G8_WAIT_V(6); G8_BAR; G8_MMA(1, 1, At, B1); G8_BAR;
        }
        {
            int tz = TIDX; asm volatile("" : "+v"(tz));
            const int ewid = tz >> 6, elane = tz & 63;
            E(acc, cur, ewid >> 2, ewid & 3, elane & 15, elane >> 4);
        }
        if (!has_next) break;
#pragma unroll
        for (int a = 0; a < 2; ++a)
#pragma unroll
            for (int b = 0; b < 2; ++b)
#pragma unroll
                for (int m = 0; m < 4; ++m)
#pragma unroll
                    for (int n = 0; n < 2; ++n) acc[a][b][m][n] = (f32x4){0.f, 0.f, 0.f, 0.f};
        cur = nxt; cA = nA; cB = nB; ++ui; gcur = gnxt;
    }
    G8_WAIT_V(0);
    if (wr == 0) G8_BAR;
    G8_BAR;
#undef G8_SA
#undef G8_SB
#undef G8_STAGE
#undef G8_STAGE_A
#undef G8_LDA
#undef G8_LDB
#undef G8_MMA
#undef G8_LD2
#undef G8_LO
#undef G8_HI
#undef G8_WAIT_V
#undef G8_WAIT_L
#undef G8_BAR
#undef G8_SCHED
}

struct DenseSched {
    struct Unit { int pm, pn; };
    const bf16_t* A; const bf16_t* Bt; int K, nM, nN, nwg, G, c, rep, esz;
    DEV void init(const bf16_t* A_, const bf16_t* Bt_, int M, int N, int K_, int G_, int c_) { A = A_; Bt = Bt_; K = K_; nM = M / 256; nN = N / 256; nwg = nM * nN; G = G_; c = c_; rep = 1; esz = 2; }
    DEV bool next(int i, Unit& u) const {
        const int rounds = (nwg + G - 1) / G; if (i >= rounds * rep) return false;
        const long L = (long)(i % rounds) * G + c; if (L >= nwg) return false;
        int wgid = (int)L; { const int q = nwg / 8, r = nwg % 8, xcd = wgid % 8, off = wgid / 8; wgid = (xcd < r ? xcd * (q + 1) : r * (q + 1) + (xcd - r) * q) + off; }
        const int nig = 8 * nN, gid = wgid / nig, fm = gid * 8, gsz = (nM - fm) < 8 ? (nM - fm) : 8;
        u.pm = fm + ((wgid % nig) % gsz); u.pn = (wgid % nig) / gsz; return true;
    }
    DEV const char* A0(const Unit& u) const { return (const char*)A + (size_t)u.pm * 256 * K * esz; }
    DEV const char* B0(const Unit& u) const { return (const char*)Bt + (size_t)u.pn * 256 * K * esz; }
    DEV const char* Abase() const { return (const char*)A; }
    DEV bool half1(const Unit&) const { return true; }
    DEV unsigned rowoff(const Unit&, int) const { return 0u; }
};
template <class F> struct EpiEach { F f;
    DEV void operator()(const f32x4 (&acc)[2][2][4][2], const DenseSched::Unit& u, int wr, int wc, int fr, int fq) const {
#pragma unroll
        for (int ai = 0; ai < 2; ++ai)
#pragma unroll
            for (int m = 0; m < 4; ++m) {
#pragma unroll
                for (int bj = 0; bj < 2; ++bj)
#pragma unroll
                    for (int n = 0; n < 2; ++n) f(u.pm * 256 + ai * 128 + wr * 64 + m * 16 + fr, u.pn * 256 + bj * 128 + wc * 32 + n * 16 + fq * 4, acc[ai][bj][m][n]);
                __builtin_amdgcn_sched_barrier(0);
            }
    } };
constexpr int EPI_LDS = 136 * 1024, EPI_WAVE = 2560, EPI_PATCH = 1280;
template <int LD> struct EpiBfT { bf16_t* Z;
    DEV void operator()(const f32x4 (&acc)[2][2][4][2], const DenseSched::Unit& u, int wr, int wc, int fr, int fq) const {
        unsigned char* buf = g_lds + EPI_LDS + (wr * 4 + wc) * EPI_WAVE;
        const int lane = fq * 16 + fr, r2 = lane >> 2, c2 = lane & 3;
        const unsigned off0 = ((unsigned)(u.pm * 256 + wr * 64 + r2) * (unsigned)LD + (unsigned)(u.pn * 256 + wc * 32 + c2 * 8)) * 2u;
#pragma unroll
        for (int ai = 0; ai < 2; ++ai)
#pragma unroll
            for (int m = 0; m < 4; ++m)
#pragma unroll
                for (int bj = 0; bj < 2; ++bj) {
                    unsigned char* bb = buf + bj * EPI_PATCH;
#pragma unroll
                    for (int n = 0; n < 2; ++n) { const f32x4 v = acc[ai][bj][m][n]; u32x2 w; w.x = pk_bf16(v.x, v.y); w.y = pk_bf16(v.z, v.w); *(u32x2*)(bb + fr * 80 + n * 32 + fq * 8) = w; }
                    const u32x4 o = *(const u32x4*)(bb + r2 * 80 + c2 * 16);
                    *(u32x4*)((unsigned char*)Z + (off0 + (unsigned)(((ai * 128 + m * 16) * LD + bj * 128) * 2))) = o;
                    if (bj == 1) __builtin_amdgcn_sched_barrier(0);
                }
    } };
template <int ROWB> struct EpiF8T { unsigned char* Z;
    DEV void operator()(const f32x4 (&acc)[2][2][4][2], const DenseSched::Unit& u, int wr, int wc, int fr, int fq) const {
        unsigned char* buf = g_lds + EPI_LDS + (wr * 4 + wc) * EPI_WAVE;
        const int lane = fq * 16 + fr, r2 = lane >> 2, c2 = lane & 3;
        const unsigned off0 = (unsigned)(u.pm * 256 + wr * 64 + r2) * (unsigned)ROWB + (unsigned)(u.pn * 256 + wc * 32 + c2 * 8);
#pragma unroll
        for (int ai = 0; ai < 2; ++ai)
#pragma unroll
            for (int m = 0; m < 4; ++m)
#pragma unroll
                for (int bj = 0; bj < 2; ++bj) {
                    unsigned char* bb = buf + bj * EPI_PATCH;
#pragma unroll
                    for (int n = 0; n < 2; ++n) { const f32x4 v = acc[ai][bj][m][n]; u32x2 w; w.x = pk_bf16(v.x, v.y); w.y = pk_bf16(v.z, v.w); *(u32x2*)(bb + fr * 80 + n * 32 + fq * 8) = w; }
                    const u32x4 o = *(const u32x4*)(bb + r2 * 80 + c2 * 16);
                    u32x2 o8; o8.x = pk4_fp8(bflo(o.x), bfhi(o.x), bflo(o.y), bfhi(o.y)); o8.y = pk4_fp8(bflo(o.z), bfhi(o.z), bflo(o.w), bfhi(o.w));
                    *(u32x2*)(Z + (off0 + (unsigned)((ai * 128 + m * 16) * ROWB + bj * 128))) = o8;
                    if (bj == 1) __builtin_amdgcn_sched_barrier(0);
                }
    } };
struct EpiZ0T { bf16_t* Z; float* ZS;
    DEV void operator()(const f32x4 (&acc)[2][2][4][2], const DenseSched::Unit& u, int wr, int wc, int fr, int fq) const {
        EpiBfT<LD0>{Z}(acc, u, wr, wc, fr, fq);
        if (u.pn == 18) {
#pragma unroll
            for (int ai = 0; ai < 2; ++ai)
#pragma unroll
                for (int m = 0; m < 4; ++m)
#pragma unroll
                    for (int bj = 0; bj < 2; ++bj)
#pragma unroll
                        for (int n = 0; n < 2; ++n) *(f32x4*)(ZS + (size_t)(u.pm * 256 + ai * 128 + wr * 64 + m * 16 + fr) * 256 + bj * 128 + wc * 32 + n * 16 + fq * 4) = acc[ai][bj][m][n];
        }
    } };
struct EpiResidT { const float* xin; float* xout; float scale;
    DEV void operator()(const f32x4 (&acc)[2][2][4][2], const DenseSched::Unit& u, int wr, int wc, int fr, int fq) const {
        unsigned char* buf = g_lds + EPI_LDS + (wr * 4 + wc) * EPI_WAVE;
        const int lane = fq * 16 + fr, r2 = lane >> 2, c2 = lane & 3;
        const unsigned off0 = ((unsigned)(u.pm * 256 + wr * 64 + r2) * (unsigned)DM + (unsigned)(u.pn * 256 + wc * 32 + c2 * 4)) * 4u;
#pragma unroll
        for (int ai = 0; ai < 2; ++ai)
#pragma unroll
            for (int m = 0; m < 4; ++m) {
#pragma unroll
                for (int bj = 0; bj < 2; ++bj)
#pragma unroll
                    for (int n = 0; n < 2; ++n) {
                        unsigned char* bb = buf + n * EPI_PATCH;
                        *(f32x4*)(bb + fr * 80 + fq * 16) = acc[ai][bj][m][n];
                        const f32x4 v = *(const f32x4*)(bb + r2 * 80 + c2 * 16);
                        const unsigned o = off0 + (unsigned)(((ai * 128 + m * 16) * DM + bj * 128 + n * 16) * 4);
                        const f32x4 r = *(const f32x4*)((const unsigned char*)xin + o);
                        *(f32x4*)((unsigned char*)xout + o) = r + v * scale;
                    }
                __builtin_amdgcn_sched_barrier(0);
            }
    } };
}

struct EpiZ1 { bf16_t* Z; const float* tbl;
    DEV void operator()(const f32x4 (&acc)[2][2][4][2], const g8::DenseSched::Unit& u, int wr, int wc, int fr, int fq) const {
        const float sc = (u.pn >= 8) ? 0.0625f : 1.f;
        unsigned char* buf = g_lds + g8::EPI_LDS + (wr * 4 + wc) * g8::EPI_WAVE;
        const int lane = fq * 16 + fr, r2 = lane >> 2, c2 = lane & 3;
#pragma unroll
        for (int ai = 0; ai < 2; ++ai)
#pragma unroll
            for (int m = 0; m < 4; ++m) {
                const int row = u.pm * 256 + ai * 128 + wr * 64 + m * 16 + r2;
#pragma unroll
                for (int n = 0; n < 2; ++n) {
                    *(f32x4*)(buf + fr * 80 + fq * 16) = acc[ai][0][m][n]; *(f32x4*)(buf + g8::EPI_PATCH + fr * 80 + fq * 16) = acc[ai][1][m][n];
                    const f32x4 a = *(const f32x4*)(buf + r2 * 80 + c2 * 16), b = *(const f32x4*)(buf + g8::EPI_PATCH + r2 * 80 + c2 * 16);
                    const int i0 = wc * 32 + n * 16 + c2 * 4;
                    const f32x4 c = *(const f32x4*)(tbl + (size_t)row * 256 + i0), sn = *(const f32x4*)(tbl + (size_t)row * 256 + 128 + i0);
                    const f32x4 o1 = (a * c - b * sn) * sc, o2 = (b * c + a * sn) * sc;
                    u32x2 w; w.x = pk_bf16(o1.x, o1.y); w.y = pk_bf16(o1.z, o1.w);
                    *(u32x2*)(Z + (size_t)row * LD1 + u.pn * 256 + i0) = w;
                    w.x = pk_bf16(o2.x, o2.y); w.y = pk_bf16(o2.z, o2.w);
                    *(u32x2*)(Z + (size_t)row * LD1 + u.pn * 256 + 128 + i0) = w;
                }
                __builtin_amdgcn_sched_barrier(0);
            }
    } };
struct EpiZ1vg { bf16_t* Z; DEV void operator()(int row, int col, f32x4 v) const {
    u32x2 w; w.x = pk_bf16(v.x * 0.03125f, v.y * 0.03125f); w.y = pk_bf16(v.z * 0.03125f, v.w * 0.03125f);
    *(u32x2*)(Z + (size_t)row * LD1 + 4096 + col) = w; } };
template <class E>
DEV void ph_gemm8_dense(const bf16_t* A, const bf16_t* Bt, int N, int K, E e, int vb, int nvb) {
    g8::DenseSched S; S.init(A, Bt, NTOK, N, K, nvb, vb);
    if ((REPEAT_GROUP == 15 && N == LD0) || (REPEAT_GROUP == 16 && N == DM && K == DM)) S.rep = 2;
    g8::gemm_phase<false>(K, S, e);
}

DEV void ld16(const bf16_t* p, float (&v)[16]) {
    const u32x4 a = *(const u32x4*)p, b = *(const u32x4*)(p + 8);
    v[0] = bflo(a.x); v[1] = bfhi(a.x); v[2] = bflo(a.y); v[3] = bfhi(a.y); v[4] = bflo(a.z); v[5] = bfhi(a.z); v[6] = bflo(a.w); v[7] = bfhi(a.w);
    v[8] = bflo(b.x); v[9] = bfhi(b.x); v[10] = bflo(b.y); v[11] = bfhi(b.y); v[12] = bflo(b.z); v[13] = bfhi(b.z); v[14] = bflo(b.w); v[15] = bfhi(b.w);
}
DEV void ld8(const bf16_t* p, float (&v)[8]) {
    const u32x4 a = *(const u32x4*)p;
    v[0] = bflo(a.x); v[1] = bfhi(a.x); v[2] = bflo(a.y); v[3] = bfhi(a.y); v[4] = bflo(a.z); v[5] = bfhi(a.z); v[6] = bflo(a.w); v[7] = bfhi(a.w);
}
DEV void st16(bf16_t* p, const float (&v)[16]) {
    u32x4 a, b;
    a.x = pk_bf16(v[0], v[1]); a.y = pk_bf16(v[2], v[3]); a.z = pk_bf16(v[4], v[5]); a.w = pk_bf16(v[6], v[7]);
    b.x = pk_bf16(v[8], v[9]); b.y = pk_bf16(v[10], v[11]); b.z = pk_bf16(v[12], v[13]); b.w = pk_bf16(v[14], v[15]);
    *(u32x4*)p = a; *(u32x4*)(p + 8) = b;
}
DEV void st8(bf16_t* p, const float (&v)[8]) {
    u32x4 a; a.x = pk_bf16(v[0], v[1]); a.y = pk_bf16(v[2], v[3]); a.z = pk_bf16(v[4], v[5]); a.w = pk_bf16(v[6], v[7]);
    *(u32x4*)p = a;
}

DEV void up16(const u32x4 a, const u32x4 b, float (&v)[16]) {
    v[0] = bflo(a.x); v[1] = bfhi(a.x); v[2] = bflo(a.y); v[3] = bfhi(a.y); v[4] = bflo(a.z); v[5] = bfhi(a.z); v[6] = bflo(a.w); v[7] = bfhi(a.w);
    v[8] = bflo(b.x); v[9] = bfhi(b.x); v[10] = bflo(b.y); v[11] = bfhi(b.y); v[12] = bflo(b.z); v[13] = bfhi(b.z); v[14] = bflo(b.w); v[15] = bfhi(b.w);
}
DEV void up8(const u32x4 a, float (&v)[8]) {
    v[0] = bflo(a.x); v[1] = bfhi(a.x); v[2] = bflo(a.y); v[3] = bfhi(a.y); v[4] = bflo(a.z); v[5] = bfhi(a.z); v[6] = bflo(a.w); v[7] = bfhi(a.w);
}
DEV void ph_post0(const Params& p, int vb, int nvb) {
    unsigned char* ws = p.ws;
    const bf16_t* Z0 = (const bf16_t*)(ws + OFF_Z); const float* ZS = (const float*)(ws + OFF_ZS);
    bf16_t* QA = (bf16_t*)(ws + OFF_QA); bf16_t* KV = (bf16_t*)(ws + OFF_KV); bf16_t* QIA = (bf16_t*)(ws + OFF_QIA); bf16_t* KIA = (bf16_t*)(ws + OFF_KIA);
    float* WIS = (float*)(ws + OFF_WIS); float* DT = (float*)(ws + OFF_DT); bf16_t* XC = (bf16_t*)(ws + OFF_XC);
    const int wave = TIDX >> 6, lane = TIDX & 63, l8 = lane & 7;
    const float LOG2TH = 18.931568569324174f;
    float inv = 0.f;
    if (lane < 16) inv = exp2f(-(float)lane * (1.f / 16.f) * LOG2TH); else if (lane < 24) inv = exp2f(-(float)(lane - 16) * (1.f / 8.f) * LOG2TH);
    for (int tok = vb * 8 + wave; tok < NTOK; tok += nvb * 8) {
        const bf16_t* z = Z0 + (size_t)tok * LD0;
        const int la0 = lane & 15, s_tok = tok & (SEQ - 1);
        const u32x4 rq0 = *(const u32x4*)(z + 16 * lane), rq1 = *(const u32x4*)(z + 16 * lane + 8);
        const u32x4 rk0 = *(const u32x4*)(z + 1024 + 16 * la0), rk1 = *(const u32x4*)(z + 1024 + 16 * la0 + 8);
        const u32x4 rv0 = *(const u32x4*)(z + 1280 + 16 * la0), rv1 = *(const u32x4*)(z + 1280 + 16 * la0 + 8);
        const u32x4 rqi = *(const u32x4*)(z + 1536 + 8 * lane);
        const float zki = ZS[(size_t)tok * 256 + lane], zwi = ZS[(size_t)tok * 256 + 64 + (lane & 7)], zdt = ZS[(size_t)tok * 256 + 72 + (lane & 15)];
        u32x4 rc[3][4];
#pragma unroll
        for (int i = 0; i < 3; ++i)
#pragma unroll
            for (int k = 0; k < 4; ++k) { const int dk = (s_tok - 3 + k >= 0) ? (k - 3) : 0; rc[i][k] = *(const u32x4*)(z + (ptrdiff_t)dk * LD0 + 3072 + (i * 64 + lane) * 8); }
        const float posf = (float)p.pos[tok];
        float sn, cs; sincosf(posf * inv, &sn, &cs);
        float cq[16], sq[16];
#pragma unroll
        for (int i = 0; i < 16; ++i) { cq[i] = __shfl(cs, i); sq[i] = __shfl(sn, i); }
        {
            float v[16]; up16(rq0, rq1, v);
            float ss = 0.f;
#pragma unroll
            for (int i = 0; i < 16; ++i) ss += v[i] * v[i];
            ss += __shfl_xor(ss, 1); ss += __shfl_xor(ss, 2); ss += __shfl_xor(ss, 4);
            const float r = rsqrtf(ss * (1.f / 128.f) + EPS);
            const float* g = p.q_norm + l8 * 16;
#pragma unroll
            for (int i = 0; i < 16; ++i) v[i] = v[i] * r * g[i];
#pragma unroll
            for (int i = 0; i < 16; ++i) { const float o = __shfl_xor(v[i], 1);
                if (l8 == 0) v[i] = v[i] * cq[i] - o * sq[i]; else if (l8 == 1) v[i] = v[i] * cq[i] + o * sq[i]; }
            st16(QA + (size_t)tok * 1024 + 16 * lane, v);
        }
        {
            const int la = lane & 15;
            float v[16]; up16(rk0, rk1, v);
            float ss = 0.f;
#pragma unroll
            for (int i = 0; i < 16; ++i) ss += v[i] * v[i];
            ss += __shfl_xor(ss, 1); ss += __shfl_xor(ss, 2); ss += __shfl_xor(ss, 4);
            const float r = rsqrtf(ss * (1.f / 128.f) + EPS);
            const float* g = p.k_norm + l8 * 16;
#pragma unroll
            for (int i = 0; i < 16; ++i) v[i] = v[i] * r * g[i];
#pragma unroll
            for (int i = 0; i < 16; ++i) { const float o = __shfl_xor(v[i], 1);
                if (l8 == 0) v[i] = v[i] * cq[i] - o * sq[i]; else if (l8 == 1) v[i] = v[i] * cq[i] + o * sq[i]; }
            unsigned char* KV8 = (unsigned char*)KV;
            if (lane < 16) { u32x4 w; w.x = pk4_fp8(v[0], v[1], v[2], v[3]); w.y = pk4_fp8(v[4], v[5], v[6], v[7]); w.z = pk4_fp8(v[8], v[9], v[10], v[11]); w.w = pk4_fp8(v[12], v[13], v[14], v[15]);
                *(u32x4*)(KV8 + (size_t)tok * 512 + (la >> 3) * 256 + l8 * 16) = w; }
            if (lane >= 16 && lane < 32) {
                float vv[16]; up16(rv0, rv1, vv);
                u32x4 w; w.x = pk4_fp8(vv[0], vv[1], vv[2], vv[3]); w.y = pk4_fp8(vv[4], vv[5], vv[6], vv[7]); w.z = pk4_fp8(vv[8], vv[9], vv[10], vv[11]); w.w = pk4_fp8(vv[12], vv[13], vv[14], vv[15]);
                *(u32x4*)(KV8 + (size_t)tok * 512 + (la >> 3) * 256 + 128 + l8 * 16) = w;
            }
        }
        {
            float ci[8], si[8];
#pragma unroll
            for (int i = 0; i < 8; ++i) { ci[i] = __shfl(cs, 16 + i); si[i] = __shfl(sn, 16 + i); }
            float v[8]; up8(rqi, v);
#pragma unroll
            for (int i = 0; i < 8; ++i) { const float o = __shfl_xor(v[i], 1);
                if (l8 == 0) v[i] = v[i] * ci[i] - o * si[i]; else if (l8 == 1) v[i] = v[i] * ci[i] + o * si[i]; }
            st8(QIA + (size_t)tok * 512 + 8 * lane, v);
            float kv = zki;
            const float ss = wave_sum(kv * kv);
            kv = kv * rsqrtf(ss * (1.f / 64.f) + EPS) * p.kidx_norm[lane];
            const float o = __shfl_xor(kv, 8);
            const float c1 = __shfl(cs, 16 + (lane & 7)), s1 = __shfl(sn, 16 + (lane & 7));
            if (lane < 8) kv = kv * c1 - o * s1; else if (lane < 16) kv = kv * c1 + o * s1;
            KIA[(size_t)(tok >> 4) * 1024 + (lane >> 5) * 512 + (((lane >> 3) & 3) * 16 + (tok & 15)) * 8 + (lane & 7)] = f2bf(kv);
        }
        if (lane < 8) WIS[(size_t)tok * 8 + lane] = zwi * 0.044194173824159216f;
        if (lane < 16) { const float v = zdt + p.dt_bias[lane]; DT[(size_t)tok * 16 + lane] = v > 20.f ? v : log1pf(expf(v)); }
        {
            const int s = tok & (SEQ - 1);
#pragma unroll
            for (int i = 0; i < 3; ++i) {
                const int c0 = (i * 64 + lane) * 8;
                float acc[8];
                { const f32x4 b0 = *(const f32x4*)(p.conv_b + c0), b1 = *(const f32x4*)(p.conv_b + c0 + 4);
                  acc[0] = b0.x; acc[1] = b0.y; acc[2] = b0.z; acc[3] = b0.w; acc[4] = b1.x; acc[5] = b1.y; acc[6] = b1.z; acc[7] = b1.w; }
#pragma unroll
                for (int k = 0; k < 4; ++k) {
                    if (s - 3 + k >= 0) {
                        float xv[8]; up8(rc[i][k], xv);
                        const f32x4 w0 = *(const f32x4*)(p.conv_w + k * 1536 + c0), w1 = *(const f32x4*)(p.conv_w + k * 1536 + c0 + 4);
                        acc[0] += xv[0] * w0.x; acc[1] += xv[1] * w0.y; acc[2] += xv[2] * w0.z; acc[3] += xv[3] * w0.w;
                        acc[4] += xv[4] * w1.x; acc[5] += xv[5] * w1.y; acc[6] += xv[6] * w1.z; acc[7] += xv[7] * w1.w;
                    }
                }
#pragma unroll
                for (int e = 0; e < 8; ++e) acc[e] = siluf(acc[e]);
                st8(XC + (size_t)tok * 1536 + c0, acc);
            }
        }
    }
}

constexpr int DSA_SC = 0, DSA_HIST = 131072, DSA_SEL = 147456, DSA_MISC = 149504, DSA_PART = 149504 + 128, DSA_CAND = 150016;
DEV unsigned fkey(float f) { const unsigned u = __float_as_uint(f); return (u & 0x80000000u) ? ~u : (u | 0x80000000u); }

DEV void ph_dsa(const Params& p, int vb, int nvb) {
    unsigned char* ws = p.ws;
    const bf16_t* QA = (const bf16_t*)(ws + OFF_QA); const bf16_t* KV = (const bf16_t*)(ws + OFF_KV); const bf16_t* QIA = (const bf16_t*)(ws + OFF_QIA);
    const bf16_t* KIA = (const bf16_t*)(ws + OFF_KIA); const float* WIS = (const float*)(ws + OFF_WIS); bf16_t* MIX = (bf16_t*)(ws + OFF_MIX);
    unsigned* SC = (unsigned*)(g_lds + DSA_SC); unsigned* HIST = (unsigned*)(g_lds + DSA_HIST); unsigned short* SEL = (unsigned short*)(g_lds + DSA_SEL);
    unsigned* MISC = (unsigned*)(g_lds + DSA_MISC); unsigned* PART = (unsigned*)(g_lds + DSA_PART);
    const int tid = TIDX, wave = tid >> 6, lane = tid & 63, fr = lane & 15, fq = lane >> 4;
    bf16x8 an[2][2]; f32x4 wn[2]; int pref_k = -1;
#define DSA_QLOAD(kk) do { const int tk_ = ((kk) & 1) * SEQ + (2047 - ((kk) >> 1)) * 4; _Pragma("unroll") for (int mt = 0; mt < 2; ++mt) { \
        const bf16_t* qp = QIA + (size_t)(tk_ + (fr >> 2)) * 512 + ((fr & 3) + 4 * mt) * 64 + fq * 8; an[mt][0] = *(const bf16x8*)qp; an[mt][1] = *(const bf16x8*)(qp + 32); \
        wn[mt] = *(const f32x4*)(WIS + (size_t)(tk_ + fq) * 8 + mt * 4); } pref_k = (kk); } while (0)
#define DSA_UNIT(i2) (((((REPEAT_GROUP == 2) ? ((i2) >> 1) : (i2)) & 1) ? ((REPEAT_GROUP == 2) ? ((i2) >> 1) : (i2)) * nvb + (nvb - 1 - vb) : ((REPEAT_GROUP == 2) ? ((i2) >> 1) : (i2)) * nvb + vb))
    for (int it2 = 0; it2 * nvb < 4096 * (REPEAT_GROUP == 2 ? 2 : 1); ++it2) {
        const int k = DSA_UNIT(it2);
        if (k >= 4096) continue;
        const int b = k & 1, s0 = (2047 - (k >> 1)) * 4, tok0 = b * SEQ + s0;
        const int ntile = (s0 + 3) / 16 + 1, npad = ntile * 16;
        const bool sel = (s0 >= 256);
        if (pref_k != k) DSA_QLOAD(k);
        __syncthreads();
        if (sel) for (int i = tid; i < 4096; i += NBLK) HIST[i] = 0u;
        __syncthreads();
        {
            bf16x8 a[2][2]; f32x4 wv[2];
#pragma unroll
            for (int mt = 0; mt < 2; ++mt) { a[mt][0] = an[mt][0]; a[mt][1] = an[mt][1]; wv[mt] = wn[mt]; }
            const bf16_t* kbase = KIA + (size_t)(b * (SEQ / 16)) * 1024 + lane * 8;
            bf16x8 kb[2][4][2];
#define DSA_KLOAD(buf, t0) do { _Pragma("unroll") for (int u = 0; u < 4; ++u) { const bf16_t* kp = kbase + (size_t)min((t0) + 8 * u, ntile - 1) * 1024; \
                kb[buf][u][0] = *(const bf16x8*)kp; kb[buf][u][1] = *(const bf16x8*)(kp + 512); } } while (0)
            for (int srep = 0; srep < (REPEAT_GROUP == 21 ? 2 : 1); ++srep) {
            DSA_KLOAD(0, wave);
            for (int tile00 = wave; tile00 < ntile; tile00 += 64) {
#pragma unroll
              for (int hb = 0; hb < 2; ++hb) {
                const int tile0 = tile00 + hb * 32;
                if (hb == 0) DSA_KLOAD(1, tile0 + 32); else DSA_KLOAD(0, tile0 + 32);
#pragma unroll
                for (int u = 0; u < 4; ++u) {
                    const int tile = tile0 + 8 * u;
                    if (tile < ntile) {
                        const int key = tile * 16 + fr;
                        float tot = 0.f;
#pragma unroll
                        for (int mt = 0; mt < 2; ++mt) {
                            f32x4 acc = (f32x4){0.f, 0.f, 0.f, 0.f};
                            acc = mfma16(a[mt][0], kb[hb][u][0], acc); acc = mfma16(a[mt][1], kb[hb][u][1], acc);
#define DSA_RELU(x) __builtin_amdgcn_fmed3f((x), 0.f, 3.0e38f)
                            const float r0 = DSA_RELU(acc.x), r1 = DSA_RELU(acc.y), r2 = DSA_RELU(acc.z), r3 = DSA_RELU(acc.w);
                            asm("v_fmac_f32_e32 %0, %1, %2" : "+v"(tot) : "v"(wv[mt].x), "v"(r0)); asm("v_fmac_f32_e32 %0, %1, %2" : "+v"(tot) : "v"(wv[mt].y), "v"(r1));
                            asm("v_fmac_f32_e32 %0, %1, %2" : "+v"(tot) : "v"(wv[mt].z), "v"(r2)); asm("v_fmac_f32_e32 %0, %1, %2" : "+v"(tot) : "v"(wv[mt].w), "v"(r3));
#undef DSA_RELU
                        }
                        const int r = fq;
                        const unsigned fb = __float_as_uint(tot);
                        unsigned uk = fb ^ ((unsigned)((int)fb >> 31) | 0x80000000u);
                        if (tile == ntile - 1) uk = (key <= s0 + r) ? uk : 0u;
                        SC[r * 8192 + key] = uk;
                        if (sel && srep == 0 && uk != 0u) { const unsigned d = uk >> 21; atomicAdd(&HIST[r * 1024 + (d >> 1)], (d & 1u) ? 65536u : 1u); if (REPEAT_GROUP == 22) atomicAdd(&HIST[r * 1024 + (d >> 1)], 0u); }
                    }
                }
              }
            }
            }
#undef DSA_KLOAD
        }
        { const int kn = DSA_UNIT(it2 + 1); if ((it2 + 1) * nvb < 4096 * (REPEAT_GROUP == 2 ? 2 : 1) && kn < 4096) DSA_QLOAD(kn); }
        __syncthreads();
        if (!sel) {
            const int r = tid >> 7, tl = tid & 127, n = s0 + r + 1;
            for (int i = tl; i < 256; i += 128) SEL[r * 256 + i] = (unsigned short)(i < n ? i : 0);
            if (tl == 0) MISC[8 + r] = (unsigned)n;
        } else {
            const int r = tid >> 7, tl = tid & 127, hi = tl >> 6;
            unsigned* CK = (unsigned*)(g_lds + DSA_CAND); unsigned short* CI = (unsigned short*)(g_lds + DSA_CAND + 8192);
            for (int selrep = 0; selrep < (REPEAT_GROUP == 23 ? 2 : 1); ++selrep) {
            const unsigned long long ltm = (1ull << lane) - 1ull;
            unsigned prefix = 0u; int need = 256;
            {
                unsigned s = 0u;
                for (int w = 0; w < 8; ++w) { const unsigned hw = HIST[r * 1024 + tl * 8 + w]; s += (hw & 0xffffu) + (hw >> 16); }
                unsigned incl = s;
#pragma unroll
                for (int off = 1; off < 64; off <<= 1) { const unsigned t2 = __shfl_down(incl, off); if (lane + off < 64) incl += t2; }
                if (hi == 1 && lane == 0) PART[r] = incl;
                __syncthreads();
                const unsigned above = (incl - s) + (hi == 0 ? PART[r] : 0u);
                if ((int)above < need && need <= (int)(above + s)) {
                    unsigned cum = above; int dsel = tl * 16;
                    for (int d = tl * 16 + 15; d >= tl * 16; --d) {
                        const unsigned hw = HIST[r * 1024 + (d >> 1)]; const unsigned c = (d & 1) ? (hw >> 16) : (hw & 0xffffu);
                        if ((int)(cum + c) >= need) { dsel = d; break; }
                        cum += c;
                    }
                    MISC[r] = (unsigned)dsel; MISC[4 + r] = (unsigned)(need - (int)cum);
                }
                __syncthreads();
                prefix = MISC[r]; need = (int)MISC[4 + r];
            }
            const int ngt1 = 256 - need;
            {
                const int mid = ((npad >> 1) + 63) & ~63, lo_i = hi ? mid : 0, hi_i = hi ? npad : mid;
                const int ngr = (hi_i - lo_i + 63) >> 6;
                unsigned mg0 = 0u, mg1 = 0u, me0 = 0u, me1 = 0u;
#pragma unroll 4
                for (int gidx = 0; gidx < ngr; ++gidx) {
                    const int i = lo_i + gidx * 64 + lane; const unsigned u = (i < hi_i) ? SC[r * 8192 + i] : 0u; const unsigned bin = u >> 21;
                    const unsigned long long mg = __ballot(bin > prefix), me = __ballot((bin == prefix) && (u != 0u));
                    const bool mine = (lane == gidx);
                    mg0 = mine ? (unsigned)mg : mg0; mg1 = mine ? (unsigned)(mg >> 32) : mg1; me0 = mine ? (unsigned)me : me0; me1 = mine ? (unsigned)(me >> 32) : me1;
                }
                const unsigned packed = (unsigned)(__popc(mg0) + __popc(mg1)) | ((unsigned)(__popc(me0) + __popc(me1)) << 16);
                unsigned incl = packed;
#pragma unroll
                for (int off = 1; off < 64; off <<= 1) { const unsigned t2 = __shfl_up(incl, off); if (lane >= off) incl += t2; }
                int pg = (int)((incl - packed) & 0xffffu), pe = (int)((incl - packed) >> 16);
                const int cc = (int)(__shfl(incl, 63) >> 16);
                unsigned long long m = ((unsigned long long)mg1 << 32) | mg0;
                while (m) { const int i = lo_i + lane * 64 + __builtin_ctzll(m); m &= m - 1ull; SEL[r * 256 + (hi ? (ngt1 - 1 - pg) : pg)] = (unsigned short)i; ++pg; }
                m = ((unsigned long long)me1 << 32) | me0;
                while (m) { const int i = lo_i + lane * 64 + __builtin_ctzll(m); m &= m - 1ull;
                    if (pe < 512) { const int q = hi ? (511 - pe) : pe; const unsigned u = SC[r * 8192 + i]; CK[r * 512 + q] = ((u & 0x1FFFFFu) << 10) | (unsigned)((hi ? 511 : 1023) - pe); CI[r * 512 + q] = (unsigned short)i; }
                    ++pe; }
                if (lane == 0) MISC[12 + r * 2 + hi] = (unsigned)cc;
            }
            __syncthreads();
            bool ovf = false;
#pragma unroll
            for (int q = 0; q < 4; ++q) ovf |= (MISC[12 + q * 2] + MISC[13 + q * 2] > 512u);
            if (!ovf) {
                const int c0 = (int)MISC[12 + r * 2], c1 = (int)MISC[13 + r * 2], C = c0 + c1;
                unsigned kc[4]; int rank[4]; unsigned short ki[4];
#pragma unroll
                for (int q = 0; q < 4; ++q) { const int c = tl + q * 128; const int qc = (c < c0) ? c : (512 - C + c); kc[q] = (c < C) ? CK[r * 512 + qc] : ~0u; ki[q] = (c < C) ? CI[r * 512 + qc] : (unsigned short)0; rank[q] = 0; }
                const unsigned* s0 = CK + r * 512; const unsigned* s1 = CK + r * 512 + (512 - c1);
                if (C <= 256) {
#pragma unroll 8
                    for (int c2 = 0; c2 < c0; ++c2) { const unsigned k2 = s0[c2]; rank[0] += (k2 > kc[0]) ? 1 : 0; rank[1] += (k2 > kc[1]) ? 1 : 0; }
#pragma unroll 8
                    for (int c2 = 0; c2 < c1; ++c2) { const unsigned k2 = s1[c2]; rank[0] += (k2 > kc[0]) ? 1 : 0; rank[1] += (k2 > kc[1]) ? 1 : 0; }
                } else {
#pragma unroll 8
                    for (int c2 = 0; c2 < c0; ++c2) { const unsigned k2 = s0[c2];
#pragma unroll
                        for (int q = 0; q < 4; ++q) rank[q] += (k2 > kc[q]) ? 1 : 0; }
#pragma unroll 8
                    for (int c2 = 0; c2 < c1; ++c2) { const unsigned k2 = s1[c2];
#pragma unroll
                        for (int q = 0; q < 4; ++q) rank[q] += (k2 > kc[q]) ? 1 : 0; }
                }
#pragma unroll
                for (int q = 0; q < 4; ++q) if (tl + q * 128 < C && rank[q] < need) SEL[r * 256 + ngt1 + rank[q]] = ki[q];
                if (tl == 0) MISC[8 + r] = 256u;
            } else if (selrep == 0) {
#pragma unroll 1
                for (int pass = 1; pass < 3; ++pass) {
                    const int shift = pass == 1 ? 10 : 0, nbits = pass == 2 ? 10 : 11, per = (1 << nbits) / 128;
                    for (int i = tl; i < 1024; i += 128) HIST[r * 1024 + i] = 0u;
                    __syncthreads();
                    for (int i = tl; i < npad; i += 128) {
                        const unsigned u = SC[r * 8192 + i];
                        if ((u >> (shift + nbits)) == prefix) { const unsigned d = (u >> shift) & ((1u << nbits) - 1u); atomicAdd(&HIST[r * 1024 + (d >> 1)], (d & 1u) ? 65536u : 1u); }
                    }
                    __syncthreads();
                    unsigned s = 0u;
                    for (int w = 0; w < per / 2; ++w) { const unsigned hw = HIST[r * 1024 + tl * (per / 2) + w]; s += (hw & 0xffffu) + (hw >> 16); }
                    unsigned incl = s;
#pragma unroll
                    for (int off = 1; off < 64; off <<= 1) { const unsigned t2 = __shfl_down(incl, off); if (lane + off < 64) incl += t2; }
                    if (hi == 1 && lane == 0) PART[r] = incl;
                    __syncthreads();
                    const unsigned above = (incl - s) + (hi == 0 ? PART[r] : 0u);
                    if ((int)above < need && need <= (int)(above + s)) {
                        unsigned cum = above; int dsel = tl * per;
                        for (int d = tl * per + per - 1; d >= tl * per; --d) {
                            const unsigned hw = HIST[r * 1024 + (d >> 1)]; const unsigned c = (d & 1) ? (hw >> 16) : (hw & 0xffffu);
                            if ((int)(cum + c) >= need) { dsel = d; break; }
                            cum += c;
                        }
                        MISC[r] = (prefix << nbits) | (unsigned)dsel; MISC[4 + r] = (unsigned)(need - (int)cum);
                    }
                    __syncthreads();
                    prefix = MISC[r]; need = (int)MISC[4 + r];
                }
                if (wave < 4) {
                    const int rr = wave; const unsigned Kst = MISC[rr]; const int nd = (int)MISC[4 + rr], ngt = 256 - nd;
                    int cg = 0, ce = 0;
                    for (int base = 0; base < npad; base += 64) {
                        const int i0 = base + lane;
                        const unsigned u0 = (i0 < npad) ? SC[rr * 8192 + i0] : 0u;
                        const bool gt0 = u0 > Kst, eq0 = (u0 == Kst);
                        const unsigned long long mg0 = __ballot(gt0), me0 = __ballot(eq0);
                        if (gt0) SEL[rr * 256 + cg + __popcll(mg0 & ltm)] = (unsigned short)i0;
                        if (eq0) { const int rk = ce + __popcll(me0 & ltm); if (rk < nd) SEL[rr * 256 + ngt + rk] = (unsigned short)i0; }
                        cg += __popcll(mg0); ce += __popcll(me0);
                    }
                    if (lane == 0) MISC[8 + rr] = 256u;
                }
            }
            if (REPEAT_GROUP == 23) __syncthreads();
            }
        }
        __syncthreads();
        {
            unsigned short* SELG = (unsigned short*)(ws + OFF_SELG);
            if (tid < 128) { const int r = tid >> 5, c8 = tid & 31;
                *(u32x4*)(SELG + (size_t)(tok0 + r) * 256 + c8 * 8) = *(const u32x4*)(SEL + r * 256 + c8 * 8); }
        }
    }
}

#undef DSA_QLOAD
#undef DSA_UNIT
DEV void ph_dsa_attn(const Params& p, int vb, int nvb) {
    unsigned char* ws = p.ws;
    const bf16_t* QA = (const bf16_t*)(ws + OFF_QA); const bf16_t* KV = (const bf16_t*)(ws + OFF_KV); bf16_t* MIX = (bf16_t*)(ws + OFF_MIX);
    const unsigned short* SELG = (const unsigned short*)(ws + OFF_SELG);
    unsigned* Q = (unsigned*)(ws + OFF_CTL) + CW_DSAQ;
    int tz = TIDX; asm volatile("" : "+v"(tz));
    const int tid = tz, wave = tid >> 6, lane = tid & 63, fr = lane & 15, fq = lane >> 4;
    float* P = (float*)g_lds + wave * 1024;
    unsigned short* SELW = (unsigned short*)(g_lds + 32768) + wave * 256;
    const int grp0 = (int)((xb_xcc_id() >> 1) & 3u);
    const float scale = 0.08838834764831845f;
    for (int gi = 0; gi < 4; ++gi) {
        const int grp = (grp0 + gi) & 3, b = grp >> 1, g = grp & 1;
        const unsigned char* kvb = (const unsigned char*)KV + (size_t)(b * SEQ) * 512 + g * 256;
        for (;;) {
            unsigned chunk = 0;
            if (lane == 0) chunk = atomicAdd(&Q[grp * 64], 1u);
            chunk = (unsigned)__builtin_amdgcn_readfirstlane((int)chunk);
            if (chunk >= 2048u) break;
            const int sbase = (2047 - (int)chunk) * 4;
            u32x2 selnext = *(const u32x2*)(SELG + (size_t)(b * SEQ + sbase) * 256 + lane * 4);
#pragma unroll 1
            for (int rr = 0; rr < 4; ++rr) {
                const int sl = sbase + rr, tok = b * SEQ + sl, ns = min(sl + 1, 256);
                *(u32x2*)(SELW + lane * 4) = selnext;
                if (rr < 3) selnext = *(const u32x2*)(SELG + (size_t)(tok + 1) * 256 + lane * 4);
                bf16x8 qf[4];
#pragma unroll
                for (int ks = 0; ks < 4; ++ks) {
                    bf16x8 z = {0, 0, 0, 0, 0, 0, 0, 0};
                    qf[ks] = (fr < 4) ? *(const bf16x8*)(QA + (size_t)tok * 1024 + (4 * g + fr) * 128 + fq * 32 + ks * 8) : z;
                }
                __builtin_amdgcn_wave_barrier();
                float sc[4][4];
                {
                    u32x4 kf[16][2];
#define ATT_KLOAD(u0, u1) do { _Pragma("unroll") for (int u = (u0); u < (u1); ++u) { const int j = u * 16 + fr; const int idx = (j < ns) ? (int)SELW[j] : 0; \
                        const unsigned char* kp = kvb + (size_t)idx * 512 + fq * 32; kf[u][0] = *(const u32x4*)kp; kf[u][1] = *(const u32x4*)(kp + 16); } } while (0)
#define ATT_KUSE(u0, u1) do { _Pragma("unroll") for (int u = (u0); u < (u1); ++u) { f32x4 acc = (f32x4){0.f, 0.f, 0.f, 0.f}; \
                        _Pragma("unroll") for (int ks = 0; ks < 4; ++ks) { const u32x4 kq = kf[u][ks >> 1]; acc = mfma16(qf[ks], fp8x8_to_bf16((ks & 1) ? (u32x2){kq.z, kq.w} : (u32x2){kq.x, kq.y}), acc); } \
                        _Pragma("unroll") for (int h = 0; h < 4; ++h) { const float t = __shfl(acc[h], fr); if (fq == (u & 3)) sc[u >> 2][h] = t; } \
                        __builtin_amdgcn_sched_barrier(0); } } while (0)
                    ATT_KLOAD(0, 8);
                    __builtin_amdgcn_sched_barrier(0);
                    ATT_KUSE(0, 4);
                    ATT_KLOAD(8, 12);
                    __builtin_amdgcn_sched_barrier(0);
                    ATT_KUSE(4, 8);
                    ATT_KLOAD(12, 16);
                    __builtin_amdgcn_sched_barrier(0);
                    ATT_KUSE(8, 16);
#undef ATT_KLOAD
#undef ATT_KUSE
                }
                const unsigned char* vb2 = kvb + 128 + fr * 8;
                const int ngrp = (ns + 3) >> 2;
                u32x2 vvA[16], vvB[16];
#define ATT_VLOAD(vv, g0) do { _Pragma("unroll") for (int u = 0; u < 16; ++u) { const int j = min(((g0) + u) * 4 + fq, 255); const int idx = (int)SELW[j]; vv[u] = *(const u32x2*)(vb2 + (size_t)idx * 512); } } while (0)
                ATT_VLOAD(vvA, 0);
                __builtin_amdgcn_sched_barrier(0);
#pragma unroll
                for (int i = 0; i < 4; ++i) {
                    const bool vld = ((i * 4 + fq) * 16 + fr) < ns;
#pragma unroll
                    for (int h = 0; h < 4; ++h) sc[i][h] = vld ? sc[i][h] * scale : -INFINITY;
                }
                float mx[4], sm[4];
#pragma unroll
                for (int h = 0; h < 4; ++h) { mx[h] = wave_max(fmaxf(fmaxf(sc[0][h], sc[1][h]), fmaxf(sc[2][h], sc[3][h]))); sm[h] = 0.f; }
#pragma unroll
                for (int i = 0; i < 4; ++i) {
                    f32x4 pv;
#pragma unroll
                    for (int h = 0; h < 4; ++h) { const float e = __expf(sc[i][h] - mx[h]); pv[h] = e; sm[h] += e; }
                    *(f32x4*)(P + ((i * 4 + fq) * 16 + fr) * 4) = pv;
                }
                float inv[4];
#pragma unroll
                for (int h = 0; h < 4; ++h) inv[h] = __builtin_amdgcn_rcpf(wave_sum(sm[h]));
                __builtin_amdgcn_wave_barrier();
                float o[4][8];
#pragma unroll
                for (int h = 0; h < 4; ++h)
#pragma unroll
                    for (int e = 0; e < 8; ++e) o[h][e] = 0.f;
#define ATT_PV(vv, g0) do { _Pragma("unroll") for (int u = 0; u < 16; ++u) { \
                        const int j = ((g0) + u) * 4 + fq; \
                        f32x4 pv = *(const f32x4*)(P + min(j, 255) * 4); \
                        if (j >= ns) pv = (f32x4){0.f, 0.f, 0.f, 0.f}; \
                        const f32x4 va = up4_fp8(vv[u].x), vb4 = up4_fp8(vv[u].y); \
                        const float v8[8] = {va.x, va.y, va.z, va.w, vb4.x, vb4.y, vb4.z, vb4.w}; \
                        _Pragma("unroll") for (int h = 0; h < 4; ++h) _Pragma("unroll") for (int e = 0; e < 8; ++e) \
                            asm("v_fmac_f32_e32 %0, %1, %2" : "+v"(o[h][e]) : "v"(pv[h]), "v"(v8[e]));        \
                        if ((u & 3) == 3) __builtin_amdgcn_sched_barrier(0);         \
                    } } while (0)
#pragma unroll 1
                for (int g0 = 0; g0 < ngrp; g0 += 32) {
                    if (g0 + 16 < ngrp) ATT_VLOAD(vvB, g0 + 16);
                    __builtin_amdgcn_sched_barrier(0);
                    ATT_PV(vvA, g0);
                    if (g0 + 16 < ngrp) {
                        if (g0 + 32 < ngrp) ATT_VLOAD(vvA, g0 + 32);
                        __builtin_amdgcn_sched_barrier(0);
                        ATT_PV(vvB, g0 + 16);
                    }
                }
#undef ATT_VLOAD
#undef ATT_PV
#pragma unroll
                for (int h = 0; h < 4; ++h)
#pragma unroll
                    for (int e = 0; e < 8; ++e) { float v = o[h][e]; v += __shfl_xor(v, 16); v += __shfl_xor(v, 32); o[h][e] = v * inv[h]; }
                if (fq == 0) {
#pragma unroll
                    for (int h = 0; h < 4; ++h) {
                        if (FP8_OUT0) { u32x2 w8; w8.x = pk4_fp8(o[h][0], o[h][1], o[h][2], o[h][3]); w8.y = pk4_fp8(o[h][4], o[h][5], o[h][6], o[h][7]);
                            *(u32x2*)(ws + OFF_H + (size_t)tok * 2048 + (4 * g + h) * 128 + fr * 8) = w8; }
                        else { u32x4 w; w.x = pk_bf16(o[h][0], o[h][1]); w.y = pk_bf16(o[h][2], o[h][3]); w.z = pk_bf16(o[h][4], o[h][5]); w.w = pk_bf16(o[h][6], o[h][7]);
                            *(u32x4*)(MIX + (size_t)tok * 2048 + (4 * g + h) * 128 + fr * 8) = w; }
                    }
                }
                __builtin_amdgcn_wave_barrier();
            }
        }
    }
}

#ifdef DEBUG_NAN
#define DBG_SUB(cond, code) do { if (cond) atomicMax((unsigned*)(p.ws + OFF_CTL) + 8001, (unsigned)(code)); } while (0)
DEV bool nonfin(float v) { return (__float_as_uint(v) & 0x7f800000u) == 0x7f800000u; }
#else
#define DBG_SUB(cond, code) do {} while (0)
#endif
constexpr int SSD_PITCH = 136;
DEV void ssd_dt_acum(const Params& p, int tok0, int g, float* acum, float* dtv, float* cd_out) {
    const float* DT = (const float*)(p.ws + OFF_DT);
    for (int i = TIDX; i < 1024; i += NBLK) dtv[i] = DT[(size_t)(tok0 + (i >> 3)) * 16 + g * 8 + (i & 7)];
    __syncthreads();
    if (TIDX < 8) {
        const float a = -expf(p.a_log[g * 8 + TIDX]); float run = 0.f;
        for (int row = 0; row < 128; ++row) { run += dtv[row * 8 + TIDX] * a; acum[row * 8 + TIDX] = run; }
        if (cd_out) cd_out[g * 8 + TIDX] = expf(run);
    }
    __syncthreads();
}

DEV void ph_ssd_states(const Params& p, int vb, int nvb) {
    unsigned char* ws = p.ws;
    const bf16_t* XC = (const bf16_t*)(ws + OFF_XC); float* ST = (float*)(ws + OFF_ST); float* CD = (float*)(ws + OFF_CD);
    float* acum = (float*)g_lds; float* dtv = (float*)(g_lds + 4096);
    bf16_t* BT = (bf16_t*)(g_lds + 8192); bf16_t* XT = (bf16_t*)(g_lds + 43008);
    const int tid = TIDX, wave = tid >> 6, lane = tid & 63, fr = lane & 15, fq = lane >> 4;
    for (int unit = vb; unit < 256; unit += nvb) {
        const int b = unit >> 7, c = (unit >> 1) & 63, g = unit & 1, tok0 = b * SEQ + c * 128;
        __syncthreads();
        ssd_dt_acum(p, tok0, g, acum, dtv, CD + (size_t)(b * 64 + c) * 16);
        for (int ci = tid; ci < 2048; ci += NBLK) {
            const int j = ci & 127, n8 = ci >> 7;
            const u32x4 w = *(const u32x4*)(XC + (size_t)(tok0 + j) * 1536 + 1024 + g * 128 + n8 * 8);
            const unsigned ww[4] = {w.x, w.y, w.z, w.w};
#pragma unroll
            for (int e = 0; e < 4; ++e) { BT[(n8 * 8 + 2 * e) * SSD_PITCH + j] = (bf16_t)(ww[e] & 0xffffu); BT[(n8 * 8 + 2 * e + 1) * SSD_PITCH + j] = (bf16_t)(ww[e] >> 16); }
        }
        for (int half = 0; half < 2; ++half) {
            __syncthreads();
            for (int ci = tid; ci < 4096; ci += NBLK) {
                const int j = ci & 127, c8 = ci >> 7, chl0 = c8 * 8, hh = half * 4 + (chl0 >> 6);
                const float scl = dtv[j * 8 + hh] * expf(acum[127 * 8 + hh] - acum[j * 8 + hh]);
                float v[8]; ld8(XC + (size_t)(tok0 + j) * 1536 + g * 512 + half * 256 + chl0, v);
#pragma unroll
                for (int e = 0; e < 8; ++e) XT[(chl0 + e) * SSD_PITCH + j] = f2bf(v[e] * scl);
            }
            __syncthreads();
            const int hh4 = wave >> 1, nh = wave & 1;
            f32x4 acc[4][4];
#pragma unroll
            for (int m = 0; m < 4; ++m)
#pragma unroll
                for (int n = 0; n < 4; ++n) acc[m][n] = (f32x4){0.f, 0.f, 0.f, 0.f};
#pragma unroll
            for (int ks = 0; ks < 4; ++ks) {
                bf16x8 af[4], bfr[4];
#pragma unroll
                for (int m = 0; m < 4; ++m) af[m] = *(const bf16x8*)(XT + (hh4 * 64 + m * 16 + fr) * SSD_PITCH + ks * 32 + fq * 8);
#pragma unroll
                for (int n = 0; n < 4; ++n) bfr[n] = *(const bf16x8*)(BT + (nh * 64 + n * 16 + fr) * SSD_PITCH + ks * 32 + fq * 8);
#pragma unroll
                for (int m = 0; m < 4; ++m)
#pragma unroll
                    for (int n = 0; n < 4; ++n) acc[m][n] = mfma16(bfr[n], af[m], acc[m][n]);
            }
            const int h = g * 8 + half * 4 + hh4;
            float* stp = ST + ((size_t)((b * 64 + c) * 16 + h)) * 8192;
#pragma unroll
            for (int m = 0; m < 4; ++m)
#pragma unroll
                for (int n = 0; n < 4; ++n) *(f32x4*)(stp + (m * 16 + fr) * 128 + nh * 64 + n * 16 + fq * 4) = acc[m][n];
        }
    }
}

DEV void ph_ssd_scan(const Params& p, int vb, int nvb) {
    const float* ST = (const float*)(p.ws + OFF_ST); const float* CD = (const float*)(p.ws + OFF_CD); bf16_t* PREV = (bf16_t*)(p.ws + OFF_PREV);
    for (int e = vb * NBLK + TIDX; e < 65536; e += nvb * NBLK) {
        const int b = e >> 15, rem = e & 32767, h = rem >> 11, pn = rem & 2047;
        f32x4 run = (f32x4){0.f, 0.f, 0.f, 0.f};
#pragma unroll 8
        for (int c = 0; c < 64; ++c) {
            const size_t off = ((size_t)((b * 64 + c) * 16 + h)) * 8192 + pn * 4;
            const f32x4 st = *(const f32x4*)(ST + off); const float cd = CD[(b * 64 + c) * 16 + h];
            u32x2 w; w.x = pk_bf16(run.x, run.y); w.y = pk_bf16(run.z, run.w);
            *(u32x2*)(PREV + off) = w;
            run = run * cd + st;
        }
    }
}

DEV void ph_ssd_out(const Params& p, int vb, int nvb) {
    unsigned char* ws = p.ws;
    const bf16_t* XC = (const bf16_t*)(ws + OFF_XC); const bf16_t* Z0 = (const bf16_t*)(ws + OFF_Z); const bf16_t* PREV = (const bf16_t*)(ws + OFF_PREV);
    bf16_t* MIX = (bf16_t*)(ws + OFF_MIX);
    float* acum = (float*)g_lds; float* dtv = (float*)(g_lds + 4096); float* sspart = (float*)(g_lds + 8192); float* rstd = (float*)(g_lds + 16384);
    bf16_t* Cs = (bf16_t*)(g_lds + 17408); bf16_t* BL = (bf16_t*)(g_lds + 52224); bf16_t* CBs = (bf16_t*)(g_lds + 87040); bf16_t* XT = (bf16_t*)(g_lds + 121856);
    constexpr int SO_PATCH = 139264;
    const int tid = TIDX, wave = tid >> 6, lane = tid & 63, fr = lane & 15, fq = lane >> 4, wm = wave >> 1, wn = wave & 1;
    for (int unit = vb; unit < 256; unit += nvb) {
        const int b = unit >> 7, c = (unit >> 1) & 63, g = unit & 1, tok0 = b * SEQ + c * 128;
        __syncthreads();
        ssd_dt_acum(p, tok0, g, acum, dtv, nullptr);
#ifdef DEBUG_NAN
        for (int i = tid; i < 1024; i += NBLK) { DBG_SUB(nonfin(acum[i]), 60); DBG_SUB(nonfin(dtv[i]), 61); DBG_SUB(dtv[i] < 0.f, 62); DBG_SUB(dtv[i] > 100.f, 63); }
        if (tid < 16) DBG_SUB(nonfin(p.a_log[tid]) || p.a_log[tid] > 10.f || p.a_log[tid] < -10.f, 64);
#endif
        for (int ci = tid; ci < 2048; ci += NBLK) {
            const int row = ci >> 4, q = ci & 15;
            *(u32x4*)(Cs + row * SSD_PITCH + q * 8) = *(const u32x4*)(XC + (size_t)(tok0 + row) * 1536 + 1280 + g * 128 + q * 8);
            *(u32x4*)(BL + row * SSD_PITCH + q * 8) = *(const u32x4*)(XC + (size_t)(tok0 + row) * 1536 + 1024 + g * 128 + q * 8);
        }
        __syncthreads();
#ifdef DEBUG_NAN
        for (int i = tid; i < 1024; i += NBLK) DBG_SUB(nonfin(acum[i]), 75);
#endif
        {
            f32x4 acc[2][4];
#pragma unroll
            for (int m = 0; m < 2; ++m)
#pragma unroll
                for (int n = 0; n < 4; ++n) acc[m][n] = (f32x4){0.f, 0.f, 0.f, 0.f};
#pragma unroll
            for (int ks = 0; ks < 4; ++ks) {
                bf16x8 af[2], bfr[4];
#pragma unroll
                for (int m = 0; m < 2; ++m) af[m] = *(const bf16x8*)(Cs + (wm * 32 + m * 16 + fr) * SSD_PITCH + ks * 32 + fq * 8);
#pragma unroll
                for (int n = 0; n < 4; ++n) bfr[n] = *(const bf16x8*)(BL + (wn * 64 + n * 16 + fr) * SSD_PITCH + ks * 32 + fq * 8);
#pragma unroll
                for (int m = 0; m < 2; ++m)
#pragma unroll
                    for (int n = 0; n < 4; ++n) acc[m][n] = mfma16(bfr[n], af[m], acc[m][n]);
            }
#pragma unroll
            for (int m = 0; m < 2; ++m)
#pragma unroll
                for (int n = 0; n < 4; ++n) { u32x2 w; w.x = pk_bf16(acc[m][n].x, acc[m][n].y); w.y = pk_bf16(acc[m][n].z, acc[m][n].w);
#ifdef DEBUG_NAN
                    DBG_SUB(nonfin(acc[m][n].x) || nonfin(acc[m][n].y) || nonfin(acc[m][n].z) || nonfin(acc[m][n].w), 80);
                    DBG_SUB(fabsf(acc[m][n].x) > 1e6f, 81);
                    DBG_SUB((w.x & 0x7f80u) == 0x7f80u || (w.x & 0x7f800000u) == 0x7f800000u || (w.y & 0x7f80u) == 0x7f80u || (w.y & 0x7f800000u) == 0x7f800000u, 82);
#endif
                    *(u32x2*)(CBs + (wm * 32 + m * 16 + fr) * SSD_PITCH + wn * 64 + n * 16 + fq * 4) = w; }
        }
        __syncthreads();
        for (int hh = 0; hh < 8; ++hh) {
            const int h = g * 8 + hh, ch0 = g * 512 + hh * 64;
#ifdef DEBUG_NAN
            for (int i = tid; i < 1024; i += NBLK) DBG_SUB(nonfin(acum[i]), hh == 0 ? 74 : 73);
#endif
            for (int ci = tid; ci < 2048; ci += NBLK) {
                const int i = ci >> 4, j0 = (ci & 15) * 8; const float ai = acum[i * 8 + hh];
                float v[8]; ld8(CBs + i * SSD_PITCH + j0, v);
#ifdef DEBUG_NAN
                for (int e = 0; e < 8; ++e) DBG_SUB(nonfin(v[e]), 78);
#endif
#pragma unroll
                for (int e = 0; e < 8; ++e) { const int j = j0 + e; v[e] = (j <= i) ? v[e] * expf(ai - acum[j * 8 + hh]) : 0.f; }
#ifdef DEBUG_NAN
                for (int e = 0; e < 8; ++e) DBG_SUB(nonfin(v[e]), 53);
                DBG_SUB(nonfin(ai), 54);
#endif
                st8(BL + i * SSD_PITCH + j0, v);
            }
            for (int ci = tid; ci < 1024; ci += NBLK) {
                const int j = ci & 127, p0 = (ci >> 7) * 8; const float d = dtv[j * 8 + hh];
                float v[8]; ld8(XC + (size_t)(tok0 + j) * 1536 + ch0 + p0, v);
#pragma unroll
                for (int e = 0; e < 8; ++e) XT[(p0 + e) * SSD_PITCH + j] = f2bf(v[e] * d);
            }
            __syncthreads();
            f32x4 ad[2][2], ao[2][2];
#pragma unroll
            for (int m = 0; m < 2; ++m)
#pragma unroll
                for (int n = 0; n < 2; ++n) { ad[m][n] = (f32x4){0.f, 0.f, 0.f, 0.f}; ao[m][n] = (f32x4){0.f, 0.f, 0.f, 0.f}; }
            const bf16_t* pv = PREV + ((size_t)((b * 64 + c) * 16 + h)) * 8192;
#pragma unroll
            for (int ks = 0; ks < 4; ++ks) {
                bf16x8 al[2], ac[2], bx[2], bp[2];
#pragma unroll
                for (int m = 0; m < 2; ++m) { al[m] = *(const bf16x8*)(BL + (wm * 32 + m * 16 + fr) * SSD_PITCH + ks * 32 + fq * 8);
                                              ac[m] = *(const bf16x8*)(Cs + (wm * 32 + m * 16 + fr) * SSD_PITCH + ks * 32 + fq * 8); }
#pragma unroll
                for (int n = 0; n < 2; ++n) { bx[n] = *(const bf16x8*)(XT + (wn * 32 + n * 16 + fr) * SSD_PITCH + ks * 32 + fq * 8);
                                              bp[n] = *(const bf16x8*)(pv + (wn * 32 + n * 16 + fr) * 128 + ks * 32 + fq * 8); }
#pragma unroll
                for (int m = 0; m < 2; ++m)
#pragma unroll
                    for (int n = 0; n < 2; ++n) { ad[m][n] = mfma16(bx[n], al[m], ad[m][n]); ao[m][n] = mfma16(bp[n], ac[m], ao[m][n]); }
#ifdef DEBUG_NAN
                for (int m = 0; m < 2; ++m) for (int e = 0; e < 8; ++e) { DBG_SUB(((unsigned short)al[m][e] & 0x7f80u) == 0x7f80u, 50); DBG_SUB(((unsigned short)bx[m][e] & 0x7f80u) == 0x7f80u, 51); }
#endif
            }
            const float dsk = p.ssm_d[h];
#pragma unroll
            for (int m = 0; m < 2; ++m) {
                const float ea = expf(acum[(wm * 32 + m * 16 + fr) * 8 + hh]);
                unsigned char* bb = g_lds + SO_PATCH + wave * 2304;
#pragma unroll
                for (int n = 0; n < 2; ++n) *(f32x4*)(bb + fr * 144 + n * 64 + fq * 16) = ad[m][n] + ao[m][n] * ea;
                const int r2 = lane >> 2, c2 = lane & 3, i = wm * 32 + m * 16 + r2, pc = wn * 32 + c2 * 8;
                const f32x4 t0 = *(const f32x4*)(bb + r2 * 144 + c2 * 32), t1 = *(const f32x4*)(bb + r2 * 144 + c2 * 32 + 16);
                const u32x4 xw = *(const u32x4*)(XC + (size_t)(tok0 + i) * 1536 + ch0 + pc);
                const u32x4 zw = *(const u32x4*)(Z0 + (size_t)(tok0 + i) * LD0 + 2048 + ch0 + pc);
                float xs[8], zz[8]; up8(xw, xs); up8(zw, zz);
                const float t[8] = {t0.x, t0.y, t0.z, t0.w, t1.x, t1.y, t1.z, t1.w};
                float y[8], ssq = 0.f;
#pragma unroll
                for (int e = 0; e < 8; ++e) { y[e] = (t[e] + dsk * xs[e]) * siluf(zz[e]); ssq += y[e] * y[e]; }
                st8(MIX + (size_t)(tok0 + i) * 2048 + 1024 + ch0 + pc, y);
                ssq += __shfl_xor(ssq, 1); ssq += __shfl_xor(ssq, 2);
                if (c2 == 0) sspart[i * 16 + hh * 2 + wn] = ssq;
            }
            __syncthreads();
        }
        if (tid < 128) { float s = 0.f;
#pragma unroll
            for (int k2 = 0; k2 < 16; ++k2) s += sspart[tid * 16 + k2];
            rstd[tid] = rsqrtf(s * (1.f / 512.f) + EPS); }
        WAIT_VM0();
        __syncthreads();
#pragma unroll 4
        for (int k2 = 0; k2 < 16; ++k2) {
            const int ci = tid + k2 * NBLK, i = ci >> 6, cc = g * 512 + (ci & 63) * 8; const float rs = rstd[i];
            bf16_t* yp = MIX + (size_t)(tok0 + i) * 2048 + 1024 + cc;
            const u32x4 yw = *(const u32x4*)yp; const f32x4 g0 = *(const f32x4*)(p.ssm_norm + cc), g1 = *(const f32x4*)(p.ssm_norm + cc + 4);
            if (FP8_OUT0) { u32x2 w8; w8.x = pk4_fp8(bflo(yw.x) * rs * g0.x, bfhi(yw.x) * rs * g0.y, bflo(yw.y) * rs * g0.z, bfhi(yw.y) * rs * g0.w);
                w8.y = pk4_fp8(bflo(yw.z) * rs * g1.x, bfhi(yw.z) * rs * g1.y, bflo(yw.w) * rs * g1.z, bfhi(yw.w) * rs * g1.w);
                *(u32x2*)(ws + OFF_H + (size_t)(tok0 + i) * 2048 + 1024 + cc) = w8; }
            else { u32x4 w; w.x = pk_bf16(bflo(yw.x) * rs * g0.x, bfhi(yw.x) * rs * g0.y); w.y = pk_bf16(bflo(yw.y) * rs * g0.z, bfhi(yw.y) * rs * g0.w);
                w.z = pk_bf16(bflo(yw.z) * rs * g1.x, bfhi(yw.z) * rs * g1.y); w.w = pk_bf16(bflo(yw.w) * rs * g1.z, bfhi(yw.w) * rs * g1.w);
                *(u32x4*)yp = w; }
        }
    }
}

DEV void ph_router(const Params& p, int layer, const float* X, int vb, int nvb) {
    unsigned char* ws = p.ws;
    const float* gnorm = p.ffn_norm + layer * 2048;
    const bf16_t* WRB = (const bf16_t*)(ws + OFF_WRT) + (size_t)layer * 327680;
    bf16_t* H = (bf16_t*)(ws + OFF_H); float* RSTD = (float*)(ws + OFF_RSTD);
    unsigned* cnt = (unsigned*)(ws + OFF_CTL) + CW_CNT + layer * 64;
    unsigned* LIST = (unsigned*)(ws + OFF_LIST) + (size_t)layer * 64 * 16384;
    float* GATE = (float*)(ws + OFF_GATE) + (size_t)layer * 32768;
    float* PART = (float*)g_lds;
    float* SSP = (float*)(g_lds + 147456);
    const int tid = TIDX, wave = tid >> 6, lane = tid & 63, fr = lane & 15, fq = lane >> 4;
    for (int rb = vb; rb < NTOK / 64; rb += nvb) {
        const int row0 = rb * 64;
        __syncthreads();
        f32x4 acc[4][5]; float ssq[4] = {0.f, 0.f, 0.f, 0.f};
#pragma unroll
        for (int mt = 0; mt < 4; ++mt)
#pragma unroll
            for (int nt = 0; nt < 5; ++nt) acc[mt][nt] = (f32x4){0.f, 0.f, 0.f, 0.f};
        f32x4 xr[4][2];
#define RT_XLOAD(mt_, ks_) do { const size_t ro_ = (size_t)(row0 + (mt_) * 16 + fr) * DM + (wave * 8 + (ks_)) * 32 + fq * 8; xr[mt_][0] = *(const f32x4*)(X + ro_); xr[mt_][1] = *(const f32x4*)(X + ro_ + 4); } while (0)
#pragma unroll
        for (int mt = 0; mt < 4; ++mt) RT_XLOAD(mt, 0);
#pragma unroll 1
        for (int ks = 0; ks < 8; ++ks) {
          {
            const int kg = wave * 8 + ks, kb = kg * 32 + fq * 8;
            const bf16_t* bp = WRB + ((size_t)kg * 10 * 64 + lane) * 8;
            bf16x8 bh[5], bl[5];
#pragma unroll
            for (int nt = 0; nt < 5; ++nt) { bh[nt] = *(const bf16x8*)(bp + nt * 512); bl[nt] = *(const bf16x8*)(bp + (5 + nt) * 512); }
            const f32x4 g0 = *(const f32x4*)(gnorm + kb), g1 = *(const f32x4*)(gnorm + kb + 4);
#pragma unroll
            for (int mt = 0; mt < 4; ++mt) {
                const size_t ro = (size_t)(row0 + mt * 16 + fr) * DM + kb;
                const f32x4 x0 = xr[mt][0], x1 = xr[mt][1];
                ssq[mt] += x0.x * x0.x + x0.y * x0.y + x0.z * x0.z + x0.w * x0.w + x1.x * x1.x + x1.y * x1.y + x1.z * x1.z + x1.w * x1.w;
                u32x4 hh; hh.x = pk_bf16(x0.x, x0.y); hh.y = pk_bf16(x0.z, x0.w); hh.z = pk_bf16(x1.x, x1.y); hh.w = pk_bf16(x1.z, x1.w);
                u32x4 ll; ll.x = pk_bf16(x0.x - bflo(hh.x), x0.y - bfhi(hh.x)); ll.y = pk_bf16(x0.z - bflo(hh.y), x0.w - bfhi(hh.y));
                ll.z = pk_bf16(x1.x - bflo(hh.z), x1.y - bfhi(hh.z)); ll.w = pk_bf16(x1.z - bflo(hh.w), x1.w - bfhi(hh.w));
                u32x2 hw; hw.x = pk4_fp8(x0.x * g0.x, x0.y * g0.y, x0.z * g0.z, x0.w * g0.w); hw.y = pk4_fp8(x1.x * g1.x, x1.y * g1.y, x1.z * g1.z, x1.w * g1.w);
                *(u32x2*)((unsigned char*)H + ro) = hw;
                if (ks + 1 < 8) RT_XLOAD(mt, ks + 1);
                const bf16x8 xh = __builtin_bit_cast(bf16x8, hh), xl = __builtin_bit_cast(bf16x8, ll);
#pragma unroll
                for (int nt = 0; nt < 5; ++nt) { acc[mt][nt] = mfma16(xh, bh[nt], acc[mt][nt]); acc[mt][nt] = mfma16(xl, bh[nt], acc[mt][nt]); acc[mt][nt] = mfma16(xh, bl[nt], acc[mt][nt]); }
            }
          }
        }
#undef RT_XLOAD
#pragma unroll
        for (int mt = 0; mt < 4; ++mt) {
#pragma unroll
            for (int nt = 0; nt < 5; ++nt) {
                const int col = nt * 16 + fr;
                if (col < 72) {
#pragma unroll
                    for (int j = 0; j < 4; ++j) PART[(wave * 64 + mt * 16 + fq * 4 + j) * 72 + col] = acc[mt][nt][j];
                }
            }
            float sq = ssq[mt]; sq += __shfl_xor(sq, 16); sq += __shfl_xor(sq, 32);
            if (fq == 0) SSP[wave * 64 + mt * 16 + fr] = sq;
        }
        __syncthreads();
        {
            const int row = tid >> 3, c0 = (tid & 7) * 9;
            float ss = 0.f;
#pragma unroll
            for (int w = 0; w < 8; ++w) ss += SSP[w * 64 + row];
            const float rs = rsqrtf(ss * (1.f / DM) + EPS);
            float sum[9];
#pragma unroll
            for (int c = 0; c < 9; ++c) { float t = 0.f;
#pragma unroll
                for (int w = 0; w < 8; ++w) t += PART[(w * 64 + row) * 72 + c0 + c];
                sum[c] = t * rs; }
#pragma unroll
            for (int c = 0; c < 9; ++c) PART[row * 72 + c0 + c] = sum[c];
            if ((tid & 7) == 0) RSTD[row0 + row] = rs;
        }
        __syncthreads();
        if (tid < 64) {
            const int row = row0 + tid; const float* lg = PART + tid * 72;
            int gi = 0; float gm = lg[0];
            for (int k = 1; k < 8; ++k) if (lg[k] > gm) { gm = lg[k]; gi = k; }
            float se = 0.f; for (int k = 0; k < 8; ++k) se += expf(lg[k] - gm);
            const float pg = 1.f / se;
            const float* el = lg + 8 + gi * 8;
            int i1 = 0; float v1 = el[0];
            for (int k = 1; k < 8; ++k) if (el[k] > v1) { v1 = el[k]; i1 = k; }
            int i2 = -1; float v2 = -INFINITY;
            for (int k = 0; k < 8; ++k) if (k != i1 && el[k] > v2) { v2 = el[k]; i2 = k; }
            const float e2 = expf(v2 - v1), w1 = 1.f / (1.f + e2), w2 = e2 / (1.f + e2);
            const int ea = gi * 8 + i1, eb = gi * 8 + i2;
            GATE[row * 2] = pg * w1; GATE[row * 2 + 1] = pg * w2;
            const unsigned p1 = atomicAdd(&cnt[ea], 1u); LIST[(size_t)ea * 16384 + p1] = (unsigned)(row * 2);
            const unsigned p2 = atomicAdd(&cnt[eb], 1u); LIST[(size_t)eb * 16384 + p2] = (unsigned)(row * 2 + 1);
        }
    }
}

constexpr int MOE_TB = 132 * 1024;
DEV int moe_prefix(const unsigned* cnt) {
    int* tb = (int*)(g_lds + MOE_TB);
    __syncthreads();
    if (TIDX < 64) {
        const int lane = TIDX;
        const int t = (int)((__hip_atomic_load(cnt + lane, __ATOMIC_RELAXED, __HIP_MEMORY_SCOPE_AGENT) + 255u) >> 8);
        int incl = t;
#pragma unroll
        for (int off = 1; off < 64; off <<= 1) { const int v = __shfl_up(incl, off); if (lane >= off) incl += v; }
        tb[lane] = incl - t; if (lane == 63) tb[64] = incl;
    }
    __syncthreads();
    return tb[64];
}
struct MoeSched {
    struct Unit { int e, mt, nt, ce, slot0; };
    const int* tb; const unsigned* cnt; const unsigned* LIST; const bf16_t* A; const bf16_t* W; size_t wstride; int NT, K, G, c, total;
    DEV bool next(int i, Unit& u) const {
        int id;
        if ((G & 7) == 0) { const int k = i * (G >> 3) + (c >> 3); id = (((k >> 2) << 3) + (c & 7)) * 4 + (k & 3); } else id = i * G + c;
        if (id >= total * NT) return false;
        int e = 0, hi = 63; while (e < hi) { const int mid = (e + hi + 1) >> 1; if (tb[mid] * NT <= id) e = mid; else hi = mid - 1; }
        const int te = tb[e + 1] - tb[e], local = id - tb[e] * NT;
        u.e = e; u.nt = local / te; u.mt = local - u.nt * te; u.ce = (int)cnt[e]; u.slot0 = (tb[e] + u.mt) * 256; return true;
    }
    DEV const char* B0(const Unit& u) const { return (const char*)W + (size_t)u.e * wstride + (size_t)u.nt * 256 * K; }
    DEV const char* A0(const Unit& u) const { return (const char*)A + (size_t)u.slot0 * K; }
    DEV const char* Abase() const { return (const char*)A; }
    DEV bool half1(const Unit& u) const { return u.mt * 256 + 128 < u.ce; }
    DEV unsigned rowoff(const Unit& u, int r) const {
        const int idx = u.mt * 256 + r; const unsigned a = LIST[(size_t)u.e * 16384 + (idx < u.ce ? idx : 0)];
        return (a >> 1) * (unsigned)K; }
};
struct EpiGU { bf16_t* HID; const unsigned* LIST; const float* RSTD; unsigned* TSLOT;
    DEV void operator()(const f32x4 (&acc)[2][2][4][2], const MoeSched::Unit& u, int wr, int wc, int fr, int fq) const {
#pragma unroll
        for (int ai = 0; ai < 2; ++ai)
#pragma unroll
            for (int m = 0; m < 4; ++m) {
                const int r = ai * 128 + wr * 64 + m * 16 + fr;
                float rs = 0.f;
                if (u.mt * 256 + r < u.ce) {
                    const unsigned a = LIST[(size_t)u.e * 16384 + u.mt * 256 + r]; rs = RSTD[a >> 1] * 0.03125f;
                    if (u.nt == 0 && wc == 0 && fq == 0) TSLOT[a] = (unsigned)(u.slot0 + r);
                }
                unsigned char* bb = g_lds + g8::EPI_LDS + (wr * 4 + wc) * g8::EPI_WAVE + (m & 1) * g8::EPI_PATCH;
#pragma unroll
                for (int n = 0; n < 2; ++n) {
                    const f32x4 gg = acc[ai][0][m][n] * rs, uu = acc[ai][1][m][n] * rs;
                    *(unsigned*)(bb + fr * 40 + n * 16 + fq * 4) = pk4_fp8(siluf(gg.x) * uu.x, siluf(gg.y) * uu.y, siluf(gg.z) * uu.z, siluf(gg.w) * uu.w);
                }
                const int lane = fq * 16 + fr, r2 = lane >> 2, c2 = lane & 3;
                const u32x2 o = *(const u32x2*)(bb + r2 * 40 + c2 * 8);
                *(u32x2*)((unsigned char*)HID + (size_t)(u.slot0 + ai * 128 + wr * 64 + m * 16 + r2) * 512 + u.nt * 128 + wc * 32 + c2 * 8) = o;
            }
    } };
struct EpiDown { bf16_t* Y;
    DEV void operator()(const f32x4 (&acc)[2][2][4][2], const MoeSched::Unit& u, int wr, int wc, int fr, int fq) const {
#pragma unroll
        for (int ai = 0; ai < 2; ++ai)
#pragma unroll
            for (int m = 0; m < 4; ++m) {
                const int lane = fq * 16 + fr, r2 = lane >> 2, c2 = lane & 3;
                unsigned char* yp = (unsigned char*)Y + (size_t)(u.slot0 + ai * 128 + wr * 64 + m * 16 + r2) * 2048 + u.nt * 256 + wc * 32 + c2 * 8;
#pragma unroll
                for (int bj = 0; bj < 2; ++bj) {
                    unsigned char* bb = g_lds + g8::EPI_LDS + (wr * 4 + wc) * g8::EPI_WAVE + bj * g8::EPI_PATCH;
#pragma unroll
                    for (int n = 0; n < 2; ++n) {
                        const f32x4 v = (MX_DOWN == 2) ? acc[ai][bj][m][n] : acc[ai][bj][m][n] * 0.25f;
                        *(unsigned*)(bb + fr * 40 + n * 16 + fq * 4) = pk4_fp8(v.x, v.y, v.z, v.w);
                    }
                    *(u32x2*)(yp + bj * 128) = *(const u32x2*)(bb + r2 * 40 + c2 * 8);
                }
            }
    } };
DEV void ph_moe_gu(const Params& p, int layer, int vb, int nvb) {
    unsigned char* ws = p.ws;
    const unsigned* cnt = (const unsigned*)(ws + OFF_CTL) + CW_CNT + layer * 64;
    const int total = __builtin_amdgcn_readfirstlane(moe_prefix(cnt));
    MoeSched S; S.tb = (const int*)(g_lds + MOE_TB); S.cnt = cnt; S.LIST = (const unsigned*)(ws + OFF_LIST) + (size_t)layer * 64 * 16384; S.total = total;
    S.A = (const bf16_t*)(ws + OFF_H); S.W = (const bf16_t*)(ws + OFF_WGU + (size_t)layer * 64 * 1024 * 2048); S.wstride = (size_t)1024 * 2048;   S.NT = 4; S.K = 2048; S.G = nvb; S.c = vb;
    EpiGU E{(bf16_t*)(ws + OFF_HID), S.LIST, (const float*)(ws + OFF_RSTD), (unsigned*)(ws + OFF_TSLOT)};
    g8::gemm_phase<true, EpiGU, MoeSched, MX_GU>(2048, S, E);
}
DEV void ph_moe_down(const Params& p, int layer, int vb, int nvb) {
    unsigned char* ws = p.ws;
    const unsigned* cnt = (const unsigned*)(ws + OFF_CTL) + CW_CNT + layer * 64;
    const int total = __builtin_amdgcn_readfirstlane(moe_prefix(cnt));
    MoeSched S; S.tb = (const int*)(g_lds + MOE_TB); S.cnt = cnt; S.LIST = (const unsigned*)(ws + OFF_LIST) + (size_t)layer * 64 * 16384; S.total = total;
    S.A = (const bf16_t*)(ws + OFF_HID); S.W = (const bf16_t*)(ws + OFF_WD + (size_t)layer * 64 * 2048 * 512); S.wstride = (size_t)2048 * 512;   S.NT = 8; S.K = 512; S.G = nvb; S.c = vb;
    EpiDown E{(bf16_t*)(ws + OFF_Y)};
    g8::gemm_phase<false, EpiDown, MoeSched, MX_DOWN, 2>(512, S, E);
}

DEV void ph_combine(const Params& p, int layer, float* X, const float* g  , int vb, int nvb) {
    const bf16_t* Y = (const bf16_t*)(p.ws + OFF_Y); bf16_t* H = (bf16_t*)(p.ws + OFF_H); unsigned char* H8 = p.ws + OFF_MIX;
    const unsigned* TSLOT = (const unsigned*)(p.ws + OFF_TSLOT); const float* GATE = (const float*)(p.ws + OFF_GATE) + (size_t)layer * 32768;
    const int wave = TIDX >> 6, lane = TIDX & 63;
    for (int row = vb * 8 + wave; row < NTOK; row += nvb * 8) {
        f32x4 v[8]; float ss = 0.f;
        const size_t r0 = (size_t)TSLOT[2 * row] * DM, r1 = (size_t)TSLOT[2 * row + 1] * DM; const float g0 = GATE[2 * row] * 0.25f, g1 = GATE[2 * row + 1] * 0.25f;
        const unsigned char* Y8 = (const unsigned char*)Y;
#pragma unroll
        for (int i = 0; i < 8; ++i) {
            const int c = (i * 64 + lane) * 4;
            f32x4 x4 = *(const f32x4*)(X + (size_t)row * DM + c);
            const f32x4 y0 = up4_fp8(*(const unsigned*)(Y8 + r0 + c)), y1 = up4_fp8(*(const unsigned*)(Y8 + r1 + c));
            x4.x += g0 * y0.x + g1 * y1.x; x4.y += g0 * y0.y + g1 * y1.y; x4.z += g0 * y0.z + g1 * y1.z; x4.w += g0 * y0.w + g1 * y1.w;
            *(f32x4*)(X + (size_t)row * DM + c) = x4; v[i] = x4;
            ss += x4.x * x4.x + x4.y * x4.y + x4.z * x4.z + x4.w * x4.w;
        }
        if (g) {
            ss = wave_sum(ss); const float r = rsqrtf(ss * (1.f / DM) + EPS);
#pragma unroll
            for (int i = 0; i < 8; ++i) { const f32x4 g4 = ((const f32x4*)g)[i * 64 + lane];
                u32x2 w; w.x = pk_bf16(v[i].x * r * g4.x, v[i].y * r * g4.y); w.y = pk_bf16(v[i].z * r * g4.z, v[i].w * r * g4.w);
                *(u32x2*)(H + (size_t)row * DM + (i * 64 + lane) * 4) = w;
                *(unsigned*)(H8 + (size_t)row * DM + (i * 64 + lane) * 4) = pk4_fp8(v[i].x * r * g4.x, v[i].y * r * g4.y, v[i].z * r * g4.z, v[i].w * r * g4.w); }
        }
    }
}

typedef short s16x4 __attribute__((ext_vector_type(4)));
DEV bf16x8 tr_frag(const bf16_t* tile, int pitch, int k0, int n0, int lane) {
    const int t16 = lane & 15, kq = lane >> 4;
    const bf16_t* a = tile + (k0 + 8 * kq + (t16 >> 2)) * pitch + n0 + (t16 & 3) * 4;
    const s16x4 lo = __builtin_amdgcn_ds_read_tr16_b64_v4i16((LAS s16x4*)a);
    const s16x4 hi = __builtin_amdgcn_ds_read_tr16_b64_v4i16((LAS s16x4*)(a + 4 * pitch));
    return (bf16x8){lo[0], lo[1], lo[2], lo[3], hi[0], hi[1], hi[2], hi[3]};
}
#if VG_FP8
typedef u32x2 vg8_t;
DEV vg8_t ld_vg8(const bf16_t* Z1, size_t tok, int e8) { return *(const u32x2*)((const unsigned char*)Z1 + tok * (size_t)(LD1 * 2) + 8192 + e8); }
DEV u32x4 vg8_bf(vg8_t w) { return __builtin_bit_cast(u32x4, fp8x8_to_bf16(w)); }
#else
typedef u32x4 vg8_t;
DEV vg8_t ld_vg8(const bf16_t* Z1, size_t tok, int e8) { return *(const u32x4*)(Z1 + tok * LD1 + 4096 + e8); }
DEV u32x4 vg8_bf(vg8_t w) { return w; }
#endif
DEV float ret_lg(int h) { return log1pf(-exp2f(-5.f - (float)h)); }
DEV void ph_rope1(const Params& p, int vb, int nvb) {
    bf16_t* Z1 = (bf16_t*)(p.ws + OFF_Z);
    const int wave = TIDX >> 6, lane = TIDX & 63;
    const float L2T = 13.287712379549449f;
    const float inv0 = exp2f(-(float)(2 * lane) * (1.f / 128.f) * L2T), inv1 = exp2f(-(float)(2 * lane + 1) * (1.f / 128.f) * L2T);
    for (int tok = vb * 8 + wave; tok < NTOK; tok += nvb * 8) {
        const float posf = (float)p.pos[tok];
        float s0, c0, s1, c1; sincosf(posf * inv0, &s0, &c0); sincosf(posf * inv1, &s1, &c1);
        bf16_t* z = Z1 + (size_t)tok * LD1;
#pragma unroll
        for (int hq = 0; hq < 16; ++hq) {
            bf16_t* hp = z + hq * 256 + 2 * lane;
            const unsigned a = *(const unsigned*)hp, b2 = *(const unsigned*)(hp + 128);
            const float x10 = bflo(a), x11 = bfhi(a), x20 = bflo(b2), x21 = bfhi(b2);
            const float sc = hq >= 8 ? 0.0625f : 1.f;
            *(unsigned*)hp = pk_bf16((x10 * c0 - x20 * s0) * sc, (x11 * c1 - x21 * s1) * sc);
            *(unsigned*)(hp + 128) = pk_bf16((x20 * c0 + x10 * s0) * sc, (x21 * c1 + x11 * s1) * sc);
        }
    }
}

DEV void ph_ret_kv(const Params& p, int vb, int nvb) {
    const bf16_t* Z1 = (const bf16_t*)(p.ws + OFF_Z); bf16_t* KVL = (bf16_t*)(p.ws + OFF_KVLOC);
    constexpr int TP = 272;
    bf16_t* Vs = (bf16_t*)g_lds; bf16_t* Ks = (bf16_t*)(g_lds + 69632);
    const int tid = TIDX, wave = tid >> 6, lane = tid & 63, fr = lane & 15, fq = lane >> 4, wm = wave >> 1, wn = wave & 1;
    for (int u = vb; u < 1024; u += nvb) {
        const int c = u & 63, h = (u >> 6) & 7, b = u >> 9, tok0 = b * SEQ + c * 128;
        const float lg = ret_lg(h);
        __syncthreads();
        vg8_t vpre[8];
#pragma unroll
        for (int k2 = 0; k2 < 8; ++k2) {
            const int ci = tid + k2 * NBLK, j = ci >> 5, d0 = (ci & 31) * 8; const float dec = expf((float)(127 - j) * lg);
            float v[8]; ld8(Z1 + (size_t)(tok0 + j) * LD1 + 2048 + h * 256 + d0, v);
#pragma unroll
            for (int e = 0; e < 8; ++e) v[e] *= dec;
            st8(Ks + j * TP + d0, v);
            vpre[k2] = ld_vg8(Z1, (size_t)(tok0 + j), h * 512 + d0);
        }
#pragma unroll 1
        for (int vh = 0; vh < 2; ++vh) {
            if (vh > 0) __syncthreads();
#pragma unroll
            for (int k2 = 0; k2 < 8; ++k2) { const int ci = tid + k2 * NBLK, j = ci >> 5, d0 = (ci & 31) * 8; *(u32x4*)(Vs + j * TP + d0) = vg8_bf(vpre[k2]); }
            __syncthreads();
            if (vh == 0) {
#pragma unroll
                for (int k2 = 0; k2 < 8; ++k2) { const int ci = tid + k2 * NBLK, j = ci >> 5, d0 = (ci & 31) * 8; vpre[k2] = ld_vg8(Z1, (size_t)(tok0 + j), h * 512 + 256 + d0); }
            }
            f32x4 acc[4][8];
#pragma unroll
            for (int m = 0; m < 4; ++m)
#pragma unroll
                for (int n = 0; n < 8; ++n) acc[m][n] = (f32x4){0.f, 0.f, 0.f, 0.f};
#pragma unroll 1
            for (int ks = 0; ks < 4; ++ks) {
                bf16x8 af[4];
#pragma unroll
                for (int m = 0; m < 4; ++m) af[m] = tr_frag(Vs, TP, ks * 32, wm * 64 + m * 16, lane);
#pragma unroll
                for (int n = 0; n < 8; ++n) { const bf16x8 bfr = tr_frag(Ks, TP, ks * 32, wn * 128 + n * 16, lane);
#pragma unroll
                    for (int m = 0; m < 4; ++m) acc[m][n] = mfma16(bfr, af[m], acc[m][n]); }
            }
#pragma unroll
            for (int m = 0; m < 4; ++m)
#pragma unroll
                for (int n = 0; n < 8; n += 2) {
                    const unsigned x = pk4_fp8(acc[m][n].x * 8.f, acc[m][n].y * 8.f, acc[m][n].z * 8.f, acc[m][n].w * 8.f);
                    const unsigned y = pk4_fp8(acc[m][n + 1].x * 8.f, acc[m][n + 1].y * 8.f, acc[m][n + 1].z * 8.f, acc[m][n + 1].w * 8.f);
                    const auto pr = __builtin_amdgcn_permlane16_swap(x, y, false, false);
                    u32x2 w; w.x = pr[0]; w.y = pr[1];
                    const int vg = vh * 16 + wm * 4 + m, ks = wn * 4 + (n >> 1), fq2 = (fq & 1) * 2 + (fq >> 1);
                    *(u32x2*)((unsigned char*)KVL + ((((size_t)u * 32 + vg) * 8 + ks) * 64 + fq2 * 16 + fr) * 8) = w;
                }
        }
    }
}
DEV void ph_ret_scan(const Params& p, int vb, int nvb) {
    unsigned char* KVL = p.ws + OFF_KVLOC;
    int tz = TIDX; asm volatile("" : "+v"(tz));
    for (int e = vb * NBLK + tz; e < 16 * 16384; e += nvb * NBLK) {
        const int bh = e >> 14, rem = e & 16383; const float cdec = expf(128.f * ret_lg(bh & 7));
        float run[8];
#pragma unroll
        for (int i = 0; i < 8; ++i) run[i] = 0.f;
#pragma unroll 8
        for (int c = 0; c < 64; ++c) {
            unsigned char* sp = KVL + ((size_t)(bh * 64 + c) * 16384 + rem) * 8;
            const u32x2 w = *(const u32x2*)sp;
            u32x2 o; o.x = pk4_fp8(run[0], run[1], run[2], run[3]); o.y = pk4_fp8(run[4], run[5], run[6], run[7]);
            *(u32x2*)sp = o;
            const f32x4 a = up4_fp8(w.x), b2 = up4_fp8(w.y);
            run[0] = run[0] * cdec + a.x; run[1] = run[1] * cdec + a.y; run[2] = run[2] * cdec + a.z; run[3] = run[3] * cdec + a.w;
            run[4] = run[4] * cdec + b2.x; run[5] = run[5] * cdec + b2.y; run[6] = run[6] * cdec + b2.z; run[7] = run[7] * cdec + b2.w;
        }
    }
}
DEV void ph_ret_out(const Params& p, int vb, int nvb) {
    const bf16_t* Z1 = (const bf16_t*)(p.ws + OFF_Z); const bf16_t* KVL = (const bf16_t*)(p.ws + OFF_KVLOC); bf16_t* OG = (bf16_t*)(p.ws + OFF_MIX);
    unsigned char* OG8 = p.ws + OFF_H;
    constexpr int QP = 264, VP = 144, RO_PATCH = 143104;
    bf16_t* Qs = (bf16_t*)g_lds; bf16_t* Ks = (bf16_t*)(g_lds + 67584); bf16_t* Sb = (bf16_t*)(g_lds + 67584); bf16_t* Vq = (bf16_t*)(g_lds + 67584 + 34816);
    float* sspart = (float*)(g_lds + 139264); float* rstd = (float*)(g_lds + 139264 + 2048);
    const int tid = TIDX, wave = tid >> 6, lane = tid & 63, fr = lane & 15, fq = lane >> 4, wm = wave >> 2, wn = wave & 3;
    for (int u = vb; u < 1024; u += nvb) {
        const int c = u & 63, h = (u >> 6) & 7, b = u >> 9, tok0 = b * SEQ + c * 128;
        const float lg = ret_lg(h);
        __syncthreads();
        for (int ci = tid; ci < 4096; ci += NBLK) {
            const int i = ci >> 5, d0 = (ci & 31) * 8; const float dec = expf((float)(i + 1) * lg);
            float v[8]; ld8(Z1 + (size_t)(tok0 + i) * LD1 + h * 256 + d0, v);
#pragma unroll
            for (int e = 0; e < 8; ++e) v[e] *= dec;
            st8(Qs + i * QP + d0, v);
            *(u32x4*)(Ks + i * QP + d0) = *(const u32x4*)(Z1 + (size_t)(tok0 + i) * LD1 + 2048 + h * 256 + d0);
        }
        vg8_t vpre[4];
#pragma unroll
        for (int k2 = 0; k2 < 4; ++k2) { const int ci = tid + k2 * NBLK; vpre[k2] = ld_vg8(Z1, (size_t)(tok0 + (ci >> 4)), h * 512 + (ci & 15) * 8); }
        __syncthreads();
        {
            f32x4 acc[4][2];
#pragma unroll
            for (int m = 0; m < 4; ++m)
#pragma unroll
                for (int n = 0; n < 2; ++n) acc[m][n] = (f32x4){0.f, 0.f, 0.f, 0.f};
#pragma unroll
            for (int ks = 0; ks < 8; ++ks) {
                bf16x8 af[4], bfr[2];
#pragma unroll
                for (int m = 0; m < 4; ++m) af[m] = *(const bf16x8*)(Qs + (wm * 64 + m * 16 + fr) * QP + ks * 32 + fq * 8);
#pragma unroll
                for (int n = 0; n < 2; ++n) bfr[n] = *(const bf16x8*)(Ks + (wn * 32 + n * 16 + fr) * QP + ks * 32 + fq * 8);
#pragma unroll
                for (int m = 0; m < 4; ++m)
#pragma unroll
                    for (int n = 0; n < 2; ++n) acc[m][n] = mfma16(bfr[n], af[m], acc[m][n]);
            }
            __syncthreads();
#pragma unroll
            for (int m = 0; m < 4; ++m)
#pragma unroll
                for (int n = 0; n < 2; ++n) {
                    const int i = wm * 64 + m * 16 + fr, j0 = wn * 32 + n * 16 + fq * 4;
                    float v[4];
#pragma unroll
                    for (int e = 0; e < 4; ++e) { const int j = j0 + e; v[e] = (j <= i) ? acc[m][n][e] * expf(-(float)(j + 1) * lg) : 0.f; }
                    u32x2 w; w.x = pk_bf16(v[0], v[1]); w.y = pk_bf16(v[2], v[3]);
                    *(u32x2*)(Sb + i * SSD_PITCH + j0) = w;
                }
        }
        float ssq[4] = {0.f, 0.f, 0.f, 0.f};
#pragma unroll 1
        for (int q = 0; q < 4; ++q) {
            u32x2 sf8[8][2];
#pragma unroll
            for (int ks = 0; ks < 8; ++ks)
#pragma unroll
                for (int n = 0; n < 2; ++n) sf8[ks][n] = *(const u32x2*)((const unsigned char*)KVL + ((((size_t)u * 32 + q * 8 + wn * 2 + n) * 8 + ks) * 64 + lane) * 8);
            if (q > 0) __syncthreads();
#pragma unroll
            for (int k2 = 0; k2 < 4; ++k2) { const int ci = tid + k2 * NBLK; *(u32x4*)(Vq + (ci >> 4) * VP + (ci & 15) * 8) = vg8_bf(vpre[k2]); }
            __syncthreads();
            if (q < 3) {
#pragma unroll
                for (int k2 = 0; k2 < 4; ++k2) { const int ci = tid + k2 * NBLK; vpre[k2] = ld_vg8(Z1, (size_t)(tok0 + (ci >> 4)), h * 512 + (q + 1) * 128 + (ci & 15) * 8); }
            }
            f32x4 acc[4][2];
#pragma unroll
            for (int m = 0; m < 4; ++m)
#pragma unroll
                for (int n = 0; n < 2; ++n) acc[m][n] = (f32x4){0.f, 0.f, 0.f, 0.f};
#pragma unroll
            for (int ks = 0; ks < 4; ++ks) {
                bf16x8 af[4], bfr[2];
#pragma unroll
                for (int m = 0; m < 4; ++m) af[m] = *(const bf16x8*)(Sb + (wm * 64 + m * 16 + fr) * SSD_PITCH + ks * 32 + fq * 8);
#pragma unroll
                for (int n = 0; n < 2; ++n) bfr[n] = tr_frag(Vq, VP, ks * 32, wn * 32 + n * 16, lane);
#pragma unroll
                for (int m = 0; m < 4; ++m)
#pragma unroll
                    for (int n = 0; n < 2; ++n) acc[m][n] = mfma16(bfr[n], af[m], acc[m][n]);
            }
#pragma unroll
            for (int ks = 0; ks < 8; ++ks) {
                bf16x8 af[4];
#pragma unroll
                for (int m = 0; m < 4; ++m) af[m] = *(const bf16x8*)(Qs + (wm * 64 + m * 16 + fr) * QP + ks * 32 + fq * 8);
                bf16x8 sfr[2];
#pragma unroll
                for (int n = 0; n < 2; ++n) { const f32x4 a = up4_fp8(sf8[ks][n].x) * 0.125f, b2 = up4_fp8(sf8[ks][n].y) * 0.125f;
                    u32x4 w; w.x = pk_bf16(a.x, a.y); w.y = pk_bf16(a.z, a.w); w.z = pk_bf16(b2.x, b2.y); w.w = pk_bf16(b2.z, b2.w); sfr[n] = __builtin_bit_cast(bf16x8, w); }
#pragma unroll
                for (int m = 0; m < 4; ++m)
#pragma unroll
                    for (int n = 0; n < 2; ++n) acc[m][n] = mfma16(sfr[n], af[m], acc[m][n]);
            }
#pragma unroll
            for (int m = 0; m < 4; ++m) {
                unsigned char* bb = g_lds + RO_PATCH + wave * 2560 + (m & 1) * 1280;
#pragma unroll
                for (int n = 0; n < 2; ++n) {
                    const f32x4 a = acc[m][n];
                    ssq[m] += a.x * a.x + a.y * a.y + a.z * a.z + a.w * a.w;
                    u32x2 w; w.x = pk_bf16(a.x, a.y); w.y = pk_bf16(a.z, a.w);
                    *(u32x2*)(bb + fr * 80 + n * 32 + fq * 8) = w;
                }
                const int r2 = lane >> 2, c2 = lane & 3;
                *(u32x4*)(OG + (size_t)(tok0 + wm * 64 + m * 16 + r2) * 4096 + h * 512 + q * 128 + wn * 32 + c2 * 8) = *(const u32x4*)(bb + r2 * 80 + c2 * 16);
            }
        }
#pragma unroll
        for (int m = 0; m < 4; ++m) {
            float s2 = ssq[m];
            s2 += __shfl_xor(s2, 16); s2 += __shfl_xor(s2, 32);
            if (fq == 0) sspart[(wm * 64 + m * 16 + fr) * 4 + wn] = s2;
        }
        WAIT_VM0();
        __syncthreads();
        if (tid < 128) rstd[tid] = rsqrtf((sspart[tid * 4] + sspart[tid * 4 + 1] + sspart[tid * 4 + 2] + sspart[tid * 4 + 3]) * (1.f / 512.f) + EPS);
        __syncthreads();
#pragma unroll 4
        for (int k2 = 0; k2 < 16; ++k2) {
            const int ci = tid + k2 * NBLK, i = ci >> 6, vc = h * 512 + (ci & 63) * 8; const float rs = rstd[i];
            const u32x4 ow = *(const u32x4*)(OG + (size_t)(tok0 + i) * 4096 + vc);
            const u32x4 gw = vg8_bf(ld_vg8(Z1, (size_t)(tok0 + i), 4096 + vc));
            const f32x4 g0 = *(const f32x4*)(p.ret_norm + vc), g1 = *(const f32x4*)(p.ret_norm + vc + 4);
            u32x2 o;
            o.x = pk4_fp8(bflo(ow.x) * rs * g0.x * siluf(bflo(gw.x)), bfhi(ow.x) * rs * g0.y * siluf(bfhi(gw.x)), bflo(ow.y) * rs * g0.z * siluf(bflo(gw.y)), bfhi(ow.y) * rs * g0.w * siluf(bfhi(gw.y)));
            o.y = pk4_fp8(bflo(ow.z) * rs * g1.x * siluf(bflo(gw.z)), bfhi(ow.z) * rs * g1.y * siluf(bfhi(gw.z)), bflo(ow.w) * rs * g1.z * siluf(bflo(gw.w)), bfhi(ow.w) * rs * g1.w * siluf(bfhi(gw.w)));
            *(u32x2*)(OG8 + (size_t)(tok0 + i) * 4096 + vc) = o;
        }
    }
}

__global__ void __launch_bounds__(NBLK, 2) fwd_kernel(Params p) {
    const int vb = blockIdx.x, nvb = gridDim.x;
    unsigned char* ws = p.ws;
    LAS unsigned* xbw = (LAS unsigned*)(g_lds + LDS_BYTES - 16);
    if (TIDX == 0) { xbw[0] = 0u; xbw[1] = 0u; xbw[2] = 0u; xbw[3] = 0u; }
    __syncthreads();
#if N_LAUNCH_MODE == 1
    XcdBarrier bar = xcd_barrier_post((unsigned*)(ws + OFF_CTL) + CW_BAR, (volatile LAS unsigned*)xbw);
#define GRID_BAR() xcd_barrier(bar)
#else
#define GRID_BAR() do {} while (0)
#endif
    const int lo = p.ph_lo, hi = p.ph_hi;
#ifdef ONLY_PHASE
#define IN(k) ((k) == ONLY_PHASE)
#else
#define IN(k) (lo <= (k) && (k) < hi)
#endif
#define SEAM(k) do { if (IN(k) && IN((k) + 1)) GRID_BAR(); } while (0)
    bf16_t* Hb = (bf16_t*)(ws + OFF_H);
    if (IN(0)) { ph_prep(p, vb, nvb, 0); ph_norm(p.x, p.mix_norm, Hb, vb, nvb); } SEAM(0);
    if (IN(1)) {
        const int G = (nvb == 256) ? GEMM_CUS : nvb;
        if (vb < G) ph_gemm8_dense(Hb, (const bf16_t*)(ws + OFF_WIN0), LD0, DM, g8::EpiZ0T{(bf16_t*)(ws + OFF_Z), (float*)(ws + OFF_ZS)}, vb, G);
        ph_prep(p, vb, nvb, 1);
    } SEAM(1);
    if (IN(2)) { ph_post0(p, vb, nvb); } SEAM(2);
#if REPEAT_GROUP == 13
    ph_post0(p, vb, nvb); GRID_BAR();
#endif
    if (IN(3)) { ph_dsa(p, vb, nvb); ph_ssd_states(p, vb, nvb); } SEAM(3);
#if REPEAT_GROUP == 7
    ph_ssd_states(p, vb, nvb); GRID_BAR();
#endif
    if (IN(4)) { ph_ssd_scan(p, vb, nvb); ph_dsa_attn(p, vb, nvb); } SEAM(4);
    if (IN(5)) { ph_ssd_out(p, vb, nvb); } SEAM(5);
#if REPEAT_GROUP == 6
    ph_ssd_scan(p, vb, nvb); GRID_BAR(); ph_ssd_out(p, vb, nvb); GRID_BAR();
#endif
    if (IN(6)) {
        if (FP8_OUT0) { g8::DenseSched S; S.init((const bf16_t*)(ws + OFF_H), (const bf16_t*)(ws + OFF_WOUT0), NTOK, DM, DM, nvb, vb); S.esz = 1; if (REPEAT_GROUP == 16) S.rep = 2;
            g8::EpiResidT E{p.x, p.out, 1.f};
            g8::gemm_phase<false, g8::EpiResidT, g8::DenseSched, 2, 6>(DM, S, E); }
        else ph_gemm8_dense((const bf16_t*)(ws + OFF_MIX), (const bf16_t*)(ws + OFF_WOUT0), DM, DM, g8::EpiResidT{p.x, p.out, 1.f}, vb, nvb); } SEAM(6);
    if (IN(7)) { ph_router(p, 0, p.out, vb, nvb); } SEAM(7);
    if (IN(8)) { ph_moe_gu(p, 0, vb, nvb); } SEAM(8);
    if (IN(9)) { ph_moe_down(p, 0, vb, nvb); } SEAM(9);
    if (IN(10)) { ph_combine(p, 0, p.out, p.mix_norm + DM, vb, nvb); } SEAM(10);
    if (IN(11)) {
        if (QK_FP8) { g8::DenseSched S; S.init((const bf16_t*)(ws + OFF_MIX), (const bf16_t*)(ws + OFF_WIN1), NTOK, 4096, DM, nvb, vb); S.esz = 1;
            EpiZ1 E{(bf16_t*)(ws + OFF_Z), (const float*)(ws + OFF_ROPE)}; g8::gemm_phase<false, EpiZ1, g8::DenseSched, 2, 6>(DM, S, E); }
        else { g8::DenseSched S; S.init(Hb, (const bf16_t*)(ws + OFF_WIN1), NTOK, 4096, DM, nvb, vb); if (REPEAT_GROUP == 17) S.rep = 2; g8::gemm_phase<false>(DM, S, EpiZ1{(bf16_t*)(ws + OFF_Z), (const float*)(ws + OFF_ROPE)}); } } SEAM(11);
    if (IN(12)) {
        g8::DenseSched S; S.init((const bf16_t*)(ws + OFF_MIX), (const bf16_t*)(ws + OFF_WIN1 + (size_t)4096 * 2048 * 2), NTOK, 8192, DM, nvb, vb); S.esz = 1; if (REPEAT_GROUP == 18) S.rep = 2;
#if VG_FP8
        g8::EpiF8T<LD1 * 2> E{ws + OFF_Z + 8192};
        g8::gemm_phase<false, g8::EpiF8T<LD1 * 2>, g8::DenseSched, 2, 6>(DM, S, E); } SEAM(12);
#else
        g8::EpiBfT<LD1> E{(bf16_t*)(ws + OFF_Z) + 4096};
        g8::gemm_phase<false, g8::EpiBfT<LD1>, g8::DenseSched, 2, 6>(DM, S, E); } SEAM(12);
#endif
    if (IN(13)) { ph_ret_kv(p, vb, nvb); } SEAM(13);
#if REPEAT_GROUP == 10
    ph_ret_kv(p, vb, nvb); GRID_BAR();
#endif
    if (IN(14)) { ph_ret_scan(p, vb, nvb); } SEAM(14);
    if (IN(15)) { ph_ret_out(p, vb, nvb); } SEAM(15);
#if REPEAT_GROUP == 12
    ph_ret_out(p, vb, nvb); GRID_BAR();
#endif
#if REPEAT_GROUP == 4
    ph_ret_kv(p, vb, nvb); GRID_BAR(); ph_ret_scan(p, vb, nvb); GRID_BAR(); ph_ret_out(p, vb, nvb); GRID_BAR();
#endif
    if (IN(16)) {
        g8::DenseSched S; S.init((const bf16_t*)(ws + OFF_H), (const bf16_t*)(ws + OFF_WOUT1), NTOK, DM, 4096, nvb, vb); S.esz = 1;
        g8::EpiResidT E{p.out, p.out, MX_OUT1 == 2 ? 1.f : 1.f / 64.f};
        g8::gemm_phase<false, g8::EpiResidT, g8::DenseSched, MX_OUT1, 6>(4096, S, E); } SEAM(16);
    if (IN(17)) { ph_router(p, 1, p.out, vb, nvb); } SEAM(17);
    if (IN(18)) { ph_moe_gu(p, 1, vb, nvb); } SEAM(18);
    if (IN(19)) { ph_moe_down(p, 1, vb, nvb); } SEAM(19);
#if REPEAT_GROUP == 5
    if (vb == 0 && TIDX < 64) ((unsigned*)(ws + OFF_CTL))[CW_CNT + 64 + TIDX] = 0u; GRID_BAR();
    ph_router(p, 1, p.out, vb, nvb); GRID_BAR(); ph_moe_gu(p, 1, vb, nvb); GRID_BAR(); ph_moe_down(p, 1, vb, nvb); GRID_BAR();
#endif
#if REPEAT_GROUP == 8
    ph_moe_gu(p, 1, vb, nvb); GRID_BAR();
#endif
#if REPEAT_GROUP == 9
    ph_moe_down(p, 1, vb, nvb); GRID_BAR();
#endif
    if (IN(20)) { ph_combine(p, 1, p.out, nullptr, vb, nvb); }
}


#ifdef DEBUG_NAN
__global__ void dbg_check(const void* p, size_t n, int is_f32, unsigned code, unsigned* flag) {
    size_t i = (size_t)blockIdx.x * blockDim.x + TIDX; const size_t st = (size_t)gridDim.x * blockDim.x;
    bool bad = false;
    if (is_f32) { const unsigned* u = (const unsigned*)p; for (; i < n; i += st) bad |= ((u[i] & 0x7f800000u) == 0x7f800000u); }
    else { const unsigned short* u = (const unsigned short*)p; for (; i < n; i += st) bad |= ((u[i] & 0x7f80u) == 0x7f80u); }
    if (bad) atomicMax(flag, 64u - code);
}
__global__ void dbg_fill(float* out, size_t n, const unsigned* flag) {
    const unsigned f = *flag; const unsigned sub = flag[1]; if (f == 0u && sub == 0u) return;
    const float v = sub ? (float)sub : (float)(64u - f);
    for (size_t i = (size_t)blockIdx.x * blockDim.x + TIDX; i < n; i += (size_t)gridDim.x * blockDim.x) out[i] = v;
}
#endif

extern "C" void kernel_launch(void* const* d_in, const int* in_sizes, int n_in, void* d_out, int out_size, void* d_ws, size_t ws_size, hipStream_t stream) {
    static int grid = 0;
    if (grid == 0) {
        if (n_in != 23 || ws_size < WS_TOTAL) { fprintf(stderr, "kernel_launch: need 23 inputs and %zu ws bytes (got %d, %zu)\n", (size_t)WS_TOTAL, n_in, ws_size); grid = -1; return; }
        int dev = 0, cus = 0;
        hipGetDevice(&dev); hipDeviceGetAttribute(&cus, hipDeviceAttributeMultiprocessorCount, dev);
        if (hipFuncSetAttribute((const void*)fwd_kernel, hipFuncAttributeMaxDynamicSharedMemorySize, LDS_BYTES) != hipSuccess) { fprintf(stderr, "hipFuncSetAttribute failed\n"); grid = -1; return; }
        int per_cu = 0; hipOccupancyMaxActiveBlocksPerMultiprocessor(&per_cu, (const void*)fwd_kernel, NBLK, LDS_BYTES); (void)hipGetLastError();
        grid = cus > 0 ? cus : 256;
    }
    if (grid < 0) return;
    hipMemsetAsync((char*)d_ws + OFF_CTL, 0, 65536, stream);
    Params p{};
    const float** f = (const float**)&p.x;
    (void)f;
    p.x = (const float*)d_in[0]; p.pos = (const int*)d_in[1]; p.mix_norm = (const float*)d_in[2]; p.ffn_norm = (const float*)d_in[3]; p.hyb_w_in = (const float*)d_in[4];
    p.q_norm = (const float*)d_in[5]; p.k_norm = (const float*)d_in[6]; p.kidx_norm = (const float*)d_in[7]; p.conv_w = (const float*)d_in[8]; p.conv_b = (const float*)d_in[9];
    p.dt_bias = (const float*)d_in[10]; p.a_log = (const float*)d_in[11]; p.ssm_d = (const float*)d_in[12]; p.ssm_norm = (const float*)d_in[13]; p.hyb_w_out = (const float*)d_in[14];
    p.ret_w_in = (const float*)d_in[15]; p.ret_norm = (const float*)d_in[16]; p.ret_w_out = (const float*)d_in[17]; p.w_rg = (const float*)d_in[18]; p.w_re = (const float*)d_in[19];
    p.w_gate = (const float*)d_in[20]; p.w_up = (const float*)d_in[21]; p.w_down = (const float*)d_in[22];
    p.out = (float*)d_out; p.ws = (unsigned char*)d_ws;
    constexpr int NPH = 21;
#if N_LAUNCH_MODE == 1
#ifdef PROBE_PHASE
    p.ph_lo = 0; p.ph_hi = PROBE_PHASE + 1; hipLaunchKernelGGL(fwd_kernel, dim3(grid), dim3(NBLK), LDS_BYTES, stream, p);
    hipMemsetAsync((char*)d_ws + OFF_CTL, 0, XCD_BAR_WORDS * 4, stream);
    if (PROBE_PHASE == 4) hipMemsetAsync((char*)d_ws + OFF_CTL + CW_DSAQ * 4, 0, 1024, stream);
    if (PROBE_PHASE == 7 || PROBE_PHASE == 17) hipMemsetAsync((char*)d_ws + OFF_CTL + (CW_CNT + (PROBE_PHASE == 17 ? 64 : 0)) * 4, 0, 256, stream);
    p.ph_lo = PROBE_PHASE; p.ph_hi = PROBE_PHASE + 1; hipLaunchKernelGGL(fwd_kernel, dim3(grid), dim3(NBLK), LDS_BYTES, stream, p);
    hipMemsetAsync((char*)d_ws + OFF_CTL, 0, XCD_BAR_WORDS * 4, stream);
    p.ph_lo = PROBE_PHASE + 1; p.ph_hi = NPH; hipLaunchKernelGGL(fwd_kernel, dim3(grid), dim3(NBLK), LDS_BYTES, stream, p);
#else
    p.ph_lo = 0; p.ph_hi = NPH;
    hipLaunchKernelGGL(fwd_kernel, dim3(grid), dim3(NBLK), LDS_BYTES, stream, p);
#endif
#else
    for (int k = 0; k < NPH; ++k) { p.ph_lo = k; p.ph_hi = k + 1; hipLaunchKernelGGL(fwd_kernel, dim3(grid), dim3(NBLK), LDS_BYTES, stream, p);
#ifdef DEBUG_NAN
        unsigned* flag = (unsigned*)((char*)d_ws + OFF_CTL) + 8000; char* w = (char*)d_ws;
#define CHK(ptr, n, f32) hipLaunchKernelGGL(dbg_check, dim3(1024), dim3(256), 0, stream, (const void*)(ptr), (size_t)(n), (int)(f32), (unsigned)(k + 1), flag)
        switch (k) {
        case 0: CHK(w + OFF_H, (size_t)NTOK * 2048, 0); CHK(w + OFF_WIN0, (OFF_WRT - OFF_WIN0) / 2, 0); CHK(w + OFF_WRT, 2 * 72 * 2048, 1); break;
        case 1: CHK(w + OFF_Z, (size_t)NTOK * LD0, 0); CHK(w + OFF_ZS, (size_t)NTOK * 256, 1); break;
        case 2: CHK(w + OFF_QA, (OFF_WIS - OFF_QA) / 2, 0); CHK(w + OFF_WIS, (OFF_XC - OFF_WIS) / 4, 1); CHK(w + OFF_XC, (size_t)NTOK * 1536, 0); break;
        case 3: CHK(w + OFF_MIX, (size_t)NTOK * 2048, 0); CHK(w + OFF_ST, (size_t)2 * 64 * 16 * 8192, 1); CHK(w + OFF_CD, 2048, 1); break;
        case 4: CHK(w + OFF_PREV, (size_t)2 * 64 * 16 * 8192, 0); break;
        case 5: CHK(w + OFF_MIX, (size_t)NTOK * 2048, 0); break;
        case 6: case 10: case 16: case 20: CHK(d_out, (size_t)NTOK * 2048, 1); break;
        case 7: case 17: CHK(w + OFF_H, (size_t)NTOK * 2048, 0); CHK(w + OFF_GATE, 65536, 1); break;
        case 8: case 18: CHK(w + OFF_HID, (size_t)49152 * 512, 0); break;
        case 9: case 19: CHK(w + OFF_Y, (size_t)32768 * 2048, 0); break;
        case 11: case 12: CHK(w + OFF_Z, (size_t)NTOK * LD1, 0); break;
        case 13: case 14: CHK(w + OFF_KVLOC, (size_t)1024 * 131072, 0); break;
        case 15: CHK(w + OFF_MIX, (size_t)NTOK * 4096, 0); break;
        }
        if (k == NPH - 1) hipLaunchKernelGGL(dbg_fill, dim3(1024), dim3(256), 0, stream, (float*)d_out, (size_t)NTOK * 2048, (const unsigned*)flag);
#endif
    }
#endif
}
```

```cpp
#include <hip/hip_runtime.h>
#include <stdint.h>
#include <stdio.h>

#ifndef MX_OUT1
#define MX_OUT1 2
#endif
#ifndef FP8_OUT0
#define FP8_OUT0 0
#endif
#ifndef VG_FP8
#define VG_FP8 0
#endif
#ifndef QK_FP8
#define QK_FP8 1
#endif
#ifndef MX_GU
#define MX_GU 2
#endif
#ifndef MX_DOWN
#define MX_DOWN 2
#endif
#ifndef REPEAT_GROUP
#define REPEAT_GROUP 0
#endif
#ifndef N_LAUNCH_MODE
#define N_LAUNCH_MODE 1
#endif

typedef unsigned short bf16_t;
typedef short bf16x8 __attribute__((ext_vector_type(8)));
typedef float f32x4 __attribute__((ext_vector_type(4)));
typedef float f32x2 __attribute__((ext_vector_type(2)));
typedef unsigned u32x2 __attribute__((ext_vector_type(2)));
typedef unsigned u32x4 __attribute__((ext_vector_type(4)));
#define DEV __device__ __forceinline__
#define LAS __attribute__((address_space(3)))
__device__ __forceinline__ int tid_opaque() { int t = threadIdx.x; asm volatile("" : "+v"(t)); return t; }
#define TIDX tid_opaque()

constexpr int NTOK = 16384, SEQ = 8192, DM = 2048, NBLK = 512  ;
constexpr int LD0 = 4864;
constexpr int LD1 = 12288;
constexpr float EPS = 1e-6f;
constexpr int LDS_BYTES = 160 * 1024;

constexpr size_t OFF_CTL   = 0;
constexpr size_t OFF_WIN0  = 65536;
constexpr size_t OFF_WOUT0 = OFF_WIN0  + (size_t)4864 * 2048 * 2;
constexpr size_t OFF_WIN1  = OFF_WOUT0 + (size_t)2048 * 2048 * 2;
constexpr size_t OFF_WOUT1 = OFF_WIN1  + (size_t)12288 * 2048 * 2;
constexpr size_t OFF_WGU   = OFF_WOUT1 + (size_t)2048 * 4096 * 2;
constexpr size_t OFF_WD    = OFF_WGU   + (size_t)2 * 64 * 1024 * 2048 * 2;
constexpr size_t OFF_WRT   = OFF_WD    + (size_t)2 * 64 * 2048 * 512 * 2;
constexpr size_t OFF_H     = OFF_WRT   + (size_t)2 * 1024 * 1024;
constexpr size_t OFF_Z     = OFF_H     + (size_t)NTOK * 2048 * 2;
constexpr size_t OFF_HID   = OFF_Z;
constexpr size_t OFF_Y     = OFF_Z + (size_t)64 * 1024 * 1024;
constexpr size_t OFF_MIX   = OFF_Z     + (size_t)NTOK * 12288 * 2;
constexpr size_t OFF_L0    = OFF_MIX   + (size_t)NTOK * 4096 * 2;
constexpr size_t OFF_ZS    = OFF_L0;
constexpr size_t OFF_QA    = OFF_ZS    + (size_t)NTOK * 256 * 4;
constexpr size_t OFF_KV    = OFF_QA    + (size_t)NTOK * 1024 * 2;
constexpr size_t OFF_QIA   = OFF_KV    + (size_t)NTOK * 512 * 2;
constexpr size_t OFF_KIA   = OFF_QIA   + (size_t)NTOK * 512 * 2;
constexpr size_t OFF_WIS   = OFF_KIA   + (size_t)NTOK * 64 * 2;
constexpr size_t OFF_DT    = OFF_WIS   + (size_t)NTOK * 8 * 4;
constexpr size_t OFF_XC    = OFF_DT    + (size_t)NTOK * 16 * 4;
constexpr size_t OFF_ST    = OFF_XC    + (size_t)NTOK * 1536 * 2;
constexpr size_t OFF_PREV  = OFF_ST    + (size_t)2 * 64 * 16 * 64 * 128 * 4;
constexpr size_t OFF_CD    = OFF_PREV  + (size_t)2 * 64 * 16 * 64 * 128 * 2;
constexpr size_t OFF_SELG  = OFF_CD    + 65536;
constexpr size_t L0_END    = OFF_SELG  + (size_t)NTOK * 256 * 2;
constexpr size_t OFF_KVLOC = OFF_L0;
constexpr size_t KVLOC_END = OFF_KVLOC + (size_t)1024 * 512 * 256 * 2;
constexpr size_t OFF_MOE   = (L0_END > KVLOC_END ? L0_END : KVLOC_END);
constexpr size_t OFF_LIST  = OFF_MOE;
constexpr size_t OFF_GATE  = OFF_LIST  + (size_t)2 * 64 * 16384 * 4;
constexpr size_t OFF_RSTD  = OFF_GATE  + (size_t)2 * 32768 * 4;
constexpr size_t OFF_ROPE  = OFF_RSTD  + (size_t)NTOK * 4;
constexpr size_t OFF_TSLOT = OFF_ROPE  + (size_t)NTOK * 256 * 4;
constexpr size_t WS_TOTAL  = OFF_TSLOT + (size_t)32768 * 4;
constexpr int CW_BAR = 0;
constexpr int CW_CNT = 4096;
constexpr int CW_PREPQ = 4224;
constexpr int CW_DSAQ = 4352;

struct Params {
    const float* x; const int* pos; const float* mix_norm; const float* ffn_norm; const float* hyb_w_in; const float* q_norm; const float* k_norm;
    const float* kidx_norm; const float* conv_w; const float* conv_b; const float* dt_bias; const float* a_log; const float* ssm_d; const float* ssm_norm;
    const float* hyb_w_out; const float* ret_w_in; const float* ret_norm; const float* ret_w_out; const float* w_rg; const float* w_re;
    const float* w_gate; const float* w_up; const float* w_down;
    float* out; unsigned char* ws; int ph_lo, ph_hi;
};

DEV float bf2f(bf16_t v) { return __uint_as_float(((unsigned)v) << 16); }
typedef __bf16 bf16x2_t __attribute__((ext_vector_type(2)));
DEV unsigned pk_bf16(float lo, float hi) { f32x2 v = {lo, hi}; bf16x2_t r = __builtin_convertvector(v, bf16x2_t); return __builtin_bit_cast(unsigned, r); }
DEV bf16_t f2bf(float v) { return (bf16_t)(pk_bf16(v, 0.f) & 0xffffu); }
DEV unsigned pk4_fp8(float a, float b, float c, float d) { int r = 0; r = __builtin_amdgcn_cvt_pk_fp8_f32(a, b, r, false); r = __builtin_amdgcn_cvt_pk_fp8_f32(c, d, r, true); return (unsigned)r; }
typedef int i32x8 __attribute__((ext_vector_type(8)));
DEV bf16x8 fp8x8_to_bf16(u32x2 w);
DEV f32x4 up4_fp8(unsigned w) { const f32x2 lo = __builtin_amdgcn_cvt_pk_f32_fp8((int)w, false), hi = __builtin_amdgcn_cvt_pk_f32_fp8((int)w, true); return (f32x4){lo.x, lo.y, hi.x, hi.y}; }
DEV bf16x8 fp8x8_to_bf16(u32x2 w) { const f32x4 a = up4_fp8(w.x), b = up4_fp8(w.y); u32x4 r; r.x = pk_bf16(a.x, a.y); r.y = pk_bf16(a.z, a.w); r.z = pk_bf16(b.x, b.y); r.w = pk_bf16(b.z, b.w); return __builtin_bit_cast(bf16x8, r); }
DEV float bflo(unsigned w) { return __uint_as_float(w << 16); }
DEV float bfhi(unsigned w) { return __uint_as_float(w & 0xffff0000u); }
DEV float wave_sum(float v) { v += __shfl_xor(v, 32); v += __shfl_xor(v, 16); v += __shfl_xor(v, 8); v += __shfl_xor(v, 4); v += __shfl_xor(v, 2); v += __shfl_xor(v, 1); return v; }
DEV float wave_max(float v) { v = fmaxf(v, __shfl_xor(v, 32)); v = fmaxf(v, __shfl_xor(v, 16)); v = fmaxf(v, __shfl_xor(v, 8)); v = fmaxf(v, __shfl_xor(v, 4)); v = fmaxf(v, __shfl_xor(v, 2)); v = fmaxf(v, __shfl_xor(v, 1)); return v; }
DEV float siluf(float v) { return v * __builtin_amdgcn_rcpf(1.f + __expf(-v)); }
DEV f32x4 mfma16(bf16x8 a, bf16x8 b, f32x4 c) { return __builtin_amdgcn_mfma_f32_16x16x32_bf16(a, b, c, 0, 0, 0); }
#define WAIT_VM0() asm volatile("s_waitcnt vmcnt(0)" ::: "memory")

extern __shared__ __attribute__((aligned(16))) unsigned char g_lds[];

#define XB_TMO      128
#define XB_XCNT(j)  (256  + 64 * (j))
#define XB_XSUB(j)  (1280 + 64 * (j))
#define XB_XGEN(j)  (2304 + 64 * (j))
#define XB_TOP      3328
#define XB_TOPGEN   3392
#define XCD_BAR_WORDS 3456
#define XB_SPIN_CAP (1u << 18)
__device__ __forceinline__ unsigned xb_ld(unsigned* p)              { return __hip_atomic_load(p, __ATOMIC_RELAXED, __HIP_MEMORY_SCOPE_AGENT); }
__device__ __forceinline__ unsigned xb_add(unsigned* p, unsigned v) { return __hip_atomic_fetch_add(p, v, __ATOMIC_RELAXED, __HIP_MEMORY_SCOPE_AGENT); }
__device__ __forceinline__ unsigned xb_xcc_id() { return (unsigned)__builtin_amdgcn_s_getreg((3 << 11) | 20) & 0xFu; }
#define XB_SPIN(cond, bar) do { unsigned _sp = 0; while (cond) { __builtin_amdgcn_s_sleep(1); \
    if ((++_sp & 255u) == 0u) { if (xb_ld(&(bar)[XB_TMO])) break; if (_sp > XB_SPIN_CAP) { atomicAdd(&(bar)[XB_TMO], 1u); break; } } } } while (0)
struct XcdBarrier { unsigned* bar; unsigned x; volatile LAS unsigned* st; };
__device__ __forceinline__ XcdBarrier xcd_barrier_post(unsigned* bar, volatile LAS unsigned* st) {
    XcdBarrier b; b.bar = bar; b.x = xb_xcc_id(); b.st = st;
    if (TIDX == 0) (void)xb_add(&bar[XB_XCNT(b.x)], 1u);
    return b;
}
__device__ __forceinline__ void xcd_barrier_complete(unsigned* bar, unsigned x, unsigned& nloc, unsigned& nx) {
    const unsigned G = gridDim.x * gridDim.y * gridDim.z;
    unsigned sum, cnt, mine, sp = 0u;
    for (;;) {
        sum = 0u; cnt = 0u; mine = 0u;
#pragma unroll
        for (unsigned j = 0; j < 16; ++j) { const unsigned c = xb_ld(&bar[XB_XCNT(j)]); sum += c; cnt += (c > 0u) ? 1u : 0u; mine = (j == x) ? c : mine; }
        if (sum == G) break;
        __builtin_amdgcn_s_sleep(1);
        if ((++sp & 255u) == 0u) { if (xb_ld(&bar[XB_TMO])) break; if (sp > XB_SPIN_CAP) { atomicAdd(&bar[XB_TMO], 1u); break; } }
    }
    nloc = mine > 0u ? mine : 1u; nx = cnt > 0u ? cnt : 1u;
}
__device__ __forceinline__ void xcd_barrier(const XcdBarrier& b) {
    asm volatile("s_waitcnt vmcnt(0)" ::: "memory");
    __syncthreads();
    if (TIDX == 0) {
        unsigned* bar = b.bar;
        __builtin_amdgcn_s_waitcnt(0);
        unsigned nloc = b.st[0], nx = b.st[1];
        if (nloc == 0u) { xcd_barrier_complete(bar, b.x, nloc, nx); b.st[0] = nloc; b.st[1] = nx; }
        const unsigned old = xb_add(&bar[XB_XSUB(b.x)], 1u);
        const unsigned gen = old / nloc;
        if (old + 1u == (gen + 1u) * nloc) {
            __builtin_amdgcn_fence(__ATOMIC_RELEASE, "agent");
            asm volatile("s_waitcnt vmcnt(0)" ::: "memory");
            const unsigned og = xb_add(&bar[XB_TOP], 1u);
            const unsigned tg = og / nx;
            if (og + 1u == (tg + 1u) * nx) xb_add(&bar[XB_TOPGEN], 1u);
            else XB_SPIN(xb_ld(&bar[XB_TOPGEN]) == tg, bar);
            __builtin_amdgcn_fence(__ATOMIC_ACQUIRE, "agent");
            xb_add(&bar[XB_XGEN(b.x)], 1u);
            asm volatile("s_waitcnt vmcnt(0)" ::: "memory");
        } else {
            XB_SPIN(xb_ld(&bar[XB_XGEN(b.x)]) == gen, bar);
            __builtin_amdgcn_fence(__ATOMIC_ACQUIRE, "agent");
            asm volatile("s_waitcnt vmcnt(0)" ::: "memory");
        }
    }
    __syncthreads();
}

DEV void st8(bf16_t* p, const float (&v)[8]);
struct ConvJob { const float* src; int ldsrc; bf16_t* dst; int K; float f8scale; };
template <class ColPtr>
DEV ConvJob conv_job(ColPtr cp, int ldsrc, bf16_t* dst, int K, int n0, int k0) {
    const int tid = TIDX, wid = tid >> 6, lane = tid & 63, r = tid >> 2, kq = tid & 3;
    const float* c = cp(n0 + 4 * lane);
    ConvJob j; j.src = c ? c + (size_t)(k0 + wid * 8) * ldsrc : nullptr; j.ldsrc = ldsrc; j.dst = dst + (size_t)(n0 + r) * K + k0 + kq * 16; j.K = K; j.f8scale = 0.f; return j;
}
template <class ColPtr>
DEV ConvJob conv_job8(ColPtr cp, int ldsrc, unsigned char* dst8, int K, int n0, int k0, float scale) {
    ConvJob j = conv_job(cp, ldsrc, (bf16_t*)nullptr, K, n0, k0);
    const int tid = TIDX, r = tid >> 2, kq = tid & 3;
    j.dst = (bf16_t*)(dst8 + (size_t)(n0 + r) * K + k0 + kq * 16); j.f8scale = scale; return j;
}
DEV void conv_load(const ConvJob& j, f32x4 (&v)[8]) {
#pragma unroll
    for (int i = 0; i < 8; ++i) v[i] = j.src ? *(const f32x4*)(j.src + (size_t)i * j.ldsrc) : (f32x4){0.f, 0.f, 0.f, 0.f};
}
DEV void conv_finish(const ConvJob& j, const f32x4 (&v)[8]) {
    unsigned char* tile = g_lds;
    const int tid = TIDX, wid = tid >> 6, lane = tid & 63, kq = tid & 3;
    if (j.f8scale != 0.f) {
        const float sc = j.f8scale;
#pragma unroll
        for (int c = 0; c < 4; ++c) {
            u32x2 w; w.x = pk4_fp8(v[0][c] * sc, v[1][c] * sc, v[2][c] * sc, v[3][c] * sc); w.y = pk4_fp8(v[4][c] * sc, v[5][c] * sc, v[6][c] * sc, v[7][c] * sc);
            *(u32x2*)(tile + (4 * lane + c) * 64 + ((wid ^ (lane & 7)) * 8)) = w;
        }
        __syncthreads();
#pragma unroll
        for (int ps = 0; ps < 2; ++ps) {
            const int r = (tid >> 2) + ps * 128, sw = (r >> 2) & 7;
            const u32x2 a = *(const u32x2*)(tile + r * 64 + (((2 * kq) ^ sw) * 8)), b = *(const u32x2*)(tile + r * 64 + (((2 * kq + 1) ^ sw) * 8));
            u32x4 w8; w8.x = a.x; w8.y = a.y; w8.z = b.x; w8.w = b.y;
            *(u32x4*)((unsigned char*)j.dst + (size_t)(ps * 128) * j.K) = w8;
        }
    } else {
#pragma unroll
        for (int c = 0; c < 4; ++c) {
            u32x4 w; w.x = pk_bf16(v[0][c], v[1][c]); w.y = pk_bf16(v[2][c], v[3][c]); w.z = pk_bf16(v[4][c], v[5][c]); w.w = pk_bf16(v[6][c], v[7][c]);
            *(u32x4*)(tile + (4 * lane + c) * 128 + ((wid ^ (lane & 7)) * 16)) = w;
        }
        __syncthreads();
#pragma unroll
        for (int ps = 0; ps < 2; ++ps) {
            const int r = (tid >> 2) + ps * 128, sw = (r >> 2) & 7;
            const u32x4 w0 = *(const u32x4*)(tile + r * 128 + (((2 * kq) ^ sw) * 16)), w1 = *(const u32x4*)(tile + r * 128 + (((2 * kq + 1) ^ sw) * 16));
            bf16_t* d = j.dst + (size_t)(ps * 128) * j.K;
            *(u32x4*)d = w0; *(u32x4*)(d + 8) = w1;
        }
    }
    __syncthreads();
}
struct CpPlain { const float* base; int ncols; DEV const float* operator()(int n) const { return n < ncols ? base + n : nullptr; } };
struct CpWin0 { const float* base; DEV const float* operator()(int n) const {
    int c;
    if (n < 2048) c = n; else if (n < 3072) c = 2120 + (n - 2048); else if (n < 4608) c = 3144 + (n - 3072);
    else if (n < 4672) c = 2048 + (n - 4608); else if (n < 4680) c = 2112 + (n - 4672); else if (n < 4696) c = n; else return nullptr;
    return base + c; } };
struct CpGU { const float* g; const float* u; DEV const float* operator()(int n) const {
    const int t = n >> 8, r = n & 255; return (r < 128) ? g + t * 128 + r : u + t * 128 + (r - 128); } };

constexpr int PREP_J0 = 19 * 32;
constexpr int GEMM_CUS = 152;
DEV void ph_prep(const Params& p, int vb, int nvb, int part) {
    unsigned char* ws = p.ws;
    if (part == 0 && vb == 0 && TIDX < 128) ((unsigned*)(ws + OFF_CTL))[CW_CNT + TIDX] = 0u;
    if (part == 1) {
        bf16_t* wrb = (bf16_t*)(ws + OFF_WRT);
        for (int i = vb * NBLK + TIDX; i < 2 * 64 * 5 * 64; i += nvb * NBLK) {
            const int l = i / 20480, rem = i % 20480, ks = rem / 320, nt = (rem / 64) % 5, ln = rem & 63;
            const int k0 = ks * 32 + (ln >> 4) * 8, n = nt * 16 + (ln & 15);
            float hi[8], lo[8];
#pragma unroll
            for (int e = 0; e < 8; ++e) {
                const int k = k0 + e; float w = 0.f;
                if (n < 8) w = p.w_rg[((size_t)l * 2048 + k) * 8 + n]; else if (n < 72) w = p.w_re[((size_t)l * 2048 + k) * 64 + (n - 8)];
                w *= p.ffn_norm[l * 2048 + k];
                const float h = bf2f(f2bf(w)); hi[e] = h; lo[e] = w - h;
            }
            bf16_t* d = wrb + (size_t)l * 327680 + ((size_t)(ks * 2) * 5 + nt) * 512 + ln * 8;
            st8(d, hi); st8(d + 5 * 512, lo);
        }
    }
    if (part == 1) {
        float* tbl = (float*)(ws + OFF_ROPE);
        for (int i = vb * NBLK + TIDX; i < NTOK * 128; i += nvb * NBLK) {
            const int tok = i >> 7, fi = i & 127;
            float sn, cs; sincosf((float)p.pos[tok] * exp2f(-(float)fi * (1.f / 128.f) * 13.287712379549449f), &sn, &cs);
            tbl[(size_t)tok * 256 + fi] = cs; tbl[(size_t)tok * 256 + 128 + fi] = sn;
        }
    }
    constexpr int J0 = 19 * 32, J1 = 8 * 32, J2 = 48 * 32, J3 = 8 * 64, J4 = 128 * 128, J5 = 128 * 64;
    constexpr int JT = J0 + J1 + J2 + J3 + J4 + J5;
    auto decode = [&](int job) -> ConvJob {
        int j = job;
        if (j < J0) return conv_job(CpWin0{p.hyb_w_in}, 4696, (bf16_t*)(ws + OFF_WIN0), 2048, (j / 32) * 256, (j % 32) * 64);
        j -= J0;
        if (j < J1) { if (FP8_OUT0) return conv_job8(CpPlain{p.hyb_w_out, 2048}, 2048, ws + OFF_WOUT0, 2048, (j / 32) * 256, (j % 32) * 64, 64.f);
                      return conv_job(CpPlain{p.hyb_w_out, 2048}, 2048, (bf16_t*)(ws + OFF_WOUT0), 2048, (j / 32) * 256, (j % 32) * 64); }
        j -= J1;
        if (j < J2) { const int ntile = j / 32;
            if (ntile < 16) { if (QK_FP8) return conv_job8(CpPlain{p.ret_w_in, 12288}, 12288, ws + OFF_WIN1, 2048, ntile * 256, (j % 32) * 64, 64.f);
                              return conv_job(CpPlain{p.ret_w_in, 12288}, 12288, (bf16_t*)(ws + OFF_WIN1), 2048, ntile * 256, (j % 32) * 64); }
            return conv_job8(CpPlain{p.ret_w_in + 4096, 8192}, 12288, ws + OFF_WIN1 + (size_t)4096 * 2048 * 2, 2048, (ntile - 16) * 256, (j % 32) * 64, 64.f); }
        j -= J2;
        if (j < J3) return conv_job8(CpPlain{p.ret_w_out, 2048}, 2048, ws + OFF_WOUT1, 4096, (j / 64) * 256, (j % 64) * 64, 64.f);
        j -= J3;
        if (j < J4) { const int le = j / 128, t = j % 128;
            return conv_job8(CpGU{p.w_gate + (size_t)le * 2048 * 512, p.w_up + (size_t)le * 2048 * 512}, 512, ws + OFF_WGU + (size_t)le * 1024 * 2048, 2048, (t / 32) * 256, (t % 32) * 64, 32.f); }
        j -= J4;
        { const int le = j / 64, t = j % 64;
            return conv_job8(CpPlain{p.w_down + (size_t)le * 512 * 2048, 2048}, 2048, ws + OFF_WD + (size_t)le * 2048 * 512, 512, (t / 8) * 256, (t % 8) * 64, 16.f); }
    };
    static_assert(J0 == PREP_J0, "part split");
    const int jlo = part == 0 ? 0 : J0, jhi = part == 0 ? J0 : JT;
    if (part == 0) {
        if (jlo + vb < jhi) {
            ConvJob cj = decode(jlo + vb), c1 = cj, c2 = cj; f32x4 va[8], v1[8], v2[8]; conv_load(cj, va);
            if (jlo + vb + nvb < jhi) { c1 = decode(jlo + vb + nvb); conv_load(c1, v1); }
            for (int job = jlo + vb; job < jhi; job += nvb) {
                const int nj2 = job + 2 * nvb;
                if (nj2 < jhi) { c2 = decode(nj2); conv_load(c2, v2); }
                conv_finish(cj, va);
                cj = c1; c1 = c2;
#pragma unroll
                for (int i = 0; i < 8; ++i) { va[i] = v1[i]; v1[i] = v2[i]; }
            }
        }
    } else {
        unsigned* qhead = (unsigned*)(ws + OFF_CTL) + CW_PREPQ; volatile int* ring = (volatile int*)(g_lds + 40 * 1024);
        __syncthreads();
        if (TIDX == 0) { ring[0] = jlo + (int)atomicAdd(qhead, 1u); ring[1] = jlo + (int)atomicAdd(qhead, 1u); ring[2] = jlo + (int)atomicAdd(qhead, 1u); }
        __syncthreads();
        int job = ring[0], j1 = ring[1];
        if (job < jhi) {
            ConvJob cj = decode(job), c1 = cj, c2 = cj; f32x4 va[8], v1[8], v2[8]; conv_load(cj, va);
            if (j1 < jhi) { c1 = decode(j1); conv_load(c1, v1); }
            for (int it = 0; job < jhi; ++it) {
                if (TIDX == 0) ring[(it + 3) & 3] = jlo + (int)atomicAdd(qhead, 1u);
                const int j2 = ring[(it + 2) & 3];
                if (j2 < jhi) { c2 = decode(j2); conv_load(c2, v2); }
                conv_finish(cj, va);
                cj = c1; c1 = c2; job = j1; j1 = j2;
#pragma unroll
                for (int i = 0; i < 8; ++i) { va[i] = v1[i]; v1[i] = v2[i]; }
            }
        }
    }
}

DEV void ph_norm(const float* x, const float* g, bf16_t* H, int vb, int nvb) {
    const int wave = TIDX >> 6, lane = TIDX & 63;
    for (int row = vb * 8 + wave; row < NTOK; row += nvb * 8) {
        const f32x4* xr = (const f32x4*)(x + (size_t)row * DM);
        f32x4 v[8]; float ss = 0.f;
#pragma unroll
        for (int i = 0; i < 8; ++i) { v[i] = xr[i * 64 + lane]; ss += v[i].x * v[i].x + v[i].y * v[i].y + v[i].z * v[i].z + v[i].w * v[i].w; }
        ss = wave_sum(ss);
        const float r = rsqrtf(ss * (1.f / DM) + EPS);
#pragma unroll
        for (int i = 0; i < 8; ++i) {
            const f32x4 g4 = ((const f32x4*)g)[i * 64 + lane];
            u32x2 w; w.x = pk_bf16(v[i].x * r * g4.x, v[i].y * r * g4.y); w.y = pk_bf16(v[i].z * r * g4.z, v[i].w * r * g4.w);
            *(u32x2*)(H + (size_t)row * DM + (i * 64 + lane) * 4) = w;
        }
    }
}

constexpr int GEMM_ROWOFF = 48 * 1024;
template <int BM, int BN>
DEV void gemm_core(const bf16_t* __restrict__ A, const bf16_t* __restrict__ Bt, int ldb, int bcol, int K, f32x4 (&acc)[BM / 32][BN / 64]) {
    constexpr int TM = BM / 32, TN = BN / 64;
    unsigned char* SA = g_lds; unsigned char* SB = g_lds + BM * 64;
    const unsigned* rowoff = (const unsigned*)(g_lds + GEMM_ROWOFF);
    const int tid = TIDX, wid = tid >> 6, lane = tid & 63, wr = wid >> 2, wc = wid & 3, fr = lane & 15, fq = lane >> 4;
#pragma unroll
    for (int m = 0; m < TM; ++m)
#pragma unroll
        for (int n = 0; n < TN; ++n) acc[m][n] = (f32x4){0.f, 0.f, 0.f, 0.f};
    for (int kt = 0; kt < K / 32; ++kt) {
#pragma unroll
        for (int i = 0; i < BM * 4 / NBLK; ++i) { const int c = tid + i * NBLK, r = c >> 2, q = c & 3;
            __builtin_amdgcn_global_load_lds((const unsigned*)(A + rowoff[r] + kt * 32 + q * 8), (LAS unsigned*)(SA + c * 16), 16, 0, 0); }
#pragma unroll
        for (int i = 0; i < BN * 4 / NBLK; ++i) { const int c = tid + i * NBLK, r = c >> 2, q = c & 3;
            __builtin_amdgcn_global_load_lds((const unsigned*)(Bt + (size_t)(bcol + r) * ldb + kt * 32 + q * 8), (LAS unsigned*)(SB + c * 16), 16, 0, 0); }
        WAIT_VM0(); __syncthreads();
        bf16x8 af[TM], bfr[TN];
#pragma unroll
        for (int m = 0; m < TM; ++m) af[m] = *(const bf16x8*)(SA + (wr * (BM / 2) + m * 16 + fr) * 64 + fq * 16);
#pragma unroll
        for (int n = 0; n < TN; ++n) bfr[n] = *(const bf16x8*)(SB + (wc * (BN / 4) + n * 16 + fr) * 64 + fq * 16);
#pragma unroll
        for (int m = 0; m < TM; ++m)
#pragma unroll
            for (int n = 0; n < TN; ++n) acc[m][n] = mfma16(bfr[n], af[m], acc[m][n]);
        __syncthreads();
    }
}

template <class Epi>
DEV void ph_gemm_dense(const bf16_t* A, int lda, const bf16_t* Bt, int N, int K, Epi epi, int vb, int nvb) {
    const int nN = N / 256, nM = NTOK / 256, ntile = nM * nN;
    unsigned* rowoff = (unsigned*)(g_lds + GEMM_ROWOFF);
    const int tid = TIDX, wid = tid >> 6, lane = tid & 63, wr = wid >> 2, wc = wid & 3, fr = lane & 15, fq = lane >> 4;
    for (int t = vb; t < ntile; t += nvb) {
        const int pm = t % nM, pn = t / nM;
        __syncthreads();
        if (tid < 256) rowoff[tid] = (unsigned)((size_t)(pm * 256 + tid) * lda);
        __syncthreads();
        f32x4 acc[8][4];
        gemm_core<256, 256>(A, Bt, K, pn * 256, K, acc);
#pragma unroll
        for (int m = 0; m < 8; ++m)
#pragma unroll
            for (int n = 0; n < 4; ++n) epi(pm * 256 + wr * 128 + m * 16 + fr, pn * 256 + wc * 64 + n * 16 + fq * 4, acc[m][n]);
    }
}

struct EpiZ0 { bf16_t* Z; float* ZS; DEV void operator()(int row, int col, f32x4 v) const {
    u32x2 w; w.x = pk_bf16(v.x, v.y); w.y = pk_bf16(v.z, v.w);
    *(u32x2*)(Z + (size_t)row * LD0 + col) = w;
    if (col >= 4608) *(f32x4*)(ZS + (size_t)row * 256 + (col - 4608)) = v; } };
struct EpiBf { bf16_t* Z; int ld; DEV void operator()(int row, int col, f32x4 v) const {
    u32x2 w; w.x = pk_bf16(v.x, v.y); w.y = pk_bf16(v.z, v.w);
    *(u32x2*)(Z + (size_t)row * ld + col) = w; } };
struct EpiResid { const float* xin; float* xout; float scale; DEV void operator()(int row, int col, f32x4 v) const {
    const f32x4 r = *(const f32x4*)(xin + (size_t)row * DM + col);
    *(f32x4*)(xout + (size_t)row * DM + col) = r + v * scale; } };

namespace g8 {
typedef int i32x4_t __attribute__((ext_vector_type(4)));
constexpr int BK = 64, HALF = 128, HTB = HALF * BK * 2, STAGE_BYTES = 8 * HTB;
constexpr int GOFF_LDS = 156 * 1024;
DEV int lds_byte(int r, int c) { const int st = (r >> 4) * 2 + (c >> 5), rr = r & 15, cc = c & 31, ob = rr * 64 + cc * 2; return st * 1024 + (ob ^ (((ob >> 9) & 1) << 5)); }
DEV void stage_rc(int b, int& R, int& C) { const int st = b / 1024, sb = b % 1024, swz = sb ^ (((sb >> 9) & 1) << 5); R = (st >> 1) * 16 + swz / 64; C = (st & 1) * 32 + (swz % 64) / 2; }

template <bool GATHER, class Epi, class Sched, int FP8 = 0, int WSHIFT = 0>
DEV void gemm_phase(int K, const Sched& S, const Epi& E) {
    LAS unsigned char* lds = (LAS unsigned char*)g_lds;
    typedef typename Sched::Unit Unit;
    const int tid = TIDX, wid = __builtin_amdgcn_readfirstlane(tid >> 6), lane = tid & 63, wr = wid >> 2, wc = wid & 3, fr = lane & 15, fq = lane >> 4;
    const int rowB = FP8 ? K : 2 * K, nt = rowB / 128;
    int Rr[2], Cc[2]; unsigned voffB[2];
#pragma unroll
    for (int i = 0; i < 2; ++i) { stage_rc(tid * 16 + i * 8192, Rr[i], Cc[i]); voffB[i] = (unsigned)(Rr[i] * rowB + Cc[i] * 2); }
    const size_t kstep = (size_t)(BK * 2), hstep = (size_t)HALF * rowB, r64 = (size_t)64 * rowB;
    const unsigned ldsw = (unsigned)wid * 1024u;
    const int aoff = lds_byte(wr * 64 + fr, fq * 8), boff = lds_byte(wc * 32 + fr, fq * 8);
#define G8_SA(b, h) (((b) * 2 + (h)) * HTB)
#define G8_SB(b, h) ((4 + (b) * 2 + (h)) * HTB)
#define G8_STAGE(bufoff, gbase, voff) do { _Pragma("unroll") for (int _i = 0; _i < 2; ++_i) \
        __builtin_amdgcn_global_load_lds((const unsigned*)((const char*)(gbase) + (size_t)_i * r64 + (voff)[0]), (LAS unsigned*)(lds + (bufoff) + ldsw + _i * 8192), 16, 0, 0); } while (0)
#define G8_STAGE_A(bufoff, dptr, goffs, kb) do { if (GATHER) { _Pragma("unroll") for (int _i = 0; _i < 2; ++_i) \
        __builtin_amdgcn_global_load_lds((const unsigned*)((S.Abase() + (size_t)(kb)) + (RO[(goffs) + rr0 + 64 * _i] + cc0)), (LAS unsigned*)(lds + (bufoff) + ldsw + _i * 8192), 16, 0, 0); } \
        else G8_STAGE(bufoff, dptr, voffB); } while (0)
#define G8_LD2(dst, addr) do { const i32x4_t _lo = *(const LAS i32x4_t*)(addr), _hi = *(const LAS i32x4_t*)((addr) + 1024); dst = __builtin_shufflevector(_lo, _hi, 0, 1, 2, 3, 4, 5, 6, 7); } while (0)
#define G8_LDA(dst, b, h) do { _Pragma("unroll") for (int m = 0; m < 4; ++m) G8_LD2(dst[m], lds + G8_SA(b, h) + aoff + m * 2048); } while (0)
#define G8_LDB(dst, b, h) do { _Pragma("unroll") for (int n = 0; n < 2; ++n) G8_LD2(dst[n], lds + G8_SB(b, h) + boff + n * 2048); } while (0)
typedef int i32x2_t __attribute__((ext_vector_type(2)));
#define G8_Q0(x) __builtin_bit_cast(long, __builtin_shufflevector((x), (x), 0, 1))
#define G8_Q1(x) __builtin_bit_cast(long, __builtin_shufflevector((x), (x), 2, 3))
#define G8_Q2(x) __builtin_bit_cast(long, __builtin_shufflevector((x), (x), 4, 5))
#define G8_Q3(x) __builtin_bit_cast(long, __builtin_shufflevector((x), (x), 6, 7))
#define G8_LO(x) __builtin_bit_cast(bf16x8, __builtin_shufflevector((x), (x), 0, 1, 2, 3))
#define G8_HI(x) __builtin_bit_cast(bf16x8, __builtin_shufflevector((x), (x), 4, 5, 6, 7))
#define G8_MMA(ai, bj, At, Bt) do { __builtin_amdgcn_s_setprio(1); _Pragma("unroll") for (int m = 0; m < 4; ++m) _Pragma("unroll") for (int n = 0; n < 2; ++n) { \
        if (FP8 == 2) acc[ai][bj][m][n] = __builtin_amdgcn_mfma_scale_f32_16x16x128_f8f6f4(Bt[n], At[m], acc[ai][bj][m][n], 0, 0, 0, 0x01010101 * (127 - WSHIFT / 2), 0, 0x01010101 * (127 - WSHIFT / 2)); \
        else if (FP8) { acc[ai][bj][m][n] = __builtin_amdgcn_mfma_f32_16x16x32_fp8_fp8(G8_Q0(Bt[n]), G8_Q0(At[m]), acc[ai][bj][m][n], 0, 0, 0); \
                   acc[ai][bj][m][n] = __builtin_amdgcn_mfma_f32_16x16x32_fp8_fp8(G8_Q1(Bt[n]), G8_Q1(At[m]), acc[ai][bj][m][n], 0, 0, 0); \
                   acc[ai][bj][m][n] = __builtin_amdgcn_mfma_f32_16x16x32_fp8_fp8(G8_Q2(Bt[n]), G8_Q2(At[m]), acc[ai][bj][m][n], 0, 0, 0); \
                   acc[ai][bj][m][n] = __builtin_amdgcn_mfma_f32_16x16x32_fp8_fp8(G8_Q3(Bt[n]), G8_Q3(At[m]), acc[ai][bj][m][n], 0, 0, 0); } \
        else { acc[ai][bj][m][n] = __builtin_amdgcn_mfma_f32_16x16x32_bf16(G8_LO(Bt[n]), G8_LO(At[m]), acc[ai][bj][m][n], 0, 0, 0); \
               acc[ai][bj][m][n] = __builtin_amdgcn_mfma_f32_16x16x32_bf16(G8_HI(Bt[n]), G8_HI(At[m]), acc[ai][bj][m][n], 0, 0, 0); } } \
        __builtin_amdgcn_s_setprio(0); } while (0)
#define G8_WAIT_V(n) asm volatile("s_waitcnt vmcnt(" #n ")" ::: "memory")
#define G8_WAIT_L(n) asm volatile("s_waitcnt lgkmcnt(" #n ")" ::: "memory")
#define G8_BAR __builtin_amdgcn_s_barrier()
#define G8_SCHED __builtin_amdgcn_sched_barrier(0)
    Unit cur, nxt; int ui = 0;
    if (!S.next(0, cur)) return;
    f32x4 acc[2][2][4][2];
#pragma unroll
    for (int a = 0; a < 2; ++a)
#pragma unroll
        for (int b = 0; b < 2; ++b)
#pragma unroll
            for (int m = 0; m < 4; ++m)
#pragma unroll
                for (int n = 0; n < 2; ++n) acc[a][b][m][n] = (f32x4){0.f, 0.f, 0.f, 0.f};
    i32x8 At[4], B0[2], B1[2];
    const char* cA = GATHER ? nullptr : S.A0(cur); const char* cB = S.B0(cur);
    const unsigned* RO = (const unsigned*)(g_lds + GOFF_LDS);
    const int rr0 = Rr[0], cc0 = Cc[0] * 2;
    if (GATHER) { if (tid < 256) ((unsigned*)(g_lds + GOFF_LDS))[tid] = S.rowoff(cur, tid); __syncthreads(); }
    int gcur = 0;
    G8_STAGE(G8_SB(0, 0), cB, voffB); G8_STAGE_A(G8_SA(0, 0), cA, gcur, 0); G8_STAGE(G8_SB(0, 1), cB + hstep, voffB); G8_STAGE_A(G8_SA(0, 1), cA + hstep, gcur + 128, 0);
    if (wr == 1) G8_BAR;
    G8_WAIT_V(4); G8_BAR;
    G8_STAGE(G8_SB(1, 0), cB + kstep, voffB); G8_STAGE_A(G8_SA(1, 0), cA + kstep, gcur, kstep); G8_STAGE(G8_SB(1, 1), cB + hstep + kstep, voffB);
    G8_WAIT_V(6); G8_BAR;
    for (;;) {
        const bool has_next = S.next(ui + 1, nxt);
        const char* nA = (GATHER || !has_next) ? cA : S.A0(nxt); const char* nB = has_next ? S.B0(nxt) : cB;
        const int gnxt = has_next ? (gcur ^ 256) : gcur;
        if (GATHER && has_next && wid < 4) {
            int ln; asm volatile("v_mbcnt_lo_u32_b32 %0, -1, 0\n\tv_mbcnt_hi_u32_b32 %0, -1, %0" : "=v"(ln));
            const int t2 = wid * 64 + ln; ((unsigned*)(g_lds + GOFF_LDS))[gnxt + t2] = S.rowoff(nxt, t2); }
        for (int t = 0; t < nt; t += 2) {
            const bool last = (t == nt - 2);
            const char* a1 = cA + (size_t)(t + 1) * kstep;
            const char* a2 = last ? nA : cA + (size_t)(t + 2) * kstep; const char* b2 = last ? nB : cB + (size_t)(t + 2) * kstep;
            const char* a3 = a2 + kstep; const char* b3 = b2 + kstep;
            const size_t k1 = (size_t)(t + 1) * kstep, k2 = last ? 0 : (size_t)(t + 2) * kstep, k3 = k2 + kstep;
            const int g2 = last ? gnxt : gcur;
            G8_LDB(B0, 0, 0); G8_SCHED; G8_LDA(At, 0, 0); G8_STAGE_A(G8_SA(1, 1), a1 + hstep, gcur + 128, k1);
            G8_WAIT_L(8); G8_BAR; G8_WAIT_L(0); G8_MMA(0, 0, At, B0); G8_BAR; G8_SCHED;
            G8_LDB(B1, 0, 1); G8_STAGE(G8_SB(0, 0), b2, voffB);
            G8_BAR; G8_WAIT_L(0); G8_MMA(0, 1, At, B1); G8_BAR;
            G8_LDA(At, 0, 1); G8_STAGE_A(G8_SA(0, 0), a2, g2, k2);
            G8_BAR; G8_WAIT_L(0); G8_MMA(1, 0, At, B0); G8_BAR; G8_SCHED;
            G8_STAGE(G8_SB(0, 1), b2 + hstep, voffB);
            G8_WAIT_V(6); G8_BAR; G8_MMA(1, 1, At, B1); G8_BAR;
            G8_LDB(B0, 1, 0); G8_SCHED; G8_LDA(At, 1, 0); G8_STAGE_A(G8_SA(0, 1), a2 + hstep, g2 + 128, k2);
            G8_WAIT_L(8); G8_BAR; G8_WAIT_L(0); G8_MMA(0, 0, At, B0); G8_BAR; G8_SCHED;
            G8_LDB(B1, 1, 1); G8_STAGE(G8_SB(1, 0), b3, voffB);
            G8_BAR; G8_WAIT_L(0); G8_MMA(0, 1, At, B1); G8_BAR;
            G8_LDA(At, 1, 1); G8_STAGE_A(G8_SA(1, 0), a3, g2, k3);
            G8_BAR; G8_WAIT_L(0); G8_MMA(1, 0, At, B0); G8_BAR; G8_SCHED;
            G8_STAGE(G8_SB(1, 1), b3 + hstep, voffB);
            G8_WAIT_V(6); G8_BAR; G8_MMA(1, 1, At, B1); G8_BAR;
        }
        {
            int tz = TIDX; asm volatile("" : "+v"(tz));
            const int ewid = tz >> 6, elane = tz & 63;
            E(acc, cur, ewid >> 2, ewid & 3, elane & 15, elane >> 4);
        }
        if (!has_next) break;
#pragma unroll
        for (int a = 0; a < 2; ++a)
#pragma unroll
            for (int b = 0; b < 2; ++b)
#pragma unroll
                for (int m = 0; m < 4; ++m)
#pragma unroll
                    for (int n = 0; n < 2; ++n) acc[a][b][m][n] = (f32x4){0.f, 0.f, 0.f, 0.f};
        cur = nxt; cA = nA; cB = nB; ++ui; gcur = gnxt;
    }
    G8_WAIT_V(0);
    if (wr == 0) G8_BAR;
    G8_BAR;
#undef G8_SA
#undef G8_SB
#undef G8_STAGE
#undef G8_STAGE_A
#undef G8_LDA
#undef G8_LDB
#undef G8_MMA
#undef G8_LD2
#undef G8_LO
#undef G8_HI
#undef G8_WAIT_V
#undef G8_WAIT_L
#undef G8_BAR
#undef G8_SCHED
}

struct DenseSched {
    struct Unit { int pm, pn; };
    const bf16_t* A; const bf16_t* Bt; int K, nM, nN, nwg, G, c, rep, esz;
    DEV void init(const bf16_t* A_, const bf16_t* Bt_, int M, int N, int K_, int G_, int c_) { A = A_; Bt = Bt_; K = K_; nM = M / 256; nN = N / 256; nwg = nM * nN; G = G_; c = c_; rep = 1; esz = 2; }
    DEV bool next(int i, Unit& u) const {
        const int rounds = (nwg + G - 1) / G; if (i >= rounds * rep) return false;
        const long L = (long)(i % rounds) * G + c; if (L >= nwg) return false;
        int wgid = (int)L; { const int q = nwg / 8, r = nwg % 8, xcd = wgid % 8, off = wgid / 8; wgid = (xcd < r ? xcd * (q + 1) : r * (q + 1) + (xcd - r) * q) + off; }
        const int nig = 8 * nN, gid = wgid / nig, fm = gid * 8, gsz = (nM - fm) < 8 ? (nM - fm) : 8;
        u.pm = fm + ((wgid % nig) % gsz); u.pn = (wgid % nig) / gsz; return true;
    }
    DEV const char* A0(const Unit& u) const { return (const char*)A + (size_t)u.pm * 256 * K * esz; }
    DEV const char* B0(const Unit& u) const { return (const char*)Bt + (size_t)u.pn * 256 * K * esz; }
    DEV const char* Abase() const { return (const char*)A; }
    DEV bool half1(const Unit&) const { return true; }
    DEV unsigned rowoff(const Unit&, int) const { return 0u; }
};
template <class F> struct EpiEach { F f;
    DEV void operator()(const f32x4 (&acc)[2][2][4][2], const DenseSched::Unit& u, int wr, int wc, int fr, int fq) const {
#pragma unroll
        for (int ai = 0; ai < 2; ++ai)
#pragma unroll
            for (int m = 0; m < 4; ++m) {
#pragma unroll
                for (int bj = 0; bj < 2; ++bj)
#pragma unroll
                    for (int n = 0; n < 2; ++n) f(u.pm * 256 + ai * 128 + wr * 64 + m * 16 + fr, u.pn * 256 + bj * 128 + wc * 32 + n * 16 + fq * 4, acc[ai][bj][m][n]);
                __builtin_amdgcn_sched_barrier(0);
            }
    } };
constexpr int EPI_LDS = 136 * 1024, EPI_WAVE = 2560, EPI_PATCH = 1280;
template <int LD> struct EpiBfT { bf16_t* Z;
    DEV void operator()(const f32x4 (&acc)[2][2][4][2], const DenseSched::Unit& u, int wr, int wc, int fr, int fq) const {
        unsigned char* buf = g_lds + EPI_LDS + (wr * 4 + wc) * EPI_WAVE;
        const int lane = fq * 16 + fr, r2 = lane >> 2, c2 = lane & 3;
        const unsigned off0 = ((unsigned)(u.pm * 256 + wr * 64 + r2) * (unsigned)LD + (unsigned)(u.pn * 256 + wc * 32 + c2 * 8)) * 2u;
#pragma unroll
        for (int ai = 0; ai < 2; ++ai)
#pragma unroll
            for (int m = 0; m < 4; ++m)
#pragma unroll
                for (int bj = 0; bj < 2; ++bj) {
                    unsigned char* bb = buf + bj * EPI_PATCH;
#pragma unroll
                    for (int n = 0; n < 2; ++n) { const f32x4 v = acc[ai][bj][m][n]; u32x2 w; w.x = pk_bf16(v.x, v.y); w.y = pk_bf16(v.z, v.w); *(u32x2*)(bb + fr * 80 + n * 32 + fq * 8) = w; }
                    const u32x4 o = *(const u32x4*)(bb + r2 * 80 + c2 * 16);
                    *(u32x4*)((unsigned char*)Z + (off0 + (unsigned)(((ai * 128 + m * 16) * LD + bj * 128) * 2))) = o;
                    if (bj == 1) __builtin_amdgcn_sched_barrier(0);
                }
    } };
template <int ROWB> struct EpiF8T { unsigned char* Z;
    DEV void operator()(const f32x4 (&acc)[2][2][4][2], const DenseSched::Unit& u, int wr, int wc, int fr, int fq) const {
        unsigned char* buf = g_lds + EPI_LDS + (wr * 4 + wc) * EPI_WAVE;
        const int lane = fq * 16 + fr, r2 = lane >> 2, c2 = lane & 3;
        const unsigned off0 = (unsigned)(u.pm * 256 + wr * 64 + r2) * (unsigned)ROWB + (unsigned)(u.pn * 256 + wc * 32 + c2 * 8);
#pragma unroll
        for (int ai = 0; ai < 2; ++ai)
#pragma unroll
            for (int m = 0; m < 4; ++m)
#pragma unroll
                for (int bj = 0; bj < 2; ++bj) {
                    unsigned char* bb = buf + bj * EPI_PATCH;
#pragma unroll
                    for (int n = 0; n < 2; ++n) { const f32x4 v = acc[ai][bj][m][n]; u32x2 w; w.x = pk_bf16(v.x, v.y); w.y = pk_bf16(v.z, v.w); *(u32x2*)(bb + fr * 80 + n * 32 + fq * 8) = w; }
                    const u32x4 o = *(const u32x4*)(bb + r2 * 80 + c2 * 16);
                    u32x2 o8; o8.x = pk4_fp8(bflo(o.x), bfhi(o.x), bflo(o.y), bfhi(o.y)); o8.y = pk4_fp8(bflo(o.z), bfhi(o.z), bflo(o.w), bfhi(o.w));
                    *(u32x2*)(Z + (off0 + (unsigned)((ai * 128 + m * 16) * ROWB + bj * 128))) = o8;
                    if (bj == 1) __builtin_amdgcn_sched_barrier(0);
                }
    } };
struct EpiZ0T { bf16_t* Z; float* ZS;
    DEV void operator()(const f32x4 (&acc)[2][2][4][2], const DenseSched::Unit& u, int wr, int wc, int fr, int fq) const {
        EpiBfT<LD0>{Z}(acc, u, wr, wc, fr, fq);
        if (u.pn == 18) {
#pragma unroll
            for (int ai = 0; ai < 2; ++ai)
#pragma unroll
                for (int m = 0; m < 4; ++m)
#pragma unroll
                    for (int bj = 0; bj < 2; ++bj)
#pragma unroll
                        for (int n = 0; n < 2; ++n) *(f32x4*)(ZS + (size_t)(u.pm * 256 + ai * 128 + wr * 64 + m * 16 + fr) * 256 + bj * 128 + wc * 32 + n * 16 + fq * 4) = acc[ai][bj][m][n];
        }
    } };
struct EpiResidT { const float* xin; float* xout; float scale;
    DEV void operator()(const f32x4 (&acc)[2][2][4][2], const DenseSched::Unit& u, int wr, int wc, int fr, int fq) const {
        unsigned char* buf = g_lds + EPI_LDS + (wr * 4 + wc) * EPI_WAVE;
        const int lane = fq * 16 + fr, r2 = lane >> 2, c2 = lane & 3;
        const unsigned off0 = ((unsigned)(u.pm * 256 + wr * 64 + r2) * (unsigned)DM + (unsigned)(u.pn * 256 + wc * 32 + c2 * 4)) * 4u;
#pragma unroll
        for (int ai = 0; ai < 2; ++ai)
#pragma unroll
            for (int m = 0; m < 4; ++m) {
#pragma unroll
                for (int bj = 0; bj < 2; ++bj)
#pragma unroll
                    for (int n = 0; n < 2; ++n) {
                        unsigned char* bb = buf + n * EPI_PATCH;
                        *(f32x4*)(bb + fr * 80 + fq * 16) = acc[ai][bj][m][n];
                        const f32x4 v = *(const f32x4*)(bb + r2 * 80 + c2 * 16);
                        const unsigned o = off0 + (unsigned)(((ai * 128 + m * 16) * DM + bj * 128 + n * 16) * 4);
                        const f32x4 r = *(const f32x4*)((const unsigned char*)xin + o);
                        *(f32x4*)((unsigned char*)xout + o) = r + v * scale;
                    }
                __builtin_amdgcn_sched_barrier(0);
            }
    } };
}

struct EpiZ1 { bf16_t* Z; const float* tbl;
    DEV void operator()(const f32x4 (&acc)[2][2][4][2], const g8::DenseSched::Unit& u, int wr, int wc, int fr, int fq) const {
        const float sc = (u.pn >= 8) ? 0.0625f : 1.f;
        unsigned char* buf = g_lds + g8::EPI_LDS + (wr * 4 + wc) * g8::EPI_WAVE;
        const int lane = fq * 16 + fr, r2 = lane >> 2, c2 = lane & 3;
#pragma unroll
        for (int ai = 0; ai < 2; ++ai)
#pragma unroll
            for (int m = 0; m < 4; ++m) {
                const int row = u.pm * 256 + ai * 128 + wr * 64 + m * 16 + r2;
#pragma unroll
                for (int n = 0; n < 2; ++n) {
                    *(f32x4*)(buf + fr * 80 + fq * 16) = acc[ai][0][m][n]; *(f32x4*)(buf + g8::EPI_PATCH + fr * 80 + fq * 16) = acc[ai][1][m][n];
                    const f32x4 a = *(const f32x4*)(buf + r2 * 80 + c2 * 16), b = *(const f32x4*)(buf + g8::EPI_PATCH + r2 * 80 + c2 * 16);
                    const int i0 = wc * 32 + n * 16 + c2 * 4;
                    const f32x4 c = *(const f32x4*)(tbl + (size_t)row * 256 + i0), sn = *(const f32x4*)(tbl + (size_t)row * 256 + 128 + i0);
                    const f32x4 o1 = (a * c - b * sn) * sc, o2 = (b * c + a * sn) * sc;
                    u32x2 w; w.x = pk_bf16(o1.x, o1.y); w.y = pk_bf16(o1.z, o1.w);
                    *(u32x2*)(Z + (size_t)row * LD1 + u.pn * 256 + i0) = w;
                    w.x = pk_bf16(o2.x, o2.y); w.y = pk_bf16(o2.z, o2.w);
                    *(u32x2*)(Z + (size_t)row * LD1 + u.pn * 256 + 128 + i0) = w;
                }
                __builtin_amdgcn_sched_barrier(0);
            }
    } };
struct EpiZ1vg { bf16_t* Z; DEV void operator()(int row, int col, f32x4 v) const {
    u32x2 w; w.x = pk_bf16(v.x * 0.03125f, v.y * 0.03125f); w.y = pk_bf16(v.z * 0.03125f, v.w * 0.03125f);
    *(u32x2*)(Z + (size_t)row * LD1 + 4096 + col) = w; } };
template <class E>
DEV void ph_gemm8_dense(const bf16_t* A, const bf16_t* Bt, int N, int K, E e, int vb, int nvb) {
    g8::DenseSched S; S.init(A, Bt, NTOK, N, K, nvb, vb);
    if ((REPEAT_GROUP == 15 && N == LD0) || (REPEAT_GROUP == 16 && N == DM && K == DM)) S.rep = 2;
    g8::gemm_phase<false>(K, S, e);
}

DEV void ld16(const bf16_t* p, float (&v)[16]) {
    const u32x4 a = *(const u32x4*)p, b = *(const u32x4*)(p + 8);
    v[0] = bflo(a.x); v[1] = bfhi(a.x); v[2] = bflo(a.y); v[3] = bfhi(a.y); v[4] = bflo(a.z); v[5] = bfhi(a.z); v[6] = bflo(a.w); v[7] = bfhi(a.w);
    v[8] = bflo(b.x); v[9] = bfhi(b.x); v[10] = bflo(b.y); v[11] = bfhi(b.y); v[12] = bflo(b.z); v[13] = bfhi(b.z); v[14] = bflo(b.w); v[15] = bfhi(b.w);
}
DEV void ld8(const bf16_t* p, float (&v)[8]) {
    const u32x4 a = *(const u32x4*)p;
    v[0] = bflo(a.x); v[1] = bfhi(a.x); v[2] = bflo(a.y); v[3] = bfhi(a.y); v[4] = bflo(a.z); v[5] = bfhi(a.z); v[6] = bflo(a.w); v[7] = bfhi(a.w);
}
DEV void st16(bf16_t* p, const float (&v)[16]) {
    u32x4 a, b;
    a.x = pk_bf16(v[0], v[1]); a.y = pk_bf16(v[2], v[3]); a.z = pk_bf16(v[4], v[5]); a.w = pk_bf16(v[6], v[7]);
    b.x = pk_bf16(v[8], v[9]); b.y = pk_bf16(v[10], v[11]); b.z = pk_bf16(v[12], v[13]); b.w = pk_bf16(v[14], v[15]);
    *(u32x4*)p = a; *(u32x4*)(p + 8) = b;
}
DEV void st8(bf16_t* p, const float (&v)[8]) {
    u32x4 a; a.x = pk_bf16(v[0], v[1]); a.y = pk_bf16(v[2], v[3]); a.z = pk_bf16(v[4], v[5]); a.w = pk_bf16(v[6], v[7]);
    *(u32x4*)p = a;
}

DEV void up16(const u32x4 a, const u32x4 b, float (&v)[16]) {
    v[0] = bflo(a.x); v[1] = bfhi(a.x); v[2] = bflo(a.y); v[3] = bfhi(a.y); v[4] = bflo(a.z); v[5] = bfhi(a.z); v[6] = bflo(a.w); v[7] = bfhi(a.w);
    v[8] = bflo(b.x); v[9] = bfhi(b.x); v[10] = bflo(b.y); v[11] = bfhi(b.y); v[12] = bflo(b.z); v[13] = bfhi(b.z); v[14] = bflo(b.w); v[15] = bfhi(b.w);
}
DEV void up8(const u32x4 a, float (&v)[8]) {
    v[0] = bflo(a.x); v[1] = bfhi(a.x); v[2] = bflo(a.y); v[3] = bfhi(a.y); v[4] = bflo(a.z); v[5] = bfhi(a.z); v[6] = bflo(a.w); v[7] = bfhi(a.w);
}
DEV void ph_post0(const Params& p, int vb, int nvb) {
    unsigned char* ws = p.ws;
    const bf16_t* Z0 = (const bf16_t*)(ws + OFF_Z); const float* ZS = (const float*)(ws + OFF_ZS);
    bf16_t* QA = (bf16_t*)(ws + OFF_QA); bf16_t* KV = (bf16_t*)(ws + OFF_KV); bf16_t* QIA = (bf16_t*)(ws + OFF_QIA); bf16_t* KIA = (bf16_t*)(ws + OFF_KIA);
    float* WIS = (float*)(ws + OFF_WIS); float* DT = (float*)(ws + OFF_DT); bf16_t* XC = (bf16_t*)(ws + OFF_XC);
    const int wave = TIDX >> 6, lane = TIDX & 63, l8 = lane & 7;
    const float LOG2TH = 18.931568569324174f;
    float inv = 0.f;
    if (lane < 16) inv = exp2f(-(float)lane * (1.f / 16.f) * LOG2TH); else if (lane < 24) inv = exp2f(-(float)(lane - 16) * (1.f / 8.f) * LOG2TH);
    for (int tok = vb * 8 + wave; tok < NTOK; tok += nvb * 8) {
        const bf16_t* z = Z0 + (size_t)tok * LD0;
        const int la0 = lane & 15, s_tok = tok & (SEQ - 1);
        const u32x4 rq0 = *(const u32x4*)(z + 16 * lane), rq1 = *(const u32x4*)(z + 16 * lane + 8);
        const u32x4 rk0 = *(const u32x4*)(z + 1024 + 16 * la0), rk1 = *(const u32x4*)(z + 1024 + 16 * la0 + 8);
        const u32x4 rv0 = *(const u32x4*)(z + 1280 + 16 * la0), rv1 = *(const u32x4*)(z + 1280 + 16 * la0 + 8);
        const u32x4 rqi = *(const u32x4*)(z + 1536 + 8 * lane);
        const float zki = ZS[(size_t)tok * 256 + lane], zwi = ZS[(size_t)tok * 256 + 64 + (lane & 7)], zdt = ZS[(size_t)tok * 256 + 72 + (lane & 15)];
        u32x4 rc[3][4];
#pragma unroll
        for (int i = 0; i < 3; ++i)
#pragma unroll
            for (int k = 0; k < 4; ++k) { const int dk = (s_tok - 3 + k >= 0) ? (k - 3) : 0; rc[i][k] = *(const u32x4*)(z + (ptrdiff_t)dk * LD0 + 3072 + (i * 64 + lane) * 8); }
        const float posf = (float)p.pos[tok];
        float sn, cs; sincosf(posf * inv, &sn, &cs);
        float cq[16], sq[16];
#pragma unroll
        for (int i = 0; i < 16; ++i) { cq[i] = __shfl(cs, i); sq[i] = __shfl(sn, i); }
        {
            float v[16]; up16(rq0, rq1, v);
            float ss = 0.f;
#pragma unroll
            for (int i = 0; i < 16; ++i) ss += v[i] * v[i];
            ss += __shfl_xor(ss, 1); ss += __shfl_xor(ss, 2); ss += __shfl_xor(ss, 4);
            const float r = rsqrtf(ss * (1.f / 128.f) + EPS);
            const float* g = p.q_norm + l8 * 16;
#pragma unroll
            for (int i = 0; i < 16; ++i) v[i] = v[i] * r * g[i];
#pragma unroll
            for (int i = 0; i < 16; ++i) { const float o = __shfl_xor(v[i], 1);
                if (l8 == 0) v[i] = v[i] * cq[i] - o * sq[i]; else if (l8 == 1) v[i] = v[i] * cq[i] + o * sq[i]; }
            st16(QA + (size_t)tok * 1024 + 16 * lane, v);
        }
        {
            const int la = lane & 15;
            float v[16]; up16(rk0, rk1, v);
            float ss = 0.f;
#pragma unroll
            for (int i = 0; i < 16; ++i) ss += v[i] * v[i];
            ss += __shfl_xor(ss, 1); ss += __shfl_xor(ss, 2); ss += __shfl_xor(ss, 4);
            const float r = rsqrtf(ss * (1.f / 128.f) + EPS);
            const float* g = p.k_norm + l8 * 16;
#pragma unroll
            for (int i = 0; i < 16; ++i) v[i] = v[i] * r * g[i];
#pragma unroll
            for (int i = 0; i < 16; ++i) { const float o = __shfl_xor(v[i], 1);
                if (l8 == 0) v[i] = v[i] * cq[i] - o * sq[i]; else if (l8 == 1) v[i] = v[i] * cq[i] + o * sq[i]; }
            unsigned char* KV8 = (unsigned char*)KV;
            if (lane < 16) { u32x4 w; w.x = pk4_fp8(v[0], v[1], v[2], v[3]); w.y = pk4_fp8(v[4], v[5], v[6], v[7]); w.z = pk4_fp8(v[8], v[9], v[10], v[11]); w.w = pk4_fp8(v[12], v[13], v[14], v[15]);
                *(u32x4*)(KV8 + (size_t)tok * 512 + (la >> 3) * 256 + l8 * 16) = w; }
            if (lane >= 16 && lane < 32) {
                float vv[16]; up16(rv0, rv1, vv);
                u32x4 w; w.x = pk4_fp8(vv[0], vv[1], vv[2], vv[3]); w.y = pk4_fp8(vv[4], vv[5], vv[6], vv[7]); w.z = pk4_fp8(vv[8], vv[9], vv[10], vv[11]); w.w = pk4_fp8(vv[12], vv[13], vv[14], vv[15]);
                *(u32x4*)(KV8 + (size_t)tok * 512 + (la >> 3) * 256 + 128 + l8 * 16) = w;
            }
        }
        {
            float ci[8], si[8];
#pragma unroll
            for (int i = 0; i < 8; ++i) { ci[i] = __shfl(cs, 16 + i); si[i] = __shfl(sn, 16 + i); }
            float v[8]; up8(rqi, v);
#pragma unroll
            for (int i = 0; i < 8; ++i) { const float o = __shfl_xor(v[i], 1);
                if (l8 == 0) v[i] = v[i] * ci[i] - o * si[i]; else if (l8 == 1) v[i] = v[i] * ci[i] + o * si[i]; }
            st8(QIA + (size_t)tok * 512 + 8 * lane, v);
            float kv = zki;
            const float ss = wave_sum(kv * kv);
            kv = kv * rsqrtf(ss * (1.f / 64.f) + EPS) * p.kidx_norm[lane];
            const float o = __shfl_xor(kv, 8);
            const float c1 = __shfl(cs, 16 + (lane & 7)), s1 = __shfl(sn, 16 + (lane & 7));
            if (lane < 8) kv = kv * c1 - o * s1; else if (lane < 16) kv = kv * c1 + o * s1;
            KIA[(size_t)(tok >> 4) * 1024 + (lane >> 5) * 512 + (((lane >> 3) & 3) * 16 + (tok & 15)) * 8 + (lane & 7)] = f2bf(kv);
        }
        if (lane < 8) WIS[(size_t)tok * 8 + lane] = zwi * 0.044194173824159216f;
        if (lane < 16) { const float v = zdt + p.dt_bias[lane]; DT[(size_t)tok * 16 + lane] = v > 20.f ? v : log1pf(expf(v)); }
        {
            const int s = tok & (SEQ - 1);
#pragma unroll
            for (int i = 0; i < 3; ++i) {
                const int c0 = (i * 64 + lane) * 8;
                float acc[8];
                { const f32x4 b0 = *(const f32x4*)(p.conv_b + c0), b1 = *(const f32x4*)(p.conv_b + c0 + 4);
                  acc[0] = b0.x; acc[1] = b0.y; acc[2] = b0.z; acc[3] = b0.w; acc[4] = b1.x; acc[5] = b1.y; acc[6] = b1.z; acc[7] = b1.w; }
#pragma unroll
                for (int k = 0; k < 4; ++k) {
                    if (s - 3 + k >= 0) {
                        float xv[8]; up8(rc[i][k], xv);
                        const f32x4 w0 = *(const f32x4*)(p.conv_w + k * 1536 + c0), w1 = *(const f32x4*)(p.conv_w + k * 1536 + c0 + 4);
                        acc[0] += xv[0] * w0.x; acc[1] += xv[1] * w0.y; acc[2] += xv[2] * w0.z; acc[3] += xv[3] * w0.w;
                        acc[4] += xv[4] * w1.x; acc[5] += xv[5] * w1.y; acc[6] += xv[6] * w1.z; acc[7] += xv[7] * w1.w;
                    }
                }
#pragma unroll
                for (int e = 0; e < 8; ++e) acc[e] = siluf(acc[e]);
                st8(XC + (size_t)tok * 1536 + c0, acc);
            }
        }
    }
}

constexpr int DSA_SC = 0, DSA_HIST = 131072, DSA_SEL = 147456, DSA_MISC = 149504, DSA_PART = 149504 + 128, DSA_CAND = 150016;
DEV unsigned fkey(float f) { const unsigned u = __float_as_uint(f); return (u & 0x80000000u) ? ~u : (u | 0x80000000u); }

DEV void ph_dsa(const Params& p, int vb, int nvb) {
    unsigned char* ws = p.ws;
    const bf16_t* QA = (const bf16_t*)(ws + OFF_QA); const bf16_t* KV = (const bf16_t*)(ws + OFF_KV); const bf16_t* QIA = (const bf16_t*)(ws + OFF_QIA);
    const bf16_t* KIA = (const bf16_t*)(ws + OFF_KIA); const float* WIS = (const float*)(ws + OFF_WIS); bf16_t* MIX = (bf16_t*)(ws + OFF_MIX);
    unsigned* SC = (unsigned*)(g_lds + DSA_SC); unsigned* HIST = (unsigned*)(g_lds + DSA_HIST); unsigned short* SEL = (unsigned short*)(g_lds + DSA_SEL);
    unsigned* MISC = (unsigned*)(g_lds + DSA_MISC); unsigned* PART = (unsigned*)(g_lds + DSA_PART);
    const int tid = TIDX, wave = tid >> 6, lane = tid & 63, fr = lane & 15, fq = lane >> 4;
    bf16x8 an[2][2]; f32x4 wn[2]; int pref_k = -1;
#define DSA_QLOAD(kk) do { const int tk_ = ((kk) & 1) * SEQ + (2047 - ((kk) >> 1)) * 4; _Pragma("unroll") for (int mt = 0; mt < 2; ++mt) { \
        const bf16_t* qp = QIA + (size_t)(tk_ + (fr >> 2)) * 512 + ((fr & 3) + 4 * mt) * 64 + fq * 8; an[mt][0] = *(const bf16x8*)qp; an[mt][1] = *(const bf16x8*)(qp + 32); \
        wn[mt] = *(const f32x4*)(WIS + (size_t)(tk_ + fq) * 8 + mt * 4); } pref_k = (kk); } while (0)
#define DSA_UNIT(i2) (((((REPEAT_GROUP == 2) ? ((i2) >> 1) : (i2)) & 1) ? ((REPEAT_GROUP == 2) ? ((i2) >> 1) : (i2)) * nvb + (nvb - 1 - vb) : ((REPEAT_GROUP == 2) ? ((i2) >> 1) : (i2)) * nvb + vb))
    for (int it2 = 0; it2 * nvb < 4096 * (REPEAT_GROUP == 2 ? 2 : 1); ++it2) {
        const int k = DSA_UNIT(it2);
        if (k >= 4096) continue;
        const int b = k & 1, s0 = (2047 - (k >> 1)) * 4, tok0 = b * SEQ + s0;
        const int ntile = (s0 + 3) / 16 + 1, npad = ntile * 16;
        const bool sel = (s0 >= 256);
        if (pref_k != k) DSA_QLOAD(k);
        __syncthreads();
        if (sel) for (int i = tid; i < 4096; i += NBLK) HIST[i] = 0u;
        __syncthreads();
        {
            bf16x8 a[2][2]; f32x4 wv[2];
#pragma unroll
            for (int mt = 0; mt < 2; ++mt) { a[mt][0] = an[mt][0]; a[mt][1] = an[mt][1]; wv[mt] = wn[mt]; }
            const bf16_t* kbase = KIA + (size_t)(b * (SEQ / 16)) * 1024 + lane * 8;
            bf16x8 kb[2][4][2];
#define DSA_KLOAD(buf, t0) do { _Pragma("unroll") for (int u = 0; u < 4; ++u) { const bf16_t* kp = kbase + (size_t)min((t0) + 8 * u, ntile - 1) * 1024; \
                kb[buf][u][0] = *(const bf16x8*)kp; kb[buf][u][1] = *(const bf16x8*)(kp + 512); } } while (0)
            for (int srep = 0; srep < (REPEAT_GROUP == 21 ? 2 : 1); ++srep) {
            DSA_KLOAD(0, wave);
            for (int tile00 = wave; tile00 < ntile; tile00 += 64) {
#pragma unroll
              for (int hb = 0; hb < 2; ++hb) {
                const int tile0 = tile00 + hb * 32;
                if (hb == 0) DSA_KLOAD(1, tile0 + 32); else DSA_KLOAD(0, tile0 + 32);
#pragma unroll
                for (int u = 0; u < 4; ++u) {
                    const int tile = tile0 + 8 * u;
                    if (tile < ntile) {
                        const int key = tile * 16 + fr;
                        float tot = 0.f;
#pragma unroll
                        for (int mt = 0; mt < 2; ++mt) {
                            f32x4 acc = (f32x4){0.f, 0.f, 0.f, 0.f};
                            acc = mfma16(a[mt][0], kb[hb][u][0], acc); acc = mfma16(a[mt][1], kb[hb][u][1], acc);
#define DSA_RELU(x) __builtin_amdgcn_fmed3f((x), 0.f, 3.0e38f)
                            const float r0 = DSA_RELU(acc.x), r1 = DSA_RELU(acc.y), r2 = DSA_RELU(acc.z), r3 = DSA_RELU(acc.w);
                            asm("v_fmac_f32_e32 %0, %1, %2" : "+v"(tot) : "v"(wv[mt].x), "v"(r0)); asm("v_fmac_f32_e32 %0, %1, %2" : "+v"(tot) : "v"(wv[mt].y), "v"(r1));
                            asm("v_fmac_f32_e32 %0, %1, %2" : "+v"(tot) : "v"(wv[mt].z), "v"(r2)); asm("v_fmac_f32_e32 %0, %1, %2" : "+v"(tot) : "v"(wv[mt].w), "v"(r3));
#undef DSA_RELU
                        }
                        const int r = fq;
                        const unsigned fb = __float_as_uint(tot);
                        unsigned uk = fb ^ ((unsigned)((int)fb >> 31) | 0x80000000u);
                        if (tile == ntile - 1) uk = (key <= s0 + r) ? uk : 0u;
                        SC[r * 8192 + key] = uk;
                        if (sel && srep == 0 && uk != 0u) { const unsigned d = uk >> 21; atomicAdd(&HIST[r * 1024 + (d >> 1)], (d & 1u) ? 65536u : 1u); if (REPEAT_GROUP == 22) atomicAdd(&HIST[r * 1024 + (d >> 1)], 0u); }
                    }
                }
              }
            }
            }
#undef DSA_KLOAD
        }
        { const int kn = DSA_UNIT(it2 + 1); if ((it2 + 1) * nvb < 4096 * (REPEAT_GROUP == 2 ? 2 : 1) && kn < 4096) DSA_QLOAD(kn); }
        __syncthreads();
        if (!sel) {
            const int r = tid >> 7, tl = tid & 127, n = s0 + r + 1;
            for (int i = tl; i < 256; i += 128) SEL[r * 256 + i] = (unsigned short)(i < n ? i : 0);
            if (tl == 0) MISC[8 + r] = (unsigned)n;
        } else {
            const int r = tid >> 7, tl = tid & 127, hi = tl >> 6;
            unsigned* CK = (unsigned*)(g_lds + DSA_CAND); unsigned short* CI = (unsigned short*)(g_lds + DSA_CAND + 8192);
            for (int selrep = 0; selrep < (REPEAT_GROUP == 23 ? 2 : 1); ++selrep) {
            const unsigned long long ltm = (1ull << lane) - 1ull;
            unsigned prefix = 0u; int need = 256;
            {
                unsigned s = 0u;
                for (int w = 0; w < 8; ++w) { const unsigned hw = HIST[r * 1024 + tl * 8 + w]; s += (hw & 0xffffu) + (hw >> 16); }
                unsigned incl = s;
#pragma unroll
                for (int off = 1; off < 64; off <<= 1) { const unsigned t2 = __shfl_down(incl, off); if (lane + off < 64) incl += t2; }
                if (hi == 1 && lane == 0) PART[r] = incl;
                __syncthreads();
                const unsigned above = (incl - s) + (hi == 0 ? PART[r] : 0u);
                if ((int)above < need && need <= (int)(above + s)) {
                    unsigned cum = above; int dsel = tl * 16;
                    for (int d = tl * 16 + 15; d >= tl * 16; --d) {
                        const unsigned hw = HIST[r * 1024 + (d >> 1)]; const unsigned c = (d & 1) ? (hw >> 16) : (hw & 0xffffu);
                        if ((int)(cum + c) >= need) { dsel = d; break; }
                        cum += c;
                    }
                    MISC[r] = (unsigned)dsel; MISC[4 + r] = (unsigned)(need - (int)cum);
                }
                __syncthreads();
                prefix = MISC[r]; need = (int)MISC[4 + r];
            }
            const int ngt1 = 256 - need;
            {
                const int mid = ((npad >> 1) + 63) & ~63, lo_i = hi ? mid : 0, hi_i = hi ? npad : mid;
                const int ngr = (hi_i - lo_i + 63) >> 6;
                unsigned mg0 = 0u, mg1 = 0u, me0 = 0u, me1 = 0u;
#pragma unroll 4
                for (int gidx = 0; gidx < ngr; ++gidx) {
                    const int i = lo_i + gidx * 64 + lane; const unsigned u = (i < hi_i) ? SC[r * 8192 + i] : 0u; const unsigned bin = u >> 21;
                    const unsigned long long mg = __ballot(bin > prefix), me = __ballot((bin == prefix) && (u != 0u));
                    const bool mine = (lane == gidx);
                    mg0 = mine ? (unsigned)mg : mg0; mg1 = mine ? (unsigned)(mg >> 32) : mg1; me0 = mine ? (unsigned)me : me0; me1 = mine ? (unsigned)(me >> 32) : me1;
                }
                const unsigned packed = (unsigned)(__popc(mg0) + __popc(mg1)) | ((unsigned)(__popc(me0) + __popc(me1)) << 16);
                unsigned incl = packed;
#pragma unroll
                for (int off = 1; off < 64; off <<= 1) { const unsigned t2 = __shfl_up(incl, off); if (lane >= off) incl += t2; }
                int pg = (int)((incl - packed) & 0xffffu), pe = (int)((incl - packed) >> 16);
                const int cc = (int)(__shfl(incl, 63) >> 16);
                unsigned long long m = ((unsigned long long)mg1 << 32) | mg0;
                while (m) { const int i = lo_i + lane * 64 + __builtin_ctzll(m); m &= m - 1ull; SEL[r * 256 + (hi ? (ngt1 - 1 - pg) : pg)] = (unsigned short)i; ++pg; }
                m = ((unsigned long long)me1 << 32) | me0;
                while (m) { const int i = lo_i + lane * 64 + __builtin_ctzll(m); m &= m - 1ull;
                    if (pe < 512) { const int q = hi ? (511 - pe) : pe; const unsigned u = SC[r * 8192 + i]; CK[r * 512 + q] = ((u & 0x1FFFFFu) << 10) | (unsigned)((hi ? 511 : 1023) - pe); CI[r * 512 + q] = (unsigned short)i; }
                    ++pe; }
                if (lane == 0) MISC[12 + r * 2 + hi] = (unsigned)cc;
            }
            __syncthreads();
            bool ovf = false;
#pragma unroll
            for (int q = 0; q < 4; ++q) ovf |= (MISC[12 + q * 2] + MISC[13 + q * 2] > 512u);
            if (!ovf) {
                const int c0 = (int)MISC[12 + r * 2], c1 = (int)MISC[13 + r * 2], C = c0 + c1;
                unsigned kc[4]; int rank[4]; unsigned short ki[4];
#pragma unroll
                for (int q = 0; q < 4; ++q) { const int c = tl + q * 128; const int qc = (c < c0) ? c : (512 - C + c); kc[q] = (c < C) ? CK[r * 512 + qc] : ~0u; ki[q] = (c < C) ? CI[r * 512 + qc] : (unsigned short)0; rank[q] = 0; }
                const unsigned* s0 = CK + r * 512; const unsigned* s1 = CK + r * 512 + (512 - c1);
                if (C <= 256) {
#pragma unroll 8
                    for (int c2 = 0; c2 < c0; ++c2) { const unsigned k2 = s0[c2]; rank[0] += (k2 > kc[0]) ? 1 : 0; rank[1] += (k2 > kc[1]) ? 1 : 0; }
#pragma unroll 8
                    for (int c2 = 0; c2 < c1; ++c2) { const unsigned k2 = s1[c2]; rank[0] += (k2 > kc[0]) ? 1 : 0; rank[1] += (k2 > kc[1]) ? 1 : 0; }
                } else {
#pragma unroll 8
                    for (int c2 = 0; c2 < c0; ++c2) { const unsigned k2 = s0[c2];
#pragma unroll
                        for (int q = 0; q < 4; ++q) rank[q] += (k2 > kc[q]) ? 1 : 0; }
#pragma unroll 8
                    for (int c2 = 0; c2 < c1; ++c2) { const unsigned k2 = s1[c2];
#pragma unroll
                        for (int q = 0; q < 4; ++q) rank[q] += (k2 > kc[q]) ? 1 : 0; }
                }
#pragma unroll
                for (int q = 0; q < 4; ++q) if (tl + q * 128 < C && rank[q] < need) SEL[r * 256 + ngt1 + rank[q]] = ki[q];
                if (tl == 0) MISC[8 + r] = 256u;
            } else if (selrep == 0) {
#pragma unroll 1
                for (int pass = 1; pass < 3; ++pass) {
                    const int shift = pass == 1 ? 10 : 0, nbits = pass == 2 ? 10 : 11, per = (1 << nbits) / 128;
                    for (int i = tl; i < 1024; i += 128) HIST[r * 1024 + i] = 0u;
                    __syncthreads();
                    for (int i = tl; i < npad; i += 128) {
                        const unsigned u = SC[r * 8192 + i];
                        if ((u >> (shift + nbits)) == prefix) { const unsigned d = (u >> shift) & ((1u << nbits) - 1u); atomicAdd(&HIST[r * 1024 + (d >> 1)], (d & 1u) ? 65536u : 1u); }
                    }
                    __syncthreads();
                    unsigned s = 0u;
                    for (int w = 0; w < per / 2; ++w) { const unsigned hw = HIST[r * 1024 + tl * (per / 2) + w]; s += (hw & 0xffffu) + (hw >> 16); }
                    unsigned incl = s;
#pragma unroll
                    for (int off = 1; off < 64; off <<= 1) { const unsigned t2 = __shfl_down(incl, off); if (lane + off < 64) incl += t2; }
                    if (hi == 1 && lane == 0) PART[r] = incl;
                    __syncthreads();
                    const unsigned above = (incl - s) + (hi == 0 ? PART[r] : 0u);
                    if ((int)above < need && need <= (int)(above + s)) {
                        unsigned cum = above; int dsel = tl * per;
                        for (int d = tl * per + per - 1; d >= tl * per; --d) {
                            const unsigned hw = HIST[r * 1024 + (d >> 1)]; const unsigned c = (d & 1) ? (hw >> 16) : (hw & 0xffffu);
                            if ((int)(cum + c) >= need) { dsel = d; break; }
                            cum += c;
                        }
                        MISC[r] = (prefix << nbits) | (unsigned)dsel; MISC[4 + r] = (unsigned)(need - (int)cum);
                    }
                    __syncthreads();
                    prefix = MISC[r]; need = (int)MISC[4 + r];
                }
                if (wave < 4) {
                    const int rr = wave; const unsigned Kst = MISC[rr]; const int nd = (int)MISC[4 + rr], ngt = 256 - nd;
                    int cg = 0, ce = 0;
                    for (int base = 0; base < npad; base += 64) {
                        const int i0 = base + lane;
                        const unsigned u0 = (i0 < npad) ? SC[rr * 8192 + i0] : 0u;
                        const bool gt0 = u0 > Kst, eq0 = (u0 == Kst);
                        const unsigned long long mg0 = __ballot(gt0), me0 = __ballot(eq0);
                        if (gt0) SEL[rr * 256 + cg + __popcll(mg0 & ltm)] = (unsigned short)i0;
                        if (eq0) { const int rk = ce + __popcll(me0 & ltm); if (rk < nd) SEL[rr * 256 + ngt + rk] = (unsigned short)i0; }
                        cg += __popcll(mg0); ce += __popcll(me0);
                    }
                    if (lane == 0) MISC[8 + rr] = 256u;
                }
            }
            if (REPEAT_GROUP == 23) __syncthreads();
            }
        }
        __syncthreads();
        {
            unsigned short* SELG = (unsigned short*)(ws + OFF_SELG);
            if (tid < 128) { const int r = tid >> 5, c8 = tid & 31;
                *(u32x4*)(SELG + (size_t)(tok0 + r) * 256 + c8 * 8) = *(const u32x4*)(SEL + r * 256 + c8 * 8); }
        }
    }
}

#undef DSA_QLOAD
#undef DSA_UNIT
DEV void ph_dsa_attn(const Params& p, int vb, int nvb) {
    unsigned char* ws = p.ws;
    const bf16_t* QA = (const bf16_t*)(ws + OFF_QA); const bf16_t* KV = (const bf16_t*)(ws + OFF_KV); bf16_t* MIX = (bf16_t*)(ws + OFF_MIX);
    const unsigned short* SELG = (const unsigned short*)(ws + OFF_SELG);
    unsigned* Q = (unsigned*)(ws + OFF_CTL) + CW_DSAQ;
    int tz = TIDX; asm volatile("" : "+v"(tz));
    const int tid = tz, wave = tid >> 6, lane = tid & 63, fr = lane & 15, fq = lane >> 4;
    float* P = (float*)g_lds + wave * 1024;
    unsigned short* SELW = (unsigned short*)(g_lds + 32768) + wave * 256;
    const int grp0 = (int)((xb_xcc_id() >> 1) & 3u);
    const float scale = 0.08838834764831845f;
    for (int gi = 0; gi < 4; ++gi) {
        const int grp = (grp0 + gi) & 3, b = grp >> 1, g = grp & 1;
        const unsigned char* kvb = (const unsigned char*)KV + (size_t)(b * SEQ) * 512 + g * 256;
        for (;;) {
            unsigned chunk = 0;
            if (lane == 0) chunk = atomicAdd(&Q[grp * 64], 1u);
            chunk = (unsigned)__builtin_amdgcn_readfirstlane((int)chunk);
            if (chunk >= 2048u) break;
            const int sbase = (2047 - (int)chunk) * 4;
            u32x2 selnext = *(const u32x2*)(SELG + (size_t)(b * SEQ + sbase) * 256 + lane * 4);
#pragma unroll 1
            for (int rr = 0; rr < 4; ++rr) {
                const int sl = sbase + rr, tok = b * SEQ + sl, ns = min(sl + 1, 256);
                *(u32x2*)(SELW + lane * 4) = selnext;
                if (rr < 3) selnext = *(const u32x2*)(SELG + (size_t)(tok + 1) * 256 + lane * 4);
                bf16x8 qf[4];
#pragma unroll
                for (int ks = 0; ks < 4; ++ks) {
                    bf16x8 z = {0, 0, 0, 0, 0, 0, 0, 0};
                    qf[ks] = (fr < 4) ? *(const bf16x8*)(QA + (size_t)tok * 1024 + (4 * g + fr) * 128 + fq * 32 + ks * 8) : z;
                }
                __builtin_amdgcn_wave_barrier();
                float sc[4][4];
                {
                    u32x4 kf[16][2];
#define ATT_KLOAD(u0, u1) do { _Pragma("unroll") for (int u = (u0); u < (u1); ++u) { const int j = u * 16 + fr; const int idx = (j < ns) ? (int)SELW[j] : 0; \
                        const unsigned char* kp = kvb + (size_t)idx * 512 + fq * 32; kf[u][0] = *(const u32x4*)kp; kf[u][1] = *(const u32x4*)(kp + 16); } } while (0)
#define ATT_KUSE(u0, u1) do { _Pragma("unroll") for (int u = (u0); u < (u1); ++u) { f32x4 acc = (f32x4){0.f, 0.f, 0.f, 0.f}; \
                        _Pragma("unroll") for (int ks = 0; ks < 4; ++ks) { const u32x4 kq = kf[u][ks >> 1]; acc = mfma16(qf[ks], fp8x8_to_bf16((ks & 1) ? (u32x2){kq.z, kq.w} : (u32x2){kq.x, kq.y}), acc); } \
                        _Pragma("unroll") for (int h = 0; h < 4; ++h) { const float t = __shfl(acc[h], fr); if (fq == (u & 3)) sc[u >> 2][h] = t; } \
                        __builtin_amdgcn_sched_barrier(0); } } while (0)
                    ATT_KLOAD(0, 8);
                    __builtin_amdgcn_sched_barrier(0);
                    ATT_KUSE(0, 4);
                    ATT_KLOAD(8, 12);
                    __builtin_amdgcn_sched_barrier(0);
                    ATT_KUSE(4, 8);
                    ATT_KLOAD(12, 16);
                    __builtin_amdgcn_sched_barrier(0);
                    ATT_KUSE(8, 16);
#undef ATT_KLOAD
#undef ATT_KUSE
                }
                const unsigned char* vb2 = kvb + 128 + fr * 8;
                const int ngrp = (ns + 3) >> 2;
                u32x2 vvA[16], vvB[16];
#define ATT_VLOAD(vv, g0) do { _Pragma("unroll") for (int u = 0; u < 16; ++u) { const int j = min(((g0) + u) * 4 + fq, 255); const int idx = (int)SELW[j]; vv[u] = *(const u32x2*)(vb2 + (size_t)idx * 512); } } while (0)
                ATT_VLOAD(vvA, 0);
                __builtin_amdgcn_sched_barrier(0);
#pragma unroll
                for (int i = 0; i < 4; ++i) {
                    const bool vld = ((i * 4 + fq) * 16 + fr) < ns;
#pragma unroll
                    for (int h = 0; h < 4; ++h) sc[i][h] = vld ? sc[i][h] * scale : -INFINITY;
                }
                float mx[4], sm[4];
#pragma unroll
                for (int h = 0; h < 4; ++h) { mx[h] = wave_max(fmaxf(fmaxf(sc[0][h], sc[1][h]), fmaxf(sc[2][h], sc[3][h]))); sm[h] = 0.f; }
#pragma unroll
                for (int i = 0; i < 4; ++i) {
                    f32x4 pv;
#pragma unroll
                    for (int h = 0; h < 4; ++h) { const float e = __expf(sc[i][h] - mx[h]); pv[h] = e; sm[h] += e; }
                    *(f32x4*)(P + ((i * 4 + fq) * 16 + fr) * 4) = pv;
                }
                float inv[4];
#pragma unroll
                for (int h = 0; h < 4; ++h) inv[h] = __builtin_amdgcn_rcpf(wave_sum(sm[h]));
                __builtin_amdgcn_wave_barrier();
                float o[4][8];
#pragma unroll
                for (int h = 0; h < 4; ++h)
#pragma unroll
                    for (int e = 0; e < 8; ++e) o[h][e] = 0.f;
#define ATT_PV(vv, g0) do { _Pragma("unroll") for (int u = 0; u < 16; ++u) { \
                        const int j = ((g0) + u) * 4 + fq; \
                        f32x4 pv = *(const f32x4*)(P + min(j, 255) * 4); \
                        if (j >= ns) pv = (f32x4){0.f, 0.f, 0.f, 0.f}; \
                        const f32x4 va = up4_fp8(vv[u].x), vb4 = up4_fp8(vv[u].y); \
                        const float v8[8] = {va.x, va.y, va.z, va.w, vb4.x, vb4.y, vb4.z, vb4.w}; \
                        _Pragma("unroll") for (int h = 0; h < 4; ++h) _Pragma("unroll") for (int e = 0; e < 8; ++e) \
                            asm("v_fmac_f32_e32 %0, %1, %2" : "+v"(o[h][e]) : "v"(pv[h]), "v"(v8[e]));        \
                        if ((u & 3) == 3) __builtin_amdgcn_sched_barrier(0);         \
                    } } while (0)
#pragma unroll 1
                for (int g0 = 0; g0 < ngrp; g0 += 32) {
                    if (g0 + 16 < ngrp) ATT_VLOAD(vvB, g0 + 16);
                    __builtin_amdgcn_sched_barrier(0);
                    ATT_PV(vvA, g0);
                    if (g0 + 16 < ngrp) {
                        if (g0 + 32 < ngrp) ATT_VLOAD(vvA, g0 + 32);
                        __builtin_amdgcn_sched_barrier(0);
                        ATT_PV(vvB, g0 + 16);
                    }
                }
#undef ATT_VLOAD
#undef ATT_PV
#pragma unroll
                for (int h = 0; h < 4; ++h)
#pragma unroll
                    for (int e = 0; e < 8; ++e) { float v = o[h][e]; v += __shfl_xor(v, 16); v += __shfl_xor(v, 32); o[h][e] = v * inv[h]; }
                if (fq == 0) {
#pragma unroll
                    for (int h = 0; h < 4; ++h) {
                        if (FP8_OUT0) { u32x2 w8; w8.x = pk4_fp8(o[h][0], o[h][1], o[h][2], o[h][3]); w8.y = pk4_fp8(o[h][4], o[h][5], o[h][6], o[h][7]);
                            *(u32x2*)(ws + OFF_H + (size_t)tok * 2048 + (4 * g + h) * 128 + fr * 8) = w8; }
                        else { u32x4 w; w.x = pk_bf16(o[h][0], o[h][1]); w.y = pk_bf16(o[h][2], o[h][3]); w.z = pk_bf16(o[h][4], o[h][5]); w.w = pk_bf16(o[h][6], o[h][7]);
                            *(u32x4*)(MIX + (size_t)tok * 2048 + (4 * g + h) * 128 + fr * 8) = w; }
                    }
                }
                __builtin_amdgcn_wave_barrier();
            }
        }
    }
}

#ifdef DEBUG_NAN
#define DBG_SUB(cond, code) do { if (cond) atomicMax((unsigned*)(p.ws + OFF_CTL) + 8001, (unsigned)(code)); } while (0)
DEV bool nonfin(float v) { return (__float_as_uint(v) & 0x7f800000u) == 0x7f800000u; }
#else
#define DBG_SUB(cond, code) do {} while (0)
#endif
constexpr int SSD_PITCH = 136;
DEV void ssd_dt_acum(const Params& p, int tok0, int g, float* acum, float* dtv, float* cd_out) {
    const float* DT = (const float*)(p.ws + OFF_DT);
    for (int i = TIDX; i < 1024; i += NBLK) dtv[i] = DT[(size_t)(tok0 + (i >> 3)) * 16 + g * 8 + (i & 7)];
    __syncthreads();
    if (TIDX < 8) {
        const float a = -expf(p.a_log[g * 8 + TIDX]); float run = 0.f;
        for (int row = 0; row < 128; ++row) { run += dtv[row * 8 + TIDX] * a; acum[row * 8 + TIDX] = run; }
        if (cd_out) cd_out[g * 8 + TIDX] = expf(run);
    }
    __syncthreads();
}

DEV void ph_ssd_states(const Params& p, int vb, int nvb) {
    unsigned char* ws = p.ws;
    const bf16_t* XC = (const bf16_t*)(ws + OFF_XC); float* ST = (float*)(ws + OFF_ST); float* CD = (float*)(ws + OFF_CD);
    float* acum = (float*)g_lds; float* dtv = (float*)(g_lds + 4096);
    bf16_t* BT = (bf16_t*)(g_lds + 8192); bf16_t* XT = (bf16_t*)(g_lds + 43008);
    const int tid = TIDX, wave = tid >> 6, lane = tid & 63, fr = lane & 15, fq = lane >> 4;
    for (int unit = vb; unit < 256; unit += nvb) {
        const int b = unit >> 7, c = (unit >> 1) & 63, g = unit & 1, tok0 = b * SEQ + c * 128;
        __syncthreads();
        ssd_dt_acum(p, tok0, g, acum, dtv, CD + (size_t)(b * 64 + c) * 16);
        for (int ci = tid; ci < 2048; ci += NBLK) {
            const int j = ci & 127, n8 = ci >> 7;
            const u32x4 w = *(const u32x4*)(XC + (size_t)(tok0 + j) * 1536 + 1024 + g * 128 + n8 * 8);
            const unsigned ww[4] = {w.x, w.y, w.z, w.w};
#pragma unroll
            for (int e = 0; e < 4; ++e) { BT[(n8 * 8 + 2 * e) * SSD_PITCH + j] = (bf16_t)(ww[e] & 0xffffu); BT[(n8 * 8 + 2 * e + 1) * SSD_PITCH + j] = (bf16_t)(ww[e] >> 16); }
        }
        for (int half = 0; half < 2; ++half) {
            __syncthreads();
            for (int ci = tid; ci < 4096; ci += NBLK) {
                const int j = ci & 127, c8 = ci >> 7, chl0 = c8 * 8, hh = half * 4 + (chl0 >> 6);
                const float scl = dtv[j * 8 + hh] * expf(acum[127 * 8 + hh] - acum[j * 8 + hh]);
                float v[8]; ld8(XC + (size_t)(tok0 + j) * 1536 + g * 512 + half * 256 + chl0, v);
#pragma unroll
                for (int e = 0; e < 8; ++e) XT[(chl0 + e) * SSD_PITCH + j] = f2bf(v[e] * scl);
            }
            __syncthreads();
            const int hh4 = wave >> 1, nh = wave & 1;
            f32x4 acc[4][4];
#pragma unroll
            for (int m = 0; m < 4; ++m)
#pragma unroll
                for (int n = 0; n < 4; ++n) acc[m][n] = (f32x4){0.f, 0.f, 0.f, 0.f};
#pragma unroll
            for (int ks = 0; ks < 4; ++ks) {
                bf16x8 af[4], bfr[4];
#pragma unroll
                for (int m = 0; m < 4; ++m) af[m] = *(const bf16x8*)(XT + (hh4 * 64 + m * 16 + fr) * SSD_PITCH + ks * 32 + fq * 8);
#pragma unroll
                for (int n = 0; n < 4; ++n) bfr[n] = *(const bf16x8*)(BT + (nh * 64 + n * 16 + fr) * SSD_PITCH + ks * 32 + fq * 8);
#pragma unroll
                for (int m = 0; m < 4; ++m)
#pragma unroll
                    for (int n = 0; n < 4; ++n) acc[m][n] = mfma16(bfr[n], af[m], acc[m][n]);
            }
            const int h = g * 8 + half * 4 + hh4;
            float* stp = ST + ((size_t)((b * 64 + c) * 16 + h)) * 8192;
#pragma unroll
            for (int m = 0; m < 4; ++m)
#pragma unroll
                for (int n = 0; n < 4; ++n) *(f32x4*)(stp + (m * 16 + fr) * 128 + nh * 64 + n * 16 + fq * 4) = acc[m][n];
        }
    }
}

DEV void ph_ssd_scan(const Params& p, int vb, int nvb) {
    const float* ST = (const float*)(p.ws + OFF_ST); const float* CD = (const float*)(p.ws + OFF_CD); bf16_t* PREV = (bf16_t*)(p.ws + OFF_PREV);
    for (int e = vb * NBLK + TIDX; e < 65536; e += nvb * NBLK) {
        const int b = e >> 15, rem = e & 32767, h = rem >> 11, pn = rem & 2047;
        f32x4 run = (f32x4){0.f, 0.f, 0.f, 0.f};
#pragma unroll 8
        for (int c = 0; c < 64; ++c) {
            const size_t off = ((size_t)((b * 64 + c) * 16 + h)) * 8192 + pn * 4;
            const f32x4 st = *(const f32x4*)(ST + off); const float cd = CD[(b * 64 + c) * 16 + h];
            u32x2 w; w.x = pk_bf16(run.x, run.y); w.y = pk_bf16(run.z, run.w);
            *(u32x2*)(PREV + off) = w;
            run = run * cd + st;
        }
    }
}

DEV void ph_ssd_out(const Params& p, int vb, int nvb) {
    unsigned char* ws = p.ws;
    const bf16_t* XC = (const bf16_t*)(ws + OFF_XC); const bf16_t* Z0 = (const bf16_t*)(ws + OFF_Z); const bf16_t* PREV = (const bf16_t*)(ws + OFF_PREV);
    bf16_t* MIX = (bf16_t*)(ws + OFF_MIX);
    float* acum = (float*)g_lds; float* dtv = (float*)(g_lds + 4096); float* sspart = (float*)(g_lds + 8192); float* rstd = (float*)(g_lds + 16384);
    bf16_t* Cs = (bf16_t*)(g_lds + 17408); bf16_t* BL = (bf16_t*)(g_lds + 52224); bf16_t* CBs = (bf16_t*)(g_lds + 87040); bf16_t* XT = (bf16_t*)(g_lds + 121856);
    constexpr int SO_PATCH = 139264;
    const int tid = TIDX, wave = tid >> 6, lane = tid & 63, fr = lane & 15, fq = lane >> 4, wm = wave >> 1, wn = wave & 1;
    for (int unit = vb; unit < 256; unit += nvb) {
        const int b = unit >> 7, c = (unit >> 1) & 63, g = unit & 1, tok0 = b * SEQ + c * 128;
        __syncthreads();
        ssd_dt_acum(p, tok0, g, acum, dtv, nullptr);
#ifdef DEBUG_NAN
        for (int i = tid; i < 1024; i += NBLK) { DBG_SUB(nonfin(acum[i]), 60); DBG_SUB(nonfin(dtv[i]), 61); DBG_SUB(dtv[i] < 0.f, 62); DBG_SUB(dtv[i] > 100.f, 63); }
        if (tid < 16) DBG_SUB(nonfin(p.a_log[tid]) || p.a_log[tid] > 10.f || p.a_log[tid] < -10.f, 64);
#endif
        for (int ci = tid; ci < 2048; ci += NBLK) {
            const int row = ci >> 4, q = ci & 15;
            *(u32x4*)(Cs + row * SSD_PITCH + q * 8) = *(const u32x4*)(XC + (size_t)(tok0 + row) * 1536 + 1280 + g * 128 + q * 8);
            *(u32x4*)(BL + row * SSD_PITCH + q * 8) = *(const u32x4*)(XC + (size_t)(tok0 + row) * 1536 + 1024 + g * 128 + q * 8);
        }
        __syncthreads();
#ifdef DEBUG_NAN
        for (int i = tid; i < 1024; i += NBLK) DBG_SUB(nonfin(acum[i]), 75);
#endif
        {
            f32x4 acc[2][4];
#pragma unroll
            for (int m = 0; m < 2; ++m)
#pragma unroll
                for (int n = 0; n < 4; ++n) acc[m][n] = (f32x4){0.f, 0.f, 0.f, 0.f};
#pragma unroll
            for (int ks = 0; ks < 4; ++ks) {
                bf16x8 af[2], bfr[4];
#pragma unroll
                for (int m = 0; m < 2; ++m) af[m] = *(const bf16x8*)(Cs + (wm * 32 + m * 16 + fr) * SSD_PITCH + ks * 32 + fq * 8);
#pragma unroll
                for (int n = 0; n < 4; ++n) bfr[n] = *(const bf16x8*)(BL + (wn * 64 + n * 16 + fr) * SSD_PITCH + ks * 32 + fq * 8);
#pragma unroll
                for (int m = 0; m < 2; ++m)
#pragma unroll
                    for (int n = 0; n < 4; ++n) acc[m][n] = mfma16(bfr[n], af[m], acc[m][n]);
            }
#pragma unroll
            for (int m = 0; m < 2; ++m)
#pragma unroll
                for (int n = 0; n < 4; ++n) { u32x2 w; w.x = pk_bf16(acc[m][n].x, acc[m][n].y); w.y = pk_bf16(acc[m][n].z, acc[m][n].w);
#ifdef DEBUG_NAN
                    DBG_SUB(nonfin(acc[m][n].x) || nonfin(acc[m][n].y) || nonfin(acc[m][n].z) || nonfin(acc[m][n].w), 80);
                    DBG_SUB(fabsf(acc[m][n].x) > 1e6f, 81);
                    DBG_SUB((w.x & 0x7f80u) == 0x7f80u || (w.x & 0x7f800000u) == 0x7f800000u || (w.y & 0x7f80u) == 0x7f80u || (w.y & 0x7f800000u) == 0x7f800000u, 82);
#endif
                    *(u32x2*)(CBs + (wm * 32 + m * 16 + fr) * SSD_PITCH + wn * 64 + n * 16 + fq * 4) = w; }
        }
        __syncthreads();
        for (int hh = 0; hh < 8; ++hh) {
            const int h = g * 8 + hh, ch0 = g * 512 + hh * 64;
#ifdef DEBUG_NAN
            for (int i = tid; i < 1024; i += NBLK) DBG_SUB(nonfin(acum[i]), hh == 0 ? 74 : 73);
#endif
            for (int ci = tid; ci < 2048; ci += NBLK) {
                const int i = ci >> 4, j0 = (ci & 15) * 8; const float ai = acum[i * 8 + hh];
                float v[8]; ld8(CBs + i * SSD_PITCH + j0, v);
#ifdef DEBUG_NAN
                for (int e = 0; e < 8; ++e) DBG_SUB(nonfin(v[e]), 78);
#endif
#pragma unroll
                for (int e = 0; e < 8; ++e) { const int j = j0 + e; v[e] = (j <= i) ? v[e] * expf(ai - acum[j * 8 + hh]) : 0.f; }
#ifdef DEBUG_NAN
                for (int e = 0; e < 8; ++e) DBG_SUB(nonfin(v[e]), 53);
                DBG_SUB(nonfin(ai), 54);
#endif
                st8(BL + i * SSD_PITCH + j0, v);
            }
            for (int ci = tid; ci < 1024; ci += NBLK) {
                const int j = ci & 127, p0 = (ci >> 7) * 8; const float d = dtv[j * 8 + hh];
                float v[8]; ld8(XC + (size_t)(tok0 + j) * 1536 + ch0 + p0, v);
#pragma unroll
                for (int e = 0; e < 8; ++e) XT[(p0 + e) * SSD_PITCH + j] = f2bf(v[e] * d);
            }
            __syncthreads();
            f32x4 ad[2][2], ao[2][2];
#pragma unroll
            for (int m = 0; m < 2; ++m)
#pragma unroll
                for (int n = 0; n < 2; ++n) { ad[m][n] = (f32x4){0.f, 0.f, 0.f, 0.f}; ao[m][n] = (f32x4){0.f, 0.f, 0.f, 0.f}; }
            const bf16_t* pv = PREV + ((size_t)((b * 64 + c) * 16 + h)) * 8192;
#pragma unroll
            for (int ks = 0; ks < 4; ++ks) {
                bf16x8 al[2], ac[2], bx[2], bp[2];
#pragma unroll
                for (int m = 0; m < 2; ++m) { al[m] = *(const bf16x8*)(BL + (wm * 32 + m * 16 + fr) * SSD_PITCH + ks * 32 + fq * 8);
                                              ac[m] = *(const bf16x8*)(Cs + (wm * 32 + m * 16 + fr) * SSD_PITCH + ks * 32 + fq * 8); }
#pragma unroll
                for (int n = 0; n < 2; ++n) { bx[n] = *(const bf16x8*)(XT + (wn * 32 + n * 16 + fr) * SSD_PITCH + ks * 32 + fq * 8);
                                              bp[n] = *(const bf16x8*)(pv + (wn * 32 + n * 16 + fr) * 128 + ks * 32 + fq * 8); }
#pragma unroll
                for (int m = 0; m < 2; ++m)
#pragma unroll
                    for (int n = 0; n < 2; ++n) { ad[m][n] = mfma16(bx[n], al[m], ad[m][n]); ao[m][n] = mfma16(bp[n], ac[m], ao[m][n]); }
#ifdef DEBUG_NAN
                for (int m = 0; m < 2; ++m) for (int e = 0; e < 8; ++e) { DBG_SUB(((unsigned short)al[m][e] & 0x7f80u) == 0x7f80u, 50); DBG_SUB(((unsigned short)bx[m][e] & 0x7f80u) == 0x7f80u, 51); }
#endif
            }
            const float dsk = p.ssm_d[h];
#pragma unroll
            for (int m = 0; m < 2; ++m) {
                const float ea = expf(acum[(wm * 32 + m * 16 + fr) * 8 + hh]);
                unsigned char* bb = g_lds + SO_PATCH + wave * 2304;
#pragma unroll
                for (int n = 0; n < 2; ++n) *(f32x4*)(bb + fr * 144 + n * 64 + fq * 16) = ad[m][n] + ao[m][n] * ea;
                const int r2 = lane >> 2, c2 = lane & 3, i = wm * 32 + m * 16 + r2, pc = wn * 32 + c2 * 8;
                const f32x4 t0 = *(const f32x4*)(bb + r2 * 144 + c2 * 32), t1 = *(const f32x4*)(bb + r2 * 144 + c2 * 32 + 16);
                const u32x4 xw = *(const u32x4*)(XC + (size_t)(tok0 + i) * 1536 + ch0 + pc);
                const u32x4 zw = *(const u32x4*)(Z0 + (size_t)(tok0 + i) * LD0 + 2048 + ch0 + pc);
                float xs[8], zz[8]; up8(xw, xs); up8(zw, zz);
                const float t[8] = {t0.x, t0.y, t0.z, t0.w, t1.x, t1.y, t1.z, t1.w};
                float y[8], ssq = 0.f;
#pragma unroll
                for (int e = 0; e < 8; ++e) { y[e] = (t[e] + dsk * xs[e]) * siluf(zz[e]); ssq += y[e] * y[e]; }
                st8(MIX + (size_t)(tok0 + i) * 2048 + 1024 + ch0 + pc, y);
                ssq += __shfl_xor(ssq, 1); ssq += __shfl_xor(ssq, 2);
                if (c2 == 0) sspart[i * 16 + hh * 2 + wn] = ssq;
            }
            __syncthreads();
        }
        if (tid < 128) { float s = 0.f;
#pragma unroll
            for (int k2 = 0; k2 < 16; ++k2) s += sspart[tid * 16 + k2];
            rstd[tid] = rsqrtf(s * (1.f / 512.f) + EPS); }
        WAIT_VM0();
        __syncthreads();
#pragma unroll 4
        for (int k2 = 0; k2 < 16; ++k2) {
            const int ci = tid + k2 * NBLK, i = ci >> 6, cc = g * 512 + (ci & 63) * 8; const float rs = rstd[i];
            bf16_t* yp = MIX + (size_t)(tok0 + i) * 2048 + 1024 + cc;
            const u32x4 yw = *(const u32x4*)yp; const f32x4 g0 = *(const f32x4*)(p.ssm_norm + cc), g1 = *(const f32x4*)(p.ssm_norm + cc + 4);
            if (FP8_OUT0) { u32x2 w8; w8.x = pk4_fp8(bflo(yw.x) * rs * g0.x, bfhi(yw.x) * rs * g0.y, bflo(yw.y) * rs * g0.z, bfhi(yw.y) * rs * g0.w);
                w8.y = pk4_fp8(bflo(yw.z) * rs * g1.x, bfhi(yw.z) * rs * g1.y, bflo(yw.w) * rs * g1.z, bfhi(yw.w) * rs * g1.w);
                *(u32x2*)(ws + OFF_H + (size_t)(tok0 + i) * 2048 + 1024 + cc) = w8; }
            else { u32x4 w; w.x = pk_bf16(bflo(yw.x) * rs * g0.x, bfhi(yw.x) * rs * g0.y); w.y = pk_bf16(bflo(yw.y) * rs * g0.z, bfhi(yw.y) * rs * g0.w);
                w.z = pk_bf16(bflo(yw.z) * rs * g1.x, bfhi(yw.z) * rs * g1.y); w.w = pk_bf16(bflo(yw.w) * rs * g1.z, bfhi(yw.w) * rs * g1.w);
                *(u32x4*)yp = w; }
        }
    }
}

DEV void ph_router(const Params& p, int layer, const float* X, int vb, int nvb) {
    unsigned char* ws = p.ws;
    const float* gnorm = p.ffn_norm + layer * 2048;
    const bf16_t* WRB = (const bf16_t*)(ws + OFF_WRT) + (size_t)layer * 327680;
    bf16_t* H = (bf16_t*)(ws + OFF_H); float* RSTD = (float*)(ws + OFF_RSTD);
    unsigned* cnt = (unsigned*)(ws + OFF_CTL) + CW_CNT + layer * 64;
    unsigned* LIST = (unsigned*)(ws + OFF_LIST) + (size_t)layer * 64 * 16384;
    float* GATE = (float*)(ws + OFF_GATE) + (size_t)layer * 32768;
    float* PART = (float*)g_lds;
    float* SSP = (float*)(g_lds + 147456);
    const int tid = TIDX, wave = tid >> 6, lane = tid & 63, fr = lane & 15, fq = lane >> 4;
    for (int rb = vb; rb < NTOK / 64; rb += nvb) {
        const int row0 = rb * 64;
        __syncthreads();
        f32x4 acc[4][5]; float ssq[4] = {0.f, 0.f, 0.f, 0.f};
#pragma unroll
        for (int mt = 0; mt < 4; ++mt)
#pragma unroll
            for (int nt = 0; nt < 5; ++nt) acc[mt][nt] = (f32x4){0.f, 0.f, 0.f, 0.f};
        f32x4 xr[4][2];
#define RT_XLOAD(mt_, ks_) do { const size_t ro_ = (size_t)(row0 + (mt_) * 16 + fr) * DM + (wave * 8 + (ks_)) * 32 + fq * 8; xr[mt_][0] = *(const f32x4*)(X + ro_); xr[mt_][1] = *(const f32x4*)(X + ro_ + 4); } while (0)
#pragma unroll
        for (int mt = 0; mt < 4; ++mt) RT_XLOAD(mt, 0);
#pragma unroll 1
        for (int ks = 0; ks < 8; ++ks) {
          {
            const int kg = wave * 8 + ks, kb = kg * 32 + fq * 8;
            const bf16_t* bp = WRB + ((size_t)kg * 10 * 64 + lane) * 8;
            bf16x8 bh[5], bl[5];
#pragma unroll
            for (int nt = 0; nt < 5; ++nt) { bh[nt] = *(const bf16x8*)(bp + nt * 512); bl[nt] = *(const bf16x8*)(bp + (5 + nt) * 512); }
            const f32x4 g0 = *(const f32x4*)(gnorm + kb), g1 = *(const f32x4*)(gnorm + kb + 4);
#pragma unroll
            for (int mt = 0; mt < 4; ++mt) {
                const size_t ro = (size_t)(row0 + mt * 16 + fr) * DM + kb;
                const f32x4 x0 = xr[mt][0], x1 = xr[mt][1];
                ssq[mt] += x0.x * x0.x + x0.y * x0.y + x0.z * x0.z + x0.w * x0.w + x1.x * x1.x + x1.y * x1.y + x1.z * x1.z + x1.w * x1.w;
                u32x4 hh; hh.x = pk_bf16(x0.x, x0.y); hh.y = pk_bf16(x0.z, x0.w); hh.z = pk_bf16(x1.x, x1.y); hh.w = pk_bf16(x1.z, x1.w);
                u32x4 ll; ll.x = pk_bf16(x0.x - bflo(hh.x), x0.y - bfhi(hh.x)); ll.y = pk_bf16(x0.z - bflo(hh.y), x0.w - bfhi(hh.y));
                ll.z = pk_bf16(x1.x - bflo(hh.z), x1.y - bfhi(hh.z)); ll.w = pk_bf16(x1.z - bflo(hh.w), x1.w - bfhi(hh.w));
                u32x2 hw; hw.x = pk4_fp8(x0.x * g0.x, x0.y * g0.y, x0.z * g0.z, x0.w * g0.w); hw.y = pk4_fp8(x1.x * g1.x, x1.y * g1.y, x1.z * g1.z, x1.w * g1.w);
                *(u32x2*)((unsigned char*)H + ro) = hw;
                if (ks + 1 < 8) RT_XLOAD(mt, ks + 1);
                const bf16x8 xh = __builtin_bit_cast(bf16x8, hh), xl = __builtin_bit_cast(bf16x8, ll);
#pragma unroll
                for (int nt = 0; nt < 5; ++nt) { acc[mt][nt] = mfma16(xh, bh[nt], acc[mt][nt]); acc[mt][nt] = mfma16(xl, bh[nt], acc[mt][nt]); acc[mt][nt] = mfma16(xh, bl[nt], acc[mt][nt]); }
            }
          }
        }
#undef RT_XLOAD
#pragma unroll
        for (int mt = 0; mt < 4; ++mt) {
#pragma unroll
            for (int nt = 0; nt < 5; ++nt) {
                const int col = nt * 16 + fr;
                if (col < 72) {
#pragma unroll
                    for (int j = 0; j < 4; ++j) PART[(wave * 64 + mt * 16 + fq * 4 + j) * 72 + col] = acc[mt][nt][j];
                }
            }
            float sq = ssq[mt]; sq += __shfl_xor(sq, 16); sq += __shfl_xor(sq, 32);
            if (fq == 0) SSP[wave * 64 + mt * 16 + fr] = sq;
        }
        __syncthreads();
        {
            const int row = tid >> 3, c0 = (tid & 7) * 9;
            float ss = 0.f;
#pragma unroll
            for (int w = 0; w < 8; ++w) ss += SSP[w * 64 + row];
            const float rs = rsqrtf(ss * (1.f / DM) + EPS);
            float sum[9];
#pragma unroll
            for (int c = 0; c < 9; ++c) { float t = 0.f;
#pragma unroll
                for (int w = 0; w < 8; ++w) t += PART[(w * 64 + row) * 72 + c0 + c];
                sum[c] = t * rs; }
#pragma unroll
            for (int c = 0; c < 9; ++c) PART[row * 72 + c0 + c] = sum[c];
            if ((tid & 7) == 0) RSTD[row0 + row] = rs;
        }
        __syncthreads();
        if (tid < 64) {
            const int row = row0 + tid; const float* lg = PART + tid * 72;
            int gi = 0; float gm = lg[0];
            for (int k = 1; k < 8; ++k) if (lg[k] > gm) { gm = lg[k]; gi = k; }
            float se = 0.f; for (int k = 0; k < 8; ++k) se += expf(lg[k] - gm);
            const float pg = 1.f / se;
            const float* el = lg + 8 + gi * 8;
            int i1 = 0; float v1 = el[0];
            for (int k = 1; k < 8; ++k) if (el[k] > v1) { v1 = el[k]; i1 = k; }
            int i2 = -1; float v2 = -INFINITY;
            for (int k = 0; k < 8; ++k) if (k != i1 && el[k] > v2) { v2 = el[k]; i2 = k; }
            const float e2 = expf(v2 - v1), w1 = 1.f / (1.f + e2), w2 = e2 / (1.f + e2);
            const int ea = gi * 8 + i1, eb = gi * 8 + i2;
            GATE[row * 2] = pg * w1; GATE[row * 2 + 1] = pg * w2;
            const unsigned p1 = atomicAdd(&cnt[ea], 1u); LIST[(size_t)ea * 16384 + p1] = (unsigned)(row * 2);
            const unsigned p2 = atomicAdd(&cnt[eb], 1u); LIST[(size_t)eb * 16384 + p2] = (unsigned)(row * 2 + 1);
        }
    }
}

constexpr int MOE_TB = 132 * 1024;
DEV int moe_prefix(const unsigned* cnt) {
    int* tb = (int*)(g_lds + MOE_TB);
    __syncthreads();
    if (TIDX < 64) {
        const int lane = TIDX;
        const int t = (int)((__hip_atomic_load(cnt + lane, __ATOMIC_RELAXED, __HIP_MEMORY_SCOPE_AGENT) + 255u) >> 8);
        int incl = t;
#pragma unroll
        for (int off = 1; off < 64; off <<= 1) { const int v = __shfl_up(incl, off); if (lane >= off) incl += v; }
        tb[lane] = incl - t; if (lane == 63) tb[64] = incl;
    }
    __syncthreads();
    return tb[64];
}
struct MoeSched {
    struct Unit { int e, mt, nt, ce, slot0; };
    const int* tb; const unsigned* cnt; const unsigned* LIST; const bf16_t* A; const bf16_t* W; size_t wstride; int NT, K, G, c, total;
    DEV bool next(int i, Unit& u) const {
        int id;
        if ((G & 7) == 0) { const int k = i * (G >> 3) + (c >> 3); id = (((k >> 2) << 3) + (c & 7)) * 4 + (k & 3); } else id = i * G + c;
        if (id >= total * NT) return false;
        int e = 0, hi = 63; while (e < hi) { const int mid = (e + hi + 1) >> 1; if (tb[mid] * NT <= id) e = mid; else hi = mid - 1; }
        const int te = tb[e + 1] - tb[e], local = id - tb[e] * NT;
        u.e = e; u.nt = local / te; u.mt = local - u.nt * te; u.ce = (int)cnt[e]; u.slot0 = (tb[e] + u.mt) * 256; return true;
    }
    DEV const char* B0(const Unit& u) const { return (const char*)W + (size_t)u.e * wstride + (size_t)u.nt * 256 * K; }
    DEV const char* A0(const Unit& u) const { return (const char*)A + (size_t)u.slot0 * K; }
    DEV const char* Abase() const { return (const char*)A; }
    DEV bool half1(const Unit& u) const { return u.mt * 256 + 128 < u.ce; }
    DEV unsigned rowoff(const Unit& u, int r) const {
        const int idx = u.mt * 256 + r; const unsigned a = LIST[(size_t)u.e * 16384 + (idx < u.ce ? idx : 0)];
        return (a >> 1) * (unsigned)K; }
};
struct EpiGU { bf16_t* HID; const unsigned* LIST; const float* RSTD; unsigned* TSLOT;
    DEV void operator()(const f32x4 (&acc)[2][2][4][2], const MoeSched::Unit& u, int wr, int wc, int fr, int fq) const {
#pragma unroll
        for (int ai = 0; ai < 2; ++ai)
#pragma unroll
            for (int m = 0; m < 4; ++m) {
                const int r = ai * 128 + wr * 64 + m * 16 + fr;
                float rs = 0.f;
                if (u.mt * 256 + r < u.ce) {
                    const unsigned a = LIST[(size_t)u.e * 16384 + u.mt * 256 + r]; rs = RSTD[a >> 1] * 0.03125f;
                    if (u.nt == 0 && wc == 0 && fq == 0) TSLOT[a] = (unsigned)(u.slot0 + r);
                }
                unsigned char* bb = g_lds + g8::EPI_LDS + (wr * 4 + wc) * g8::EPI_WAVE + (m & 1) * g8::EPI_PATCH;
#pragma unroll
                for (int n = 0; n < 2; ++n) {
                    const f32x4 gg = acc[ai][0][m][n] * rs, uu = acc[ai][1][m][n] * rs;
                    *(unsigned*)(bb + fr * 40 + n * 16 + fq * 4) = pk4_fp8(siluf(gg.x) * uu.x, siluf(gg.y) * uu.y, siluf(gg.z) * uu.z, siluf(gg.w) * uu.w);
                }
                const int lane = fq * 16 + fr, r2 = lane >> 2, c2 = lane & 3;
                const u32x2 o = *(const u32x2*)(bb + r2 * 40 + c2 * 8);
                *(u32x2*)((unsigned char*)HID + (size_t)(u.slot0 + ai * 128 + wr * 64 + m * 16 + r2) * 512 + u.nt * 128 + wc * 32 + c2 * 8) = o;
            }
    } };
struct EpiDown { bf16_t* Y;
    DEV void operator()(const f32x4 (&acc)[2][2][4][2], const MoeSched::Unit& u, int wr, int wc, int fr, int fq) const {
#pragma unroll
        for (int ai = 0; ai < 2; ++ai)
#pragma unroll
            for (int m = 0; m < 4; ++m) {
                const int lane = fq * 16 + fr, r2 = lane >> 2, c2 = lane & 3;
                unsigned char* yp = (unsigned char*)Y + (size_t)(u.slot0 + ai * 128 + wr * 64 + m * 16 + r2) * 2048 + u.nt * 256 + wc * 32 + c2 * 8;
#pragma unroll
                for (int bj = 0; bj < 2; ++bj) {
                    unsigned char* bb = g_lds + g8::EPI_LDS + (wr * 4 + wc) * g8::EPI_WAVE + bj * g8::EPI_PATCH;
#pragma unroll
                    for (int n = 0; n < 2; ++n) {
                        const f32x4 v = (MX_DOWN == 2) ? acc[ai][bj][m][n] : acc[ai][bj][m][n] * 0.25f;
                        *(unsigned*)(bb + fr * 40 + n * 16 + fq * 4) = pk4_fp8(v.x, v.y, v.z, v.w);
                    }
                    *(u32x2*)(yp + bj * 128) = *(const u32x2*)(bb + r2 * 40 + c2 * 8);
                }
            }
    } };
DEV void ph_moe_gu(const Params& p, int layer, int vb, int nvb) {
    unsigned char* ws = p.ws;
    const unsigned* cnt = (const unsigned*)(ws + OFF_CTL) + CW_CNT + layer * 64;
    const int total = __builtin_amdgcn_readfirstlane(moe_prefix(cnt));
    MoeSched S; S.tb = (const int*)(g_lds + MOE_TB); S.cnt = cnt; S.LIST = (const unsigned*)(ws + OFF_LIST) + (size_t)layer * 64 * 16384; S.total = total;
    S.A = (const bf16_t*)(ws + OFF_H); S.W = (const bf16_t*)(ws + OFF_WGU + (size_t)layer * 64 * 1024 * 2048); S.wstride = (size_t)1024 * 2048;   S.NT = 4; S.K = 2048; S.G = nvb; S.c = vb;
    EpiGU E{(bf16_t*)(ws + OFF_HID), S.LIST, (const float*)(ws + OFF_RSTD), (unsigned*)(ws + OFF_TSLOT)};
    g8::gemm_phase<true, EpiGU, MoeSched, MX_GU>(2048, S, E);
}
DEV void ph_moe_down(const Params& p, int layer, int vb, int nvb) {
    unsigned char* ws = p.ws;
    const unsigned* cnt = (const unsigned*)(ws + OFF_CTL) + CW_CNT + layer * 64;
    const int total = __builtin_amdgcn_readfirstlane(moe_prefix(cnt));
    MoeSched S; S.tb = (const int*)(g_lds + MOE_TB); S.cnt = cnt; S.LIST = (const unsigned*)(ws + OFF_LIST) + (size_t)layer * 64 * 16384; S.total = total;
    S.A = (const bf16_t*)(ws + OFF_HID); S.W = (const bf16_t*)(ws + OFF_WD + (size_t)layer * 64 * 2048 * 512); S.wstride = (size_t)2048 * 512;   S.NT = 8; S.K = 512; S.G = nvb; S.c = vb;
    EpiDown E{(bf16_t*)(ws + OFF_Y)};
    g8::gemm_phase<false, EpiDown, MoeSched, MX_DOWN, 2>(512, S, E);
}

DEV void ph_combine(const Params& p, int layer, float* X, const float* g  , int vb, int nvb) {
    const bf16_t* Y = (const bf16_t*)(p.ws + OFF_Y); bf16_t* H = (bf16_t*)(p.ws + OFF_H); unsigned char* H8 = p.ws + OFF_MIX;
    const unsigned* TSLOT = (const unsigned*)(p.ws + OFF_TSLOT); const float* GATE = (const float*)(p.ws + OFF_GATE) + (size_t)layer * 32768;
    const int wave = TIDX >> 6, lane = TIDX & 63;
    for (int row = vb * 8 + wave; row < NTOK; row += nvb * 8) {
        f32x4 v[8]; float ss = 0.f;
        const size_t r0 = (size_t)TSLOT[2 * row] * DM, r1 = (size_t)TSLOT[2 * row + 1] * DM; const float g0 = GATE[2 * row] * 0.25f, g1 = GATE[2 * row + 1] * 0.25f;
        const unsigned char* Y8 = (const unsigned char*)Y;
#pragma unroll
        for (int i = 0; i < 8; ++i) {
            const int c = (i * 64 + lane) * 4;
            f32x4 x4 = *(const f32x4*)(X + (size_t)row * DM + c);
            const f32x4 y0 = up4_fp8(*(const unsigned*)(Y8 + r0 + c)), y1 = up4_fp8(*(const unsigned*)(Y8 + r1 + c));
            x4.x += g0 * y0.x + g1 * y1.x; x4.y += g0 * y0.y + g1 * y1.y; x4.z += g0 * y0.z + g1 * y1.z; x4.w += g0 * y0.w + g1 * y1.w;
            *(f32x4*)(X + (size_t)row * DM + c) = x4; v[i] = x4;
            ss += x4.x * x4.x + x4.y * x4.y + x4.z * x4.z + x4.w * x4.w;
        }
        if (g) {
            ss = wave_sum(ss); const float r = rsqrtf(ss * (1.f / DM) + EPS);
#pragma unroll
            for (int i = 0; i < 8; ++i) { const f32x4 g4 = ((const f32x4*)g)[i * 64 + lane];
                u32x2 w; w.x = pk_bf16(v[i].x * r * g4.x, v[i].y * r * g4.y); w.y = pk_bf16(v[i].z * r * g4.z, v[i].w * r * g4.w);
                if (!QK_FP8) *(u32x2*)(H + (size_t)row * DM + (i * 64 + lane) * 4) = w;
                *(unsigned*)(H8 + (size_t)row * DM + (i * 64 + lane) * 4) = pk4_fp8(v[i].x * r * g4.x, v[i].y * r * g4.y, v[i].z * r * g4.z, v[i].w * r * g4.w); }
        }
    }
}

typedef short s16x4 __attribute__((ext_vector_type(4)));
DEV bf16x8 tr_frag(const bf16_t* tile, int pitch, int k0, int n0, int lane) {
    const int t16 = lane & 15, kq = lane >> 4;
    const bf16_t* a = tile + (k0 + 8 * kq + (t16 >> 2)) * pitch + n0 + (t16 & 3) * 4;
    const s16x4 lo = __builtin_amdgcn_ds_read_tr16_b64_v4i16((LAS s16x4*)a);
    const s16x4 hi = __builtin_amdgcn_ds_read_tr16_b64_v4i16((LAS s16x4*)(a + 4 * pitch));
    return (bf16x8){lo[0], lo[1], lo[2], lo[3], hi[0], hi[1], hi[2], hi[3]};
}
#if VG_FP8
typedef u32x2 vg8_t;
DEV vg8_t ld_vg8(const bf16_t* Z1, size_t tok, int e8) { return *(const u32x2*)((const unsigned char*)Z1 + tok * (size_t)(LD1 * 2) + 8192 + e8); }
DEV u32x4 vg8_bf(vg8_t w) { return __builtin_bit_cast(u32x4, fp8x8_to_bf16(w)); }
#else
typedef u32x4 vg8_t;
DEV vg8_t ld_vg8(const bf16_t* Z1, size_t tok, int e8) { return *(const u32x4*)(Z1 + tok * LD1 + 4096 + e8); }
DEV u32x4 vg8_bf(vg8_t w) { return w; }
#endif
DEV float ret_lg(int h) { return log1pf(-exp2f(-5.f - (float)h)); }
DEV void ph_rope1(const Params& p, int vb, int nvb) {
    bf16_t* Z1 = (bf16_t*)(p.ws + OFF_Z);
    const int wave = TIDX >> 6, lane = TIDX & 63;
    const float L2T = 13.287712379549449f;
    const float inv0 = exp2f(-(float)(2 * lane) * (1.f / 128.f) * L2T), inv1 = exp2f(-(float)(2 * lane + 1) * (1.f / 128.f) * L2T);
    for (int tok = vb * 8 + wave; tok < NTOK; tok += nvb * 8) {
        const float posf = (float)p.pos[tok];
        float s0, c0, s1, c1; sincosf(posf * inv0, &s0, &c0); sincosf(posf * inv1, &s1, &c1);
        bf16_t* z = Z1 + (size_t)tok * LD1;
#pragma unroll
        for (int hq = 0; hq < 16; ++hq) {
            bf16_t* hp = z + hq * 256 + 2 * lane;
            const unsigned a = *(const unsigned*)hp, b2 = *(const unsigned*)(hp + 128);
            const float x10 = bflo(a), x11 = bfhi(a), x20 = bflo(b2), x21 = bfhi(b2);
            const float sc = hq >= 8 ? 0.0625f : 1.f;
            *(unsigned*)hp = pk_bf16((x10 * c0 - x20 * s0) * sc, (x11 * c1 - x21 * s1) * sc);
            *(unsigned*)(hp + 128) = pk_bf16((x20 * c0 + x10 * s0) * sc, (x21 * c1 + x11 * s1) * sc);
        }
    }
}

DEV void ph_ret_kv(const Params& p, int vb, int nvb) {
    const bf16_t* Z1 = (const bf16_t*)(p.ws + OFF_Z); bf16_t* KVL = (bf16_t*)(p.ws + OFF_KVLOC);
    constexpr int TP = 272;
    bf16_t* Vs = (bf16_t*)g_lds; bf16_t* Ks = (bf16_t*)(g_lds + 69632);
    const int tid = TIDX, wave = tid >> 6, lane = tid & 63, fr = lane & 15, fq = lane >> 4, wm = wave >> 1, wn = wave & 1;
    for (int u = vb; u < 1024; u += nvb) {
        const int c = u & 63, h = (u >> 6) & 7, b = u >> 9, tok0 = b * SEQ + c * 128;
        const float lg = ret_lg(h);
        __syncthreads();
        vg8_t vpre[8];
#pragma unroll
        for (int k2 = 0; k2 < 8; ++k2) {
            const int ci = tid + k2 * NBLK, j = ci >> 5, d0 = (ci & 31) * 8; const float dec = expf((float)(127 - j) * lg);
            float v[8]; ld8(Z1 + (size_t)(tok0 + j) * LD1 + 2048 + h * 256 + d0, v);
#pragma unroll
            for (int e = 0; e < 8; ++e) v[e] *= dec;
            st8(Ks + j * TP + d0, v);
            vpre[k2] = ld_vg8(Z1, (size_t)(tok0 + j), h * 512 + d0);
        }
#pragma unroll 1
        for (int vh = 0; vh < 2; ++vh) {
            if (vh > 0) __syncthreads();
#pragma unroll
            for (int k2 = 0; k2 < 8; ++k2) { const int ci = tid + k2 * NBLK, j = ci >> 5, d0 = (ci & 31) * 8; *(u32x4*)(Vs + j * TP + d0) = vg8_bf(vpre[k2]); }
            __syncthreads();
            if (vh == 0) {
#pragma unroll
                for (int k2 = 0; k2 < 8; ++k2) { const int ci = tid + k2 * NBLK, j = ci >> 5, d0 = (ci & 31) * 8; vpre[k2] = ld_vg8(Z1, (size_t)(tok0 + j), h * 512 + 256 + d0); }
            }
            f32x4 acc[4][8];
#pragma unroll
            for (int m = 0; m < 4; ++m)
#pragma unroll
                for (int n = 0; n < 8; ++n) acc[m][n] = (f32x4){0.f, 0.f, 0.f, 0.f};
#pragma unroll 1
            for (int ks = 0; ks < 4; ++ks) {
                bf16x8 af[4];
#pragma unroll
                for (int m = 0; m < 4; ++m) af[m] = tr_frag(Vs, TP, ks * 32, wm * 64 + m * 16, lane);
#pragma unroll
                for (int n = 0; n < 8; ++n) { const bf16x8 bfr = tr_frag(Ks, TP, ks * 32, wn * 128 + n * 16, lane);
#pragma unroll
                    for (int m = 0; m < 4; ++m) acc[m][n] = mfma16(bfr, af[m], acc[m][n]); }
            }
#pragma unroll
            for (int m = 0; m < 4; ++m)
#pragma unroll
                for (int n = 0; n < 8; n += 2) {
                    const unsigned x = pk4_fp8(acc[m][n].x * 8.f, acc[m][n].y * 8.f, acc[m][n].z * 8.f, acc[m][n].w * 8.f);
                    const unsigned y = pk4_fp8(acc[m][n + 1].x * 8.f, acc[m][n + 1].y * 8.f, acc[m][n + 1].z * 8.f, acc[m][n + 1].w * 8.f);
                    const auto pr = __builtin_amdgcn_permlane16_swap(x, y, false, false);
                    u32x2 w; w.x = pr[0]; w.y = pr[1];
                    const int vg = vh * 16 + wm * 4 + m, ks = wn * 4 + (n >> 1), fq2 = (fq & 1) * 2 + (fq >> 1);
                    *(u32x2*)((unsigned char*)KVL + ((((size_t)u * 32 + vg) * 8 + ks) * 64 + fq2 * 16 + fr) * 8) = w;
                }
        }
    }
}
DEV void ph_ret_scan(const Params& p, int vb, int nvb) {
    unsigned char* KVL = p.ws + OFF_KVLOC;
    int tz = TIDX; asm volatile("" : "+v"(tz));
    for (int e = vb * NBLK + tz; e < 16 * 16384; e += nvb * NBLK) {
        const int bh = e >> 14, rem = e & 16383; const float cdec = expf(128.f * ret_lg(bh & 7));
        float run[8];
#pragma unroll
        for (int i = 0; i < 8; ++i) run[i] = 0.f;
#pragma unroll 8
        for (int c = 0; c < 64; ++c) {
            unsigned char* sp = KVL + ((size_t)(bh * 64 + c) * 16384 + rem) * 8;
            const u32x2 w = *(const u32x2*)sp;
            u32x2 o; o.x = pk4_fp8(run[0], run[1], run[2], run[3]); o.y = pk4_fp8(run[4], run[5], run[6], run[7]);
            *(u32x2*)sp = o;
            const f32x4 a = up4_fp8(w.x), b2 = up4_fp8(w.y);
            run[0] = run[0] * cdec + a.x; run[1] = run[1] * cdec + a.y; run[2] = run[2] * cdec + a.z; run[3] = run[3] * cdec + a.w;
            run[4] = run[4] * cdec + b2.x; run[5] = run[5] * cdec + b2.y; run[6] = run[6] * cdec + b2.z; run[7] = run[7] * cdec + b2.w;
        }
    }
}
DEV void ph_ret_out(const Params& p, int vb, int nvb) {
    const bf16_t* Z1 = (const bf16_t*)(p.ws + OFF_Z); const bf16_t* KVL = (const bf16_t*)(p.ws + OFF_KVLOC); bf16_t* OG = (bf16_t*)(p.ws + OFF_MIX);
    unsigned char* OG8 = p.ws + OFF_H;
    constexpr int QP = 264, VP = 144, RO_PATCH = 143104;
    bf16_t* Qs = (bf16_t*)g_lds; bf16_t* Ks = (bf16_t*)(g_lds + 67584); bf16_t* Sb = (bf16_t*)(g_lds + 67584); bf16_t* Vq = (bf16_t*)(g_lds + 67584 + 34816);
    float* sspart = (float*)(g_lds + 139264); float* rstd = (float*)(g_lds + 139264 + 2048);
    const int tid = TIDX, wave = tid >> 6, lane = tid & 63, fr = lane & 15, fq = lane >> 4, wm = wave >> 2, wn = wave & 3;
    for (int u = vb; u < 1024; u += nvb) {
        const int c = u & 63, h = (u >> 6) & 7, b = u >> 9, tok0 = b * SEQ + c * 128;
        const float lg = ret_lg(h);
        __syncthreads();
        for (int ci = tid; ci < 4096; ci += NBLK) {
            const int i = ci >> 5, d0 = (ci & 31) * 8; const float dec = expf((float)(i + 1) * lg);
            float v[8]; ld8(Z1 + (size_t)(tok0 + i) * LD1 + h * 256 + d0, v);
#pragma unroll
            for (int e = 0; e < 8; ++e) v[e] *= dec;
            st8(Qs + i * QP + d0, v);
            *(u32x4*)(Ks + i * QP + d0) = *(const u32x4*)(Z1 + (size_t)(tok0 + i) * LD1 + 2048 + h * 256 + d0);
        }
        vg8_t vpre[4];
#pragma unroll
        for (int k2 = 0; k2 < 4; ++k2) { const int ci = tid + k2 * NBLK; vpre[k2] = ld_vg8(Z1, (size_t)(tok0 + (ci >> 4)), h * 512 + (ci & 15) * 8); }
        __syncthreads();
        {
            f32x4 acc[4][2];
#pragma unroll
            for (int m = 0; m < 4; ++m)
#pragma unroll
                for (int n = 0; n < 2; ++n) acc[m][n] = (f32x4){0.f, 0.f, 0.f, 0.f};
#pragma unroll
            for (int ks = 0; ks < 8; ++ks) {
                bf16x8 af[4], bfr[2];
#pragma unroll
                for (int m = 0; m < 4; ++m) af[m] = *(const bf16x8*)(Qs + (wm * 64 + m * 16 + fr) * QP + ks * 32 + fq * 8);
#pragma unroll
                for (int n = 0; n < 2; ++n) bfr[n] = *(const bf16x8*)(Ks + (wn * 32 + n * 16 + fr) * QP + ks * 32 + fq * 8);
#pragma unroll
                for (int m = 0; m < 4; ++m)
#pragma unroll
                    for (int n = 0; n < 2; ++n) acc[m][n] = mfma16(bfr[n], af[m], acc[m][n]);
            }
            __syncthreads();
#pragma unroll
            for (int m = 0; m < 4; ++m)
#pragma unroll
                for (int n = 0; n < 2; ++n) {
                    const int i = wm * 64 + m * 16 + fr, j0 = wn * 32 + n * 16 + fq * 4;
                    float v[4];
#pragma unroll
                    for (int e = 0; e < 4; ++e) { const int j = j0 + e; v[e] = (j <= i) ? acc[m][n][e] * expf(-(float)(j + 1) * lg) : 0.f; }
                    u32x2 w; w.x = pk_bf16(v[0], v[1]); w.y = pk_bf16(v[2], v[3]);
                    *(u32x2*)(Sb + i * SSD_PITCH + j0) = w;
                }
        }
        float ssq[4] = {0.f, 0.f, 0.f, 0.f};
#pragma unroll 1
        for (int q = 0; q < 4; ++q) {
            u32x2 sf8[8][2];
#pragma unroll
            for (int ks = 0; ks < 8; ++ks)
#pragma unroll
                for (int n = 0; n < 2; ++n) sf8[ks][n] = *(const u32x2*)((const unsigned char*)KVL + ((((size_t)u * 32 + q * 8 + wn * 2 + n) * 8 + ks) * 64 + lane) * 8);
            if (q > 0) __syncthreads();
#pragma unroll
            for (int k2 = 0; k2 < 4; ++k2) { const int ci = tid + k2 * NBLK; *(u32x4*)(Vq + (ci >> 4) * VP + (ci & 15) * 8) = vg8_bf(vpre[k2]); }
            __syncthreads();
            if (q < 3) {
#pragma unroll
                for (int k2 = 0; k2 < 4; ++k2) { const int ci = tid + k2 * NBLK; vpre[k2] = ld_vg8(Z1, (size_t)(tok0 + (ci >> 4)), h * 512 + (q + 1) * 128 + (ci & 15) * 8); }
            }
            f32x4 acc[4][2];
#pragma unroll
            for (int m = 0; m < 4; ++m)
#pragma unroll
                for (int n = 0; n < 2; ++n) acc[m][n] = (f32x4){0.f, 0.f, 0.f, 0.f};
#pragma unroll
            for (int ks = 0; ks < 4; ++ks) {
                bf16x8 af[4], bfr[2];
#pragma unroll
                for (int m = 0; m < 4; ++m) af[m] = *(const bf16x8*)(Sb + (wm * 64 + m * 16 + fr) * SSD_PITCH + ks * 32 + fq * 8);
#pragma unroll
                for (int n = 0; n < 2; ++n) bfr[n] = tr_frag(Vq, VP, ks * 32, wn * 32 + n * 16, lane);
#pragma unroll
                for (int m = 0; m < 4; ++m)
#pragma unroll
                    for (int n = 0; n < 2; ++n) acc[m][n] = mfma16(bfr[n], af[m], acc[m][n]);
            }
#pragma unroll
            for (int ks = 0; ks < 8; ++ks) {
                bf16x8 af[4];
#pragma unroll
                for (int m = 0; m < 4; ++m) af[m] = *(const bf16x8*)(Qs + (wm * 64 + m * 16 + fr) * QP + ks * 32 + fq * 8);
                bf16x8 sfr[2];
#pragma unroll
                for (int n = 0; n < 2; ++n) { const f32x4 a = up4_fp8(sf8[ks][n].x) * 0.125f, b2 = up4_fp8(sf8[ks][n].y) * 0.125f;
                    u32x4 w; w.x = pk_bf16(a.x, a.y); w.y = pk_bf16(a.z, a.w); w.z = pk_bf16(b2.x, b2.y); w.w = pk_bf16(b2.z, b2.w); sfr[n] = __builtin_bit_cast(bf16x8, w); }
#pragma unroll
                for (int m = 0; m < 4; ++m)
#pragma unroll
                    for (int n = 0; n < 2; ++n) acc[m][n] = mfma16(sfr[n], af[m], acc[m][n]);
            }
#pragma unroll
            for (int m = 0; m < 4; ++m) {
                unsigned char* bb = g_lds + RO_PATCH + wave * 2560 + (m & 1) * 1280;
#pragma unroll
                for (int n = 0; n < 2; ++n) {
                    const f32x4 a = acc[m][n];
                    ssq[m] += a.x * a.x + a.y * a.y + a.z * a.z + a.w * a.w;
                    u32x2 w; w.x = pk_bf16(a.x, a.y); w.y = pk_bf16(a.z, a.w);
                    *(u32x2*)(bb + fr * 80 + n * 32 + fq * 8) = w;
                }
                const int r2 = lane >> 2, c2 = lane & 3;
                *(u32x4*)(OG + (size_t)(tok0 + wm * 64 + m * 16 + r2) * 4096 + h * 512 + q * 128 + wn * 32 + c2 * 8) = *(const u32x4*)(bb + r2 * 80 + c2 * 16);
            }
        }
#pragma unroll
        for (int m = 0; m < 4; ++m) {
            float s2 = ssq[m];
            s2 += __shfl_xor(s2, 16); s2 += __shfl_xor(s2, 32);
            if (fq == 0) sspart[(wm * 64 + m * 16 + fr) * 4 + wn] = s2;
        }
        WAIT_VM0();
        __syncthreads();
        if (tid < 128) rstd[tid] = rsqrtf((sspart[tid * 4] + sspart[tid * 4 + 1] + sspart[tid * 4 + 2] + sspart[tid * 4 + 3]) * (1.f / 512.f) + EPS);
        __syncthreads();
#pragma unroll 4
        for (int k2 = 0; k2 < 16; ++k2) {
            const int ci = tid + k2 * NBLK, i = ci >> 6, vc = h * 512 + (ci & 63) * 8; const float rs = rstd[i];
            const u32x4 ow = *(const u32x4*)(OG + (size_t)(tok0 + i) * 4096 + vc);
            const u32x4 gw = vg8_bf(ld_vg8(Z1, (size_t)(tok0 + i), 4096 + vc));
            const f32x4 g0 = *(const f32x4*)(p.ret_norm + vc), g1 = *(const f32x4*)(p.ret_norm + vc + 4);
            u32x2 o;
            o.x = pk4_fp8(bflo(ow.x) * rs * g0.x * siluf(bflo(gw.x)), bfhi(ow.x) * rs * g0.y * siluf(bfhi(gw.x)), bflo(ow.y) * rs * g0.z * siluf(bflo(gw.y)), bfhi(ow.y) * rs * g0.w * siluf(bfhi(gw.y)));
            o.y = pk4_fp8(bflo(ow.z) * rs * g1.x * siluf(bflo(gw.z)), bfhi(ow.z) * rs * g1.y * siluf(bfhi(gw.z)), bflo(ow.w) * rs * g1.z * siluf(bflo(gw.w)), bfhi(ow.w) * rs * g1.w * siluf(bfhi(gw.w)));
            *(u32x2*)(OG8 + (size_t)(tok0 + i) * 4096 + vc) = o;
        }
    }
}

__global__ void __launch_bounds__(NBLK, 2) fwd_kernel(Params p) {
    const int vb = blockIdx.x, nvb = gridDim.x;
    unsigned char* ws = p.ws;
    LAS unsigned* xbw = (LAS unsigned*)(g_lds + LDS_BYTES - 16);
    if (TIDX == 0) { xbw[0] = 0u; xbw[1] = 0u; xbw[2] = 0u; xbw[3] = 0u; }
    __syncthreads();
#if N_LAUNCH_MODE == 1
    XcdBarrier bar = xcd_barrier_post((unsigned*)(ws + OFF_CTL) + CW_BAR, (volatile LAS unsigned*)xbw);
#define GRID_BAR() xcd_barrier(bar)
#else
#define GRID_BAR() do {} while (0)
#endif
    const int lo = p.ph_lo, hi = p.ph_hi;
#ifdef ONLY_PHASE
#define IN(k) ((k) == ONLY_PHASE)
#else
#define IN(k) (lo <= (k) && (k) < hi)
#endif
#define SEAM(k) do { if (IN(k) && IN((k) + 1)) GRID_BAR(); } while (0)
    bf16_t* Hb = (bf16_t*)(ws + OFF_H);
    if (IN(0)) { ph_prep(p, vb, nvb, 0); ph_norm(p.x, p.mix_norm, Hb, vb, nvb); } SEAM(0);
    if (IN(1)) {
        const int G = (nvb == 256) ? GEMM_CUS : nvb;
        if (vb < G) ph_gemm8_dense(Hb, (const bf16_t*)(ws + OFF_WIN0), LD0, DM, g8::EpiZ0T{(bf16_t*)(ws + OFF_Z), (float*)(ws + OFF_ZS)}, vb, G);
        ph_prep(p, vb, nvb, 1);
    } SEAM(1);
    if (IN(2)) { ph_post0(p, vb, nvb); } SEAM(2);
#if REPEAT_GROUP == 13
    ph_post0(p, vb, nvb); GRID_BAR();
#endif
    if (IN(3)) { ph_dsa(p, vb, nvb); ph_ssd_states(p, vb, nvb); } SEAM(3);
#if REPEAT_GROUP == 7
    ph_ssd_states(p, vb, nvb); GRID_BAR();
#endif
    if (IN(4)) { ph_ssd_scan(p, vb, nvb); ph_dsa_attn(p, vb, nvb); } SEAM(4);
    if (IN(5)) { ph_ssd_out(p, vb, nvb); } SEAM(5);
#if REPEAT_GROUP == 6
    ph_ssd_scan(p, vb, nvb); GRID_BAR(); ph_ssd_out(p, vb, nvb); GRID_BAR();
#endif
    if (IN(6)) {
        if (FP8_OUT0) { g8::DenseSched S; S.init((const bf16_t*)(ws + OFF_H), (const bf16_t*)(ws + OFF_WOUT0), NTOK, DM, DM, nvb, vb); S.esz = 1; if (REPEAT_GROUP == 16) S.rep = 2;
            g8::EpiResidT E{p.x, p.out, 1.f};
            g8::gemm_phase<false, g8::EpiResidT, g8::DenseSched, 2, 6>(DM, S, E); }
        else ph_gemm8_dense((const bf16_t*)(ws + OFF_MIX), (const bf16_t*)(ws + OFF_WOUT0), DM, DM, g8::EpiResidT{p.x, p.out, 1.f}, vb, nvb); } SEAM(6);
    if (IN(7)) { ph_router(p, 0, p.out, vb, nvb); } SEAM(7);
    if (IN(8)) { ph_moe_gu(p, 0, vb, nvb); } SEAM(8);
    if (IN(9)) { ph_moe_down(p, 0, vb, nvb); } SEAM(9);
    if (IN(10)) { ph_combine(p, 0, p.out, p.mix_norm + DM, vb, nvb); } SEAM(10);
    if (IN(11)) {
        if (QK_FP8) { g8::DenseSched S; S.init((const bf16_t*)(ws + OFF_MIX), (const bf16_t*)(ws + OFF_WIN1), NTOK, 4096, DM, nvb, vb); S.esz = 1;
            EpiZ1 E{(bf16_t*)(ws + OFF_Z), (const float*)(ws + OFF_ROPE)}; g8::gemm_phase<false, EpiZ1, g8::DenseSched, 2, 6>(DM, S, E); }
        else { g8::DenseSched S; S.init(Hb, (const bf16_t*)(ws + OFF_WIN1), NTOK, 4096, DM, nvb, vb); if (REPEAT_GROUP == 17) S.rep = 2; g8::gemm_phase<false>(DM, S, EpiZ1{(bf16_t*)(ws + OFF_Z), (const float*)(ws + OFF_ROPE)}); } } SEAM(11);
    if (IN(12)) {
        g8::DenseSched S; S.init((const bf16_t*)(ws + OFF_MIX), (const bf16_t*)(ws + OFF_WIN1 + (size_t)4096 * 2048 * 2), NTOK, 8192, DM, nvb, vb); S.esz = 1; if (REPEAT_GROUP == 18) S.rep = 2;
#if VG_FP8
        g8::EpiF8T<LD1 * 2> E{ws + OFF_Z + 8192};
        g8::gemm_phase<false, g8::EpiF8T<LD1 * 2>, g8::DenseSched, 2, 6>(DM, S, E); } SEAM(12);
#else
        g8::EpiBfT<LD1> E{(bf16_t*)(ws + OFF_Z) + 4096};
        g8::gemm_phase<false, g8::EpiBfT<LD1>, g8::DenseSched, 2, 6>(DM, S, E); } SEAM(12);
#endif
    if (IN(13)) { ph_ret_kv(p, vb, nvb); } SEAM(13);
#if REPEAT_GROUP == 10
    ph_ret_kv(p, vb, nvb); GRID_BAR();
#endif
    if (IN(14)) { ph_ret_scan(p, vb, nvb); } SEAM(14);
    if (IN(15)) { ph_ret_out(p, vb, nvb); } SEAM(15);
#if REPEAT_GROUP == 12
    ph_ret_out(p, vb, nvb); GRID_BAR();
#endif
#if REPEAT_GROUP == 4
    ph_ret_kv(p, vb, nvb); GRID_BAR(); ph_ret_scan(p, vb, nvb); GRID_BAR(); ph_ret_out(p, vb, nvb); GRID_BAR();
#endif
    if (IN(16)) {
        g8::DenseSched S; S.init((const bf16_t*)(ws + OFF_H), (const bf16_t*)(ws + OFF_WOUT1), NTOK, DM, 4096, nvb, vb); S.esz = 1;
        g8::EpiResidT E{p.out, p.out, MX_OUT1 == 2 ? 1.f : 1.f / 64.f};
        g8::gemm_phase<false, g8::EpiResidT, g8::DenseSched, MX_OUT1, 6>(4096, S, E); } SEAM(16);
    if (IN(17)) { ph_router(p, 1, p.out, vb, nvb); } SEAM(17);
    if (IN(18)) { ph_moe_gu(p, 1, vb, nvb); } SEAM(18);
    if (IN(19)) { ph_moe_down(p, 1, vb, nvb); } SEAM(19);
#if REPEAT_GROUP == 5
    if (vb == 0 && TIDX < 64) ((unsigned*)(ws + OFF_CTL))[CW_CNT + 64 + TIDX] = 0u; GRID_BAR();
    ph_router(p, 1, p.out, vb, nvb); GRID_BAR(); ph_moe_gu(p, 1, vb, nvb); GRID_BAR(); ph_moe_down(p, 1, vb, nvb); GRID_BAR();
#endif
#if REPEAT_GROUP == 8
    ph_moe_gu(p, 1, vb, nvb); GRID_BAR();
#endif
#if REPEAT_GROUP == 9
    ph_moe_down(p, 1, vb, nvb); GRID_BAR();
#endif
    if (IN(20)) { ph_combine(p, 1, p.out, nullptr, vb, nvb); }
}


#ifdef DEBUG_NAN
__global__ void dbg_check(const void* p, size_t n, int is_f32, unsigned code, unsigned* flag) {
    size_t i = (size_t)blockIdx.x * blockDim.x + TIDX; const size_t st = (size_t)gridDim.x * blockDim.x;
    bool bad = false;
    if (is_f32) { const unsigned* u = (const unsigned*)p; for (; i < n; i += st) bad |= ((u[i] & 0x7f800000u) == 0x7f800000u); }
    else { const unsigned short* u = (const unsigned short*)p; for (; i < n; i += st) bad |= ((u[i] & 0x7f80u) == 0x7f80u); }
    if (bad) atomicMax(flag, 64u - code);
}
__global__ void dbg_fill(float* out, size_t n, const unsigned* flag) {
    const unsigned f = *flag; const unsigned sub = flag[1]; if (f == 0u && sub == 0u) return;
    const float v = sub ? (float)sub : (float)(64u - f);
    for (size_t i = (size_t)blockIdx.x * blockDim.x + TIDX; i < n; i += (size_t)gridDim.x * blockDim.x) out[i] = v;
}
#endif

extern "C" void kernel_launch(void* const* d_in, const int* in_sizes, int n_in, void* d_out, int out_size, void* d_ws, size_t ws_size, hipStream_t stream) {
    static int grid = 0;
    if (grid == 0) {
        if (n_in != 23 || ws_size < WS_TOTAL) { fprintf(stderr, "kernel_launch: need 23 inputs and %zu ws bytes (got %d, %zu)\n", (size_t)WS_TOTAL, n_in, ws_size); grid = -1; return; }
        int dev = 0, cus = 0;
        hipGetDevice(&dev); hipDeviceGetAttribute(&cus, hipDeviceAttributeMultiprocessorCount, dev);
        if (hipFuncSetAttribute((const void*)fwd_kernel, hipFuncAttributeMaxDynamicSharedMemorySize, LDS_BYTES) != hipSuccess) { fprintf(stderr, "hipFuncSetAttribute failed\n"); grid = -1; return; }
        int per_cu = 0; hipOccupancyMaxActiveBlocksPerMultiprocessor(&per_cu, (const void*)fwd_kernel, NBLK, LDS_BYTES); (void)hipGetLastError();
        grid = cus > 0 ? cus : 256;
    }
    if (grid < 0) return;
    hipMemsetAsync((char*)d_ws + OFF_CTL, 0, 65536, stream);
    Params p{};
    const float** f = (const float**)&p.x;
    (void)f;
    p.x = (const float*)d_in[0]; p.pos = (const int*)d_in[1]; p.mix_norm = (const float*)d_in[2]; p.ffn_norm = (const float*)d_in[3]; p.hyb_w_in = (const float*)d_in[4];
    p.q_norm = (const float*)d_in[5]; p.k_norm = (const float*)d_in[6]; p.kidx_norm = (const float*)d_in[7]; p.conv_w = (const float*)d_in[8]; p.conv_b = (const float*)d_in[9];
    p.dt_bias = (const float*)d_in[10]; p.a_log = (const float*)d_in[11]; p.ssm_d = (const float*)d_in[12]; p.ssm_norm = (const float*)d_in[13]; p.hyb_w_out = (const float*)d_in[14];
    p.ret_w_in = (const float*)d_in[15]; p.ret_norm = (const float*)d_in[16]; p.ret_w_out = (const float*)d_in[17]; p.w_rg = (const float*)d_in[18]; p.w_re = (const float*)d_in[19];
    p.w_gate = (const float*)d_in[20]; p.w_up = (const float*)d_in[21]; p.w_down = (const float*)d_in[22];
    p.out = (float*)d_out; p.ws = (unsigned char*)d_ws;
    constexpr int NPH = 21;
#if N_LAUNCH_MODE == 1
#ifdef PROBE_PHASE
    p.ph_lo = 0; p.ph_hi = PROBE_PHASE + 1; hipLaunchKernelGGL(fwd_kernel, dim3(grid), dim3(NBLK), LDS_BYTES, stream, p);
    hipMemsetAsync((char*)d_ws + OFF_CTL, 0, XCD_BAR_WORDS * 4, stream);
    if (PROBE_PHASE == 4) hipMemsetAsync((char*)d_ws + OFF_CTL + CW_DSAQ * 4, 0, 1024, stream);
    if (PROBE_PHASE == 7 || PROBE_PHASE == 17) hipMemsetAsync((char*)d_ws + OFF_CTL + (CW_CNT + (PROBE_PHASE == 17 ? 64 : 0)) * 4, 0, 256, stream);
    p.ph_lo = PROBE_PHASE; p.ph_hi = PROBE_PHASE + 1; hipLaunchKernelGGL(fwd_kernel, dim3(grid), dim3(NBLK), LDS_BYTES, stream, p);
    hipMemsetAsync((char*)d_ws + OFF_CTL, 0, XCD_BAR_WORDS * 4, stream);
    p.ph_lo = PROBE_PHASE + 1; p.ph_hi = NPH; hipLaunchKernelGGL(fwd_kernel, dim3(grid), dim3(NBLK), LDS_BYTES, stream, p);
#else
    p.ph_lo = 0; p.ph_hi = NPH;
    hipLaunchKernelGGL(fwd_kernel, dim3(grid), dim3(NBLK), LDS_BYTES, stream, p);
#endif
#else
    for (int k = 0; k < NPH; ++k) { p.ph_lo = k; p.ph_hi = k + 1; hipLaunchKernelGGL(fwd_kernel, dim3(grid), dim3(NBLK), LDS_BYTES, stream, p);
#ifdef DEBUG_NAN
        unsigned* flag = (unsigned*)((char*)d_ws + OFF_CTL) + 8000; char* w = (char*)d_ws;
#define CHK(ptr, n, f32) hipLaunchKernelGGL(dbg_check, dim3(1024), dim3(256), 0, stream, (const void*)(ptr), (size_t)(n), (int)(f32), (unsigned)(k + 1), flag)
        switch (k) {
        case 0: CHK(w + OFF_H, (size_t)NTOK * 2048, 0); CHK(w + OFF_WIN0, (OFF_WRT - OFF_WIN0) / 2, 0); CHK(w + OFF_WRT, 2 * 72 * 2048, 1); break;
        case 1: CHK(w + OFF_Z, (size_t)NTOK * LD0, 0); CHK(w + OFF_ZS, (size_t)NTOK * 256, 1); break;
        case 2: CHK(w + OFF_QA, (OFF_WIS - OFF_QA) / 2, 0); CHK(w + OFF_WIS, (OFF_XC - OFF_WIS) / 4, 1); CHK(w + OFF_XC, (size_t)NTOK * 1536, 0); break;
        case 3: CHK(w + OFF_MIX, (size_t)NTOK * 2048, 0); CHK(w + OFF_ST, (size_t)2 * 64 * 16 * 8192, 1); CHK(w + OFF_CD, 2048, 1); break;
        case 4: CHK(w + OFF_PREV, (size_t)2 * 64 * 16 * 8192, 0); break;
        case 5: CHK(w + OFF_MIX, (size_t)NTOK * 2048, 0); break;
        case 6: case 10: case 16: case 20: CHK(d_out, (size_t)NTOK * 2048, 1); break;
        case 7: case 17: CHK(w + OFF_H, (size_t)NTOK * 2048, 0); CHK(w + OFF_GATE, 65536, 1); break;
        case 8: case 18: CHK(w + OFF_HID, (size_t)49152 * 512, 0); break;
        case 9: case 19: CHK(w + OFF_Y, (size_t)32768 * 2048, 0); break;
        case 11: case 12: CHK(w + OFF_Z, (size_t)NTOK * LD1, 0); break;
        case 13: case 14: CHK(w + OFF_KVLOC, (size_t)1024 * 131072, 0); break;
        case 15: CHK(w + OFF_MIX, (size_t)NTOK * 4096, 0); break;
        }
        if (k == NPH - 1) hipLaunchKernelGGL(dbg_fill, dim3(1024), dim3(256), 0, stream, (float*)d_out, (size_t)NTOK * 2048, (const unsigned*)flag);
#endif
    }
#endif
}
```
